# Optimizing an MI355X kernel written in HIP

```python
import math
import jax, jax.numpy as jnp
from jax import lax
import numpy as np

D_MODEL = 1024
BATCH = 32
SEQ = 2048
DEPTH = 2

N_BRANCHES = 4
BRANCH_WIDTH = D_MODEL // N_BRANCHES
MOBA_HEADS = 4
MOBA_HEAD_DIM = BRANCH_WIDTH // MOBA_HEADS
MOBA_BLOCK = 256
MOBA_TOPK = 3
Q_BLOCK = 128
CONV_WIDTH = 3
POOL_WINDOWS = (2, 4, 8, 16)
POOL_GROUP = BRANCH_WIDTH // len(POOL_WINDOWS)
DIFF_HEADS = 4
DIFF_V_DIM = BRANCH_WIDTH // DIFF_HEADS
DIFF_QK_DIM = DIFF_V_DIM // 2
REL_BUCKETS = 32
REL_MAX_DIST = 128
N_ATTN_HEADS = MOBA_HEADS + DIFF_HEADS
N_MIX_SLICES = 10
W_IN_WIDTH = N_MIX_SLICES * BRANCH_WIDTH + N_BRANCHES * D_MODEL
D_FF_DENSE = 2816
N_EXPERTS = 8
TOP_K_EXPERTS = 2
D_FF_EXPERT = 3584
N_DENSE = (DEPTH + 1) // 2
N_MOE = DEPTH // 2
RMS_EPS = 1e-6
SUBLN_EPS = 1e-5
NEG_INF = -1e30

kernel_name = "hybrid_moba_conv_pool_diffattn_moe"


def rmsnorm(x, g, eps=RMS_EPS):
    xf = x.astype(jnp.float32)
    r = lax.rsqrt(jnp.mean(xf * xf, axis=-1, keepdims=True) + eps)
    return (xf * r).astype(x.dtype) * g


def rel_bucket(dist):
    n = jnp.maximum(dist, 0)
    max_exact = REL_BUCKETS // 2
    nf = jnp.maximum(n, max_exact).astype(jnp.float32)
    large = max_exact + (jnp.log(nf / max_exact) / math.log(REL_MAX_DIST / max_exact)
                         * (REL_BUCKETS - max_exact)).astype(jnp.int32)
    large = jnp.minimum(large, REL_BUCKETS - 1)
    return jnp.where(n < max_exact, n, large)


def moba_attention(q, k, v, bias_tab):
    _, H, S, dh = q.shape
    n_blk = -(-S // MOBA_BLOCK)
    s_pad = n_blk * MOBA_BLOCK
    topk = min(MOBA_TOPK, n_blk)
    n_qc = s_pad // Q_BLOCK
    scale = dh ** -0.5
    pad = ((0, 0), (0, s_pad - S), (0, 0))
    head_ix = jnp.arange(H)[:, None, None, None]

    def per_seq(args):
        qb, kb, vb = args
        qb = jnp.pad(qb, pad) * scale
        k_blocks = jnp.pad(kb, pad).reshape(H, n_blk, MOBA_BLOCK, dh)
        v_blocks = jnp.pad(vb, pad).reshape(H, n_blk, MOBA_BLOCK, dh)
        k_mean = jnp.mean(k_blocks.astype(jnp.float32), axis=2).astype(kb.dtype)
        q_chunks = qb.reshape(H, n_qc, Q_BLOCK, dh).transpose(1, 0, 2, 3)

        def per_chunk(args2):
            qc, ci = args2
            t_pos = ci * Q_BLOCK + jnp.arange(Q_BLOCK)
            own = (ci * Q_BLOCK) // MOBA_BLOCK
            gate = jnp.einsum('hqd,hnd->hqn', qc, k_mean)
            gate = jnp.where(jnp.arange(n_blk) < own, gate, NEG_INF)
            _, sel = lax.top_k(gate, topk)
            valid = jnp.arange(topk) < own
            k_sel = jax.vmap(lambda kbh, ix: kbh[ix])(k_blocks, sel)
            v_sel = jax.vmap(lambda vbh, ix: vbh[ix])(v_blocks, sel)
            key_pos_sel = sel[..., None] * MOBA_BLOCK + jnp.arange(MOBA_BLOCK)
            bias_sel = bias_tab[head_ix, rel_bucket(t_pos[None, :, None, None] - key_pos_sel)]
            logit_sel = jnp.einsum('hqd,hqnkd->hqnk', qc, k_sel) + bias_sel
            logit_sel = jnp.where(valid[:, None], logit_sel, NEG_INF)
            k_own = lax.dynamic_index_in_dim(k_blocks, own, axis=1, keepdims=False)
            v_own = lax.dynamic_index_in_dim(v_blocks, own, axis=1, keepdims=False)
            rel_own = t_pos[:, None] - (own * MOBA_BLOCK + jnp.arange(MOBA_BLOCK))[None, :]
            logit_own = jnp.einsum('hqd,hkd->hqk', qc, k_own) + bias_tab[:, rel_bucket(rel_own)]
            logit_own = jnp.where(rel_own >= 0, logit_own, NEG_INF)
            logits = jnp.concatenate(
                [logit_sel.reshape(H, Q_BLOCK, topk * MOBA_BLOCK), logit_own], axis=-1)
            p = jax.nn.softmax(logits.astype(jnp.float32), axis=-1).astype(vb.dtype)
            p_sel = p[..., :topk * MOBA_BLOCK].reshape(H, Q_BLOCK, topk, MOBA_BLOCK)
            p_own = p[..., topk * MOBA_BLOCK:]
            return (jnp.einsum('hqnk,hqnkd->hqd', p_sel, v_sel)
                    + jnp.einsum('hqk,hkd->hqd', p_own, v_own))

        out = lax.map(per_chunk, (q_chunks, jnp.arange(n_qc)))
        return out.transpose(1, 0, 2, 3).reshape(H, s_pad, dh)[:, :S]

    return lax.map(per_seq, (q, k, v))


def diff_attention(q, k, v, bias_tab, lam, subln_g, lam_init):
    B_, H, _, S, dq = q.shape
    dv = v.shape[-1]
    n_qc = S // Q_BLOCK
    q = q * dq ** -0.5
    q_chunks = q.reshape(B_, H, 2, n_qc, Q_BLOCK, dq).transpose(3, 0, 1, 2, 4, 5)
    key_pos = jnp.arange(S)

    def per_chunk(args):
        qc, ci = args
        t_pos = ci * Q_BLOCK + jnp.arange(Q_BLOCK)
        rel = t_pos[:, None] - key_pos[None, :]
        bias = bias_tab[:, rel_bucket(rel)]
        logits = jnp.einsum('bhmqd,bhmsd->bhmqs', qc, k) + bias[None, :, None]
        logits = jnp.where(rel >= 0, logits, NEG_INF).astype(jnp.float32)
        p = jax.nn.softmax(logits, axis=-1)
        a = (p[:, :, 0] - lam * p[:, :, 1]).astype(v.dtype)
        return jnp.einsum('bhqs,bhsd->bhqd', a, v)

    o = lax.map(per_chunk, (q_chunks, jnp.arange(n_qc)))
    o = o.transpose(1, 2, 0, 3, 4).reshape(B_, H, S, dv)
    return rmsnorm(o, subln_g, SUBLN_EPS) * (1.0 - lam_init)


def short_conv(xt, b_gate, c_gate, w_conv):
    S = xt.shape[1]
    u = c_gate * xt
    up = jnp.pad(u, ((0, 0), (CONV_WIDTH - 1, 0), (0, 0)))
    conv = w_conv[0] * up[:, 0:S]
    for i in range(1, CONV_WIDTH):
        conv = conv + w_conv[i] * up[:, i:i + S]
    return b_gate * conv


def multiscale_pool(u, w_grp, scale):
    B_, S, _ = u.shape
    ug = u.reshape(B_, S, len(POOL_WINDOWS), POOL_GROUP)
    cs = jnp.cumsum(ug.astype(jnp.float32), axis=1)
    outs = []
    for g, w in enumerate(POOL_WINDOWS):
        c = cs[:, :, g]
        lag = jnp.pad(c, ((0, 0), (w, 0), (0, 0)))[:, :S]
        cnt = jnp.minimum(jnp.arange(1, S + 1), w).astype(jnp.float32)[None, :, None]
        outs.append((c - lag) / cnt)
    pooled = jnp.stack(outs, axis=2).astype(u.dtype) - ug
    y = jnp.einsum('bsgc,gcd->bsgd', pooled, w_grp).reshape(B_, S, BRANCH_WIDTH)
    return y * scale


def token_mixers(h, w_in, conv_w, pool_w, pool_scale, diff_lam, subln_g, branch_proj, w_out,
                 bias_table, layer_idx):
    B_, S, _ = h.shape
    u = h @ w_in
    split_pts = [BRANCH_WIDTH * i for i in range(1, N_MIX_SLICES + 1)]
    qa, ka, va, xb, bb, cb, pc, qd, kd, vd, gates = jnp.split(u, split_pts, axis=-1)

    def heads_a(t):
        return t.reshape(B_, S, MOBA_HEADS, MOBA_HEAD_DIM).transpose(0, 2, 1, 3)

    y_a = moba_attention(heads_a(qa), heads_a(ka), heads_a(va), bias_table[:, :MOBA_HEADS].T)
    y_a = y_a.transpose(0, 2, 1, 3).reshape(B_, S, BRANCH_WIDTH)

    y_b = short_conv(xb, bb, cb, conv_w)
    y_c = multiscale_pool(pc, pool_w, pool_scale)

    lam_init = 0.8 - 0.6 * math.exp(-0.3 * layer_idx)
    lam = (jnp.exp(jnp.sum(diff_lam[0] * diff_lam[1]).astype(jnp.float32))
           - jnp.exp(jnp.sum(diff_lam[2] * diff_lam[3]).astype(jnp.float32)) + lam_init)
    q_d = qd.reshape(B_, S, DIFF_HEADS, 2, DIFF_QK_DIM).transpose(0, 2, 3, 1, 4)
    k_d = kd.reshape(B_, S, DIFF_HEADS, 2, DIFF_QK_DIM).transpose(0, 2, 3, 1, 4)
    v_d = vd.reshape(B_, S, DIFF_HEADS, DIFF_V_DIM).transpose(0, 2, 1, 3)
    y_d = diff_attention(q_d, k_d, v_d, bias_table[:, MOBA_HEADS:].T, lam, subln_g, lam_init)
    y_d = y_d.transpose(0, 2, 1, 3).reshape(B_, S, BRANCH_WIDTH)

    g = jax.nn.sigmoid(gates.reshape(B_, S, N_BRANCHES, D_MODEL))
    merged = g[:, :, 0] * (y_a @ branch_proj[0])
    merged = merged + g[:, :, 1] * (y_b @ branch_proj[1])
    merged = merged + g[:, :, 2] * (y_c @ branch_proj[2])
    merged = merged + g[:, :, 3] * (y_d @ branch_proj[3])
    return merged @ w_out


def swiglu(h, w1, w3, w2):
    return (jax.nn.silu(h @ w1) * (h @ w3)) @ w2


def moe_swiglu(h, router, w1, w3, w2):
    logits = (h @ router).astype(jnp.float32)
    top_v, top_i = lax.top_k(logits, TOP_K_EXPERTS)
    top_w = jax.nn.softmax(top_v, axis=-1)
    out = jnp.zeros_like(h)
    for e in range(N_EXPERTS):
        gate_e = jnp.sum(jnp.where(top_i == e, top_w, 0.0), axis=-1, keepdims=True).astype(h.dtype)
        out = out + gate_e * swiglu(h, w1[e], w3[e], w2[e])
    return out


def setup_inputs(seed: int = 0) -> dict:
    key = jax.random.key(seed)
    ks = jax.random.split(key, 20)

    def nrm(k, shape, scale):
        return jax.random.normal(k, shape, jnp.float32) * scale

    return {
        "x": nrm(ks[0], (BATCH, SEQ, D_MODEL), 1.0),
        "bias_table": nrm(ks[1], (REL_BUCKETS, N_ATTN_HEADS), 0.5),
        "mix_norm_g": 1.0 + nrm(ks[2], (DEPTH, D_MODEL), 0.05),
        "w_in": nrm(ks[3], (DEPTH, D_MODEL, W_IN_WIDTH), D_MODEL ** -0.5),
        "conv_w": nrm(ks[4], (DEPTH, CONV_WIDTH, BRANCH_WIDTH), CONV_WIDTH ** -0.5),
        "pool_w": nrm(ks[5], (DEPTH, len(POOL_WINDOWS), POOL_GROUP, POOL_GROUP), POOL_GROUP ** -0.5),
        "pool_scale": 1.0 + nrm(ks[6], (DEPTH, BRANCH_WIDTH), 0.1),
        "diff_lambda": nrm(ks[7], (DEPTH, 4, DIFF_QK_DIM), 0.1),
        "diff_subln_g": 1.0 + nrm(ks[8], (DEPTH, DIFF_V_DIM), 0.05),
        "branch_proj": nrm(ks[9], (DEPTH, N_BRANCHES, BRANCH_WIDTH, D_MODEL), BRANCH_WIDTH ** -0.5),
        "w_out": nrm(ks[10], (DEPTH, D_MODEL, D_MODEL), D_MODEL ** -0.5),
        "ffn_norm_g": 1.0 + nrm(ks[11], (DEPTH, D_MODEL), 0.05),
        "dense_w1": nrm(ks[12], (N_DENSE, D_MODEL, D_FF_DENSE), D_MODEL ** -0.5),
        "dense_w3": nrm(ks[13], (N_DENSE, D_MODEL, D_FF_DENSE), D_MODEL ** -0.5),
        "dense_w2": nrm(ks[14], (N_DENSE, D_FF_DENSE, D_MODEL), D_FF_DENSE ** -0.5),
        "moe_router": nrm(ks[15], (N_MOE, D_MODEL, N_EXPERTS), D_MODEL ** -0.5),
        "moe_w1": nrm(ks[16], (N_MOE, N_EXPERTS, D_MODEL, D_FF_EXPERT), D_MODEL ** -0.5),
        "moe_w3": nrm(ks[17], (N_MOE, N_EXPERTS, D_MODEL, D_FF_EXPERT), D_MODEL ** -0.5),
        "moe_w2": nrm(ks[18], (N_MOE, N_EXPERTS, D_FF_EXPERT, D_MODEL), D_FF_EXPERT ** -0.5),
        "final_norm_g": 1.0 + nrm(ks[19], (D_MODEL,), 0.05),
    }


def reference(x, bias_table, mix_norm_g, w_in, conv_w, pool_w, pool_scale, diff_lambda,
              diff_subln_g, branch_proj, w_out, ffn_norm_g, dense_w1, dense_w3, dense_w2,
              moe_router, moe_w1, moe_w3, moe_w2, final_norm_g):
    for i in range(DEPTH):
        h = rmsnorm(x, mix_norm_g[i])
        x = x + token_mixers(h, w_in[i], conv_w[i], pool_w[i], pool_scale[i], diff_lambda[i],
                             diff_subln_g[i], branch_proj[i], w_out[i], bias_table, i)
        h = rmsnorm(x, ffn_norm_g[i])
        if i % 2 == 0:
            j = i // 2
            x = x + swiglu(h, dense_w1[j], dense_w3[j], dense_w2[j])
        else:
            j = i // 2
            x = x + moe_swiglu(h, moe_router[j], moe_w1[j], moe_w3[j], moe_w2[j])
    return rmsnorm(x, final_norm_g)
```

```cpp
#include <hip/hip_runtime.h>
#include <cstdio>
#include <cstdint>

#ifndef MK_ONE_LAUNCH
#define MK_ONE_LAUNCH 1
#endif

namespace pg8 {
#define PG8_LAS __attribute__((address_space(3)))
typedef unsigned short bf16_t;
typedef short bf16x8 __attribute__((ext_vector_type(8)));
typedef float f32x4 __attribute__((ext_vector_type(4)));
typedef unsigned u32x4 __attribute__((ext_vector_type(4)));
typedef unsigned u32x2 __attribute__((ext_vector_type(2)));
typedef int i32x4 __attribute__((ext_vector_type(4)));
typedef int i32x8 __attribute__((ext_vector_type(8)));
constexpr int BM = 256, BK = 64, HALF = 128, HTB = HALF * BK * 2  , STAGE_BYTES = 8 * HTB, NXCD = 8, WGM = 8;

__host__ __device__ __forceinline__ int lds_byte(int r, int c) { const int st = (r >> 4) * 2 + (c >> 5), rr = r & 15, cc = c & 31, ob = rr * 64 + cc * 2; return st * 1024 + (ob ^ (((ob >> 9) & 1) << 5)); }
__host__ __device__ __forceinline__ void stage_rc(int b, int& R, int& C) { const int st = b / 1024, sb = b % 1024, swz = sb ^ (((sb >> 9) & 1) << 5); R = (st >> 1) * 16 + swz / 64; C = (st & 1) * 32 + (swz % 64) / 2; }
__host__ __device__ __forceinline__ int perm32(int rho) { const int n = rho >> 4, i = rho & 15; return 8 * (i >> 2) + 4 * n + (i & 3); }

struct Unit { int pm, pn, e, prow, second; size_t aoff, boff; };
struct Gemm { const bf16_t* A; const bf16_t* Bt; int lda, ldb, K; };

struct Order {
    int nM, nN, nwg, G, c, mode, n0, skip; size_t arow  , brow  , estride; const int* tile_e;
    __device__ __forceinline__ void init(int nM_, int nN_, int G_, int c_, int mode_, int lda, int ldb, const int* te, size_t es, int n0_ = 1 << 30, int skip_ = 0) {
        nM = nM_; nN = nN_; nwg = nM * nN; G = G_; c = c_; mode = mode_; arow = (size_t)BM * lda * 2; brow = (size_t)BM * ldb * 2; tile_e = te; estride = es; n0 = n0_; skip = skip_; }
    __device__ __forceinline__ bool base(int i, Unit& u) const {
        const long L = (long)i * G + c; if (L >= nwg) return false;
        int wgid = (int)L; { const int q = nwg / NXCD, r = nwg % NXCD, xcd = wgid % NXCD, off = wgid / NXCD; wgid = (xcd < r ? xcd * (q + 1) : r * (q + 1) + (xcd - r) * q) + off; }
        const int nig = WGM * nN, gid = wgid / nig, fm = gid * WGM, gsz = (nM - fm) < WGM ? (nM - fm) : WGM;
        u.pm = fm + ((wgid % nig) % gsz); u.pn = (wgid % nig) / gsz; return true;
    }
    __device__ __forceinline__ bool next(int i, Unit& u) const {
        if (mode == 1) { if (!base(i >> 2, u)) return false; u.e = i & 3; u.prow = u.pm; u.second = 0; u.aoff = (size_t)u.pm * arow + (size_t)u.e * 512; u.boff = (size_t)u.e * estride + (size_t)u.pn * brow; return true; }
        if (!base(i, u)) return false;
        const bool second = u.pm >= n0; u.prow = second ? skip + (u.pm - n0) : u.pm; u.second = second ? 1 : 0;
        u.e = tile_e ? __builtin_amdgcn_readfirstlane(tile_e[second ? 512 + (u.pm - n0) : u.pm]) : 0; u.aoff = (size_t)u.prow * arow; u.boff = (size_t)u.e * estride + (size_t)u.pn * brow; return true;
    }
    __device__ __forceinline__ void a_ready(const Unit&) const {}
    __device__ __forceinline__ void done(const Unit&) const {}
};

__device__ __forceinline__ int fresh_lane() { int lane; asm volatile("v_mbcnt_lo_u32_b32 %0, -1, 0\n\tv_mbcnt_hi_u32_b32 %0, -1, %0" : "=v"(lane)); return lane; }
typedef float f32x2p __attribute__((ext_vector_type(2)));
typedef __bf16 bf16x2p __attribute__((ext_vector_type(2)));
__device__ __forceinline__ unsigned cvt_pk_bf16(float lo, float hi) { const f32x2p f = {lo, hi}; const bf16x2p b = __builtin_convertvector(f, bf16x2p); return __builtin_bit_cast(unsigned, b); }
__device__ __forceinline__ float bflo(unsigned w) { return __uint_as_float(w << 16); }
__device__ __forceinline__ float bfhi(unsigned w) { return __uint_as_float(w & 0xffff0000u); }
__device__ __forceinline__ float sigmoidf_(float x) { return __builtin_amdgcn_rcpf(1.0f + __expf(-x)); }

__device__ __forceinline__ void ssq_put(float* ssq, int row, int slot, float part, int lane_) {
    part += __int_as_float(__builtin_amdgcn_ds_bpermute((lane_ ^ 16) << 2, __float_as_int(part)));
    part += __int_as_float(__builtin_amdgcn_ds_bpermute((lane_ ^ 32) << 2, __float_as_int(part)));
    if (lane_ < 16) ssq[(size_t)row * 16 + slot] = part;
}
__device__ __forceinline__ float ssq_rs(const float* ssq, int row) {
    const f32x4* p = (const f32x4*)(ssq + (size_t)row * 16); const f32x4 a = p[0], b = p[1], c = p[2], d = p[3];
    const float t = (((a[0] + a[1]) + (a[2] + a[3])) + ((b[0] + b[1]) + (b[2] + b[3]))) + (((c[0] + c[1]) + (c[2] + c[3])) + ((d[0] + d[1]) + (d[2] + d[3])));
    return __builtin_amdgcn_rsqf(t * (1.0f / 1024.0f) + 1e-6f);
}
__device__ __forceinline__ float ssq_ms(const float* ssq, int row) {
    const f32x4* p = (const f32x4*)(ssq + (size_t)row * 16); const f32x4 a = p[0], b = p[1], c = p[2], d = p[3];
    const float t = (((a[0] + a[1]) + (a[2] + a[3])) + ((b[0] + b[1]) + (b[2] + b[3]))) + (((c[0] + c[1]) + (c[2] + c[3])) + ((d[0] + d[1]) + (d[2] + d[3])));
    return t * (1.0f / 1024.0f) + 1e-6f;
}
struct EpiWin {
    static constexpr bool PERM = true, AFTER_DRAIN = false;
    bf16_t* O; int ldc; const float* ssq; int gate_pn; float* kmp; int kpn;
    __device__ __forceinline__ void operator()(const f32x4 (&acc)[2][2][4][2], const Unit& u, int wr, int wc, int, int) const {
        const int lane_ = fresh_lane(), fr = lane_ & 15, fq = lane_ >> 4;
        const int row0 = u.pm * BM + wr * 64 + fr, col0 = u.pn * BM + wc * 32 + 8 * fq; const bool gt = u.pn >= gate_pn;
        const bool km = (u.pn == kpn); float cs[2][8];
#pragma unroll
        for (int b_ = 0; b_ < 2; ++b_)
#pragma unroll
            for (int k_ = 0; k_ < 8; ++k_) cs[b_][k_] = 0.f;
#pragma unroll
        for (int ai = 0; ai < 2; ++ai)
#pragma unroll
            for (int m = 0; m < 4; ++m) { const int r = row0 + ai * HALF + m * 16; bf16_t* rowp = O + (size_t)r * ldc;
                const float rs = ssq ? ssq_rs(ssq, r) : 1.0f;
#pragma unroll
                for (int bj = 0; bj < 2; ++bj) { const f32x4 v0 = acc[ai][bj][m][0] * rs, v1 = acc[ai][bj][m][1] * rs;
                    if (km) { cs[bj][0] += v0[0]; cs[bj][1] += v0[1]; cs[bj][2] += v0[2]; cs[bj][3] += v0[3]; cs[bj][4] += v1[0]; cs[bj][5] += v1[1]; cs[bj][6] += v1[2]; cs[bj][7] += v1[3]; }
                    if (gt) { u32x2 w; { int t_ = 0; t_ = __builtin_amdgcn_cvt_pk_fp8_f32(v0[0], v0[1], t_, false); t_ = __builtin_amdgcn_cvt_pk_fp8_f32(v0[2], v0[3], t_, true); w.x = (unsigned)t_; }
                        { int t_ = 0; t_ = __builtin_amdgcn_cvt_pk_fp8_f32(v1[0], v1[1], t_, false); t_ = __builtin_amdgcn_cvt_pk_fp8_f32(v1[2], v1[3], t_, true); w.y = (unsigned)t_; }
                        *(u32x2*)((unsigned char*)rowp + 512 * gate_pn + (col0 - BM * gate_pn) + bj * HALF) = w; }
                    else { u32x4 w; w.x = cvt_pk_bf16(v0[0], v0[1]); w.y = cvt_pk_bf16(v0[2], v0[3]); w.z = cvt_pk_bf16(v1[0], v1[1]); w.w = cvt_pk_bf16(v1[2], v1[3]);
                        *(u32x4*)(rowp + col0 + bj * HALF) = w; } } }
        if (km) {
#pragma unroll
            for (int b_ = 0; b_ < 2; ++b_)
#pragma unroll
                for (int k_ = 0; k_ < 8; ++k_) { float x = cs[b_][k_];
#pragma unroll
                    for (int o_ = 1; o_ < 16; o_ <<= 1) x += __int_as_float(__builtin_amdgcn_ds_bpermute((lane_ ^ o_) << 2, __float_as_int(x)));
                    cs[b_][k_] = x; }
            if (fr == 0) { float* kp = kmp + ((size_t)u.pm * 2 + wr) * 256 + wc * 32 + 8 * fq;
#pragma unroll
                for (int b_ = 0; b_ < 2; ++b_) { *(f32x4*)(kp + b_ * HALF) = (f32x4){cs[b_][0], cs[b_][1], cs[b_][2], cs[b_][3]}; *(f32x4*)(kp + b_ * HALF + 4) = (f32x4){cs[b_][4], cs[b_][5], cs[b_][6], cs[b_][7]}; } }
        }
    }
};
struct EpiMerge {
    static constexpr bool PERM = true, AFTER_DRAIN = false;
    const bf16_t* U; int ldu, gcol0; bf16_t* O; int ldc; const PG8_LAS float* slut;
    __device__ __forceinline__ void operator()(const f32x4 (&acc)[2][2][4][2], const Unit& u, int wr, int wc, int, int) const {
        const int lane_ = fresh_lane(), fr = lane_ & 15, fq = lane_ >> 4;
        const int row0 = u.pm * BM + wr * 64 + fr, col0 = u.pn * BM + wc * 32 + 8 * fq;
        typedef float f32x2g __attribute__((ext_vector_type(2)));
        const __amdgpu_buffer_rsrc_t rsrc = __builtin_amdgcn_make_buffer_rsrc((void*)O, 0, 0x7fffffff, 0x00020000);
#pragma unroll
        for (int ai = 0; ai < 2; ++ai) {
            u32x2 gq[4][2]; u32x4 pq[4][2];
#pragma unroll
            for (int m = 0; m < 4; ++m) { const size_t r = (size_t)(row0 + ai * HALF + m * 16); const unsigned char* gp = (const unsigned char*)(U + r * ldu) + 2 * gcol0 + u.e * 1024 + col0; const bf16_t* rowp = O + r * ldc + col0;
#pragma unroll
                for (int bj = 0; bj < 2; ++bj) { gq[m][bj] = *(const u32x2*)(gp + bj * HALF); if (u.e != 0) pq[m][bj] = __builtin_bit_cast(u32x4, __builtin_amdgcn_raw_buffer_load_b128(rsrc, (int)((r * ldc + col0 + bj * HALF) * 2), 0, 16  )); else pq[m][bj] = (u32x4){0u, 0u, 0u, 0u}; } }
#pragma unroll
            for (int m = 0; m < 4; ++m) { const size_t r = (size_t)(row0 + ai * HALF + m * 16); bf16_t* rowp = O + r * ldc + col0;
#pragma unroll
                for (int bj = 0; bj < 2; ++bj) { const f32x4 a0 = acc[ai][bj][m][0], a1 = acc[ai][bj][m][1]; const u32x2 g = gq[m][bj]; const u32x4 p = pq[m][bj];
                    const float s0 = slut[g.x & 0xffu], s1 = slut[(g.x >> 8) & 0xffu], s2 = slut[(g.x >> 16) & 0xffu], s3 = slut[g.x >> 24], s4 = slut[g.y & 0xffu], s5 = slut[(g.y >> 8) & 0xffu], s6 = slut[(g.y >> 16) & 0xffu], s7 = slut[g.y >> 24];
                    const float v0 = a0[0] * s0 + bflo(p.x), v1 = a0[1] * s1 + bfhi(p.x), v2 = a0[2] * s2 + bflo(p.y), v3 = a0[3] * s3 + bfhi(p.y);
                    const float v4 = a1[0] * s4 + bflo(p.z), v5 = a1[1] * s5 + bfhi(p.z), v6 = a1[2] * s6 + bflo(p.w), v7 = a1[3] * s7 + bfhi(p.w);
                    u32x4 w; w.x = cvt_pk_bf16(v0, v1); w.y = cvt_pk_bf16(v2, v3); w.z = cvt_pk_bf16(v4, v5); w.w = cvt_pk_bf16(v6, v7);
                    *(u32x4*)(rowp + bj * HALF) = w; } }
        }
    }
};
struct EpiRes {
    static constexpr bool PERM = true, AFTER_DRAIN = false;
    const float* base; const bf16_t* bb; bf16_t* out; int ldc; float* ssq;
    __device__ __forceinline__ void operator()(const f32x4 (&acc)[2][2][4][2], const Unit& u, int wr, int wc, int, int) const {
        const int lane_ = fresh_lane(), fr = lane_ & 15, fq = lane_ >> 4;
        const int row0 = u.pm * BM + wr * 64 + fr, col0 = u.pn * BM + wc * 32 + 8 * fq;
        const __amdgpu_buffer_rsrc_t rsrc = __builtin_amdgcn_make_buffer_rsrc((void*)(bb ? bb : out), 0, 0x7fffffff, 0x00020000);
#pragma unroll
        for (int ai = 0; ai < 2; ++ai)
#pragma unroll
            for (int mh = 0; mh < 2; ++mh) {
                f32x4 b0[2][2], b1[2][2];
#pragma unroll
                for (int mm = 0; mm < 2; ++mm) { const size_t off = (size_t)(row0 + ai * HALF + (2 * mh + mm) * 16) * ldc + col0;
#pragma unroll
                    for (int bj = 0; bj < 2; ++bj) {
                        if (bb) { const u32x4 p = __builtin_bit_cast(u32x4, __builtin_amdgcn_raw_buffer_load_b128(rsrc, (int)((off + bj * HALF) * 2), 0, 16  )); b0[mm][bj] = (f32x4){bflo(p.x), bfhi(p.x), bflo(p.y), bfhi(p.y)}; b1[mm][bj] = (f32x4){bflo(p.z), bfhi(p.z), bflo(p.w), bfhi(p.w)}; }
                        else { b0[mm][bj] = *(const f32x4*)(base + off + bj * HALF); b1[mm][bj] = *(const f32x4*)(base + off + bj * HALF + 4); } } }
#pragma unroll
                for (int mm = 0; mm < 2; ++mm) { const int m = 2 * mh + mm; const size_t off = (size_t)(row0 + ai * HALF + m * 16) * ldc + col0; float sq = 0.f;
#pragma unroll
                    for (int bj = 0; bj < 2; ++bj) { const f32x4 v0 = acc[ai][bj][m][0] + b0[mm][bj], v1 = acc[ai][bj][m][1] + b1[mm][bj];
                        sq += (v0[0] * v0[0] + v0[1] * v0[1]) + (v0[2] * v0[2] + v0[3] * v0[3]) + (v1[0] * v1[0] + v1[1] * v1[1]) + (v1[2] * v1[2] + v1[3] * v1[3]);
                        u32x4 w; w.x = cvt_pk_bf16(v0[0], v0[1]); w.y = cvt_pk_bf16(v0[2], v0[3]); w.z = cvt_pk_bf16(v1[0], v1[1]); w.w = cvt_pk_bf16(v1[2], v1[3]);
                        *(u32x4*)(out + off + bj * HALF) = w; }
                    if (ssq) ssq_put(ssq, row0 + ai * HALF + m * 16, u.pn * 4 + wc, sq, lane_); }
            }
    }
};
struct EpiSwiGLU {
    static constexpr bool PERM = true, AFTER_DRAIN = false;
    bf16_t* T; int ldt; const float* ssq;
    __device__ __forceinline__ void operator()(const f32x4 (&acc)[2][2][4][2], const Unit& u, int wr, int wc, int, int) const {
        const int lane_ = fresh_lane(), fr = lane_ & 15, fq = lane_ >> 4;
        const int row0 = u.pm * BM + wr * 64 + fr, col0 = u.pn * HALF + wc * 32 + 8 * fq;
#pragma unroll
        for (int ai = 0; ai < 2; ++ai)
#pragma unroll
            for (int m = 0; m < 4; ++m) { const int r = row0 + ai * HALF + m * 16; bf16_t* rowp = T + (size_t)r * ldt + col0; float v[8];
                const float q = ssq ? ssq_ms(ssq, r) : 1.0f; const float nk = -1.44269504f * __builtin_amdgcn_rsqf(q);
                const f32x2p nk2 = {nk, nk}, q2 = {q, q};
#pragma unroll
                for (int n = 0; n < 2; ++n)
#pragma unroll
                    for (int h = 0; h < 2; ++h) { const f32x2p a2 = {acc[ai][0][m][n][2 * h], acc[ai][0][m][n][2 * h + 1]}, b2 = {acc[ai][1][m][n][2 * h], acc[ai][1][m][n][2 * h + 1]};
                        const f32x2p x2 = a2 * nk2; const f32x2p e2 = {__builtin_amdgcn_exp2f(x2[0]), __builtin_amdgcn_exp2f(x2[1])};
                        const f32x2p d2 = e2 * q2 + q2; const f32x2p r2 = {__builtin_amdgcn_rcpf(d2[0]), __builtin_amdgcn_rcpf(d2[1])};
                        const f32x2p v2 = (a2 * b2) * r2; v[n * 4 + 2 * h] = v2[0]; v[n * 4 + 2 * h + 1] = v2[1]; }
                u32x4 w; w.x = cvt_pk_bf16(v[0], v[1]); w.y = cvt_pk_bf16(v[2], v[3]); w.z = cvt_pk_bf16(v[4], v[5]); w.w = cvt_pk_bf16(v[6], v[7]);
                *(u32x4*)rowp = w; }
    }
};
__device__ __forceinline__ unsigned cvt4_fp8(float a, float b, float c, float d) { int w = 0; w = __builtin_amdgcn_cvt_pk_fp8_f32(a, b, w, false); w = __builtin_amdgcn_cvt_pk_fp8_f32(c, d, w, true); return (unsigned)w; }
struct EpiSwiGLU8 {
    static constexpr bool PERM = true, AFTER_DRAIN = false;
    unsigned char* T; int ldt; float cc, lc;
    __device__ __forceinline__ void operator()(const f32x4 (&acc)[2][2][4][2], const Unit& u, int wr, int wc, int, int) const {
        const int lane_ = fresh_lane(), fr = lane_ & 15, fq = lane_ >> 4;
        const int row0 = u.prow * BM + wr * 64 + fr, col0 = u.pn * HALF + wc * 32 + 8 * fq;
#pragma unroll
        for (int ai = 0; ai < 2; ++ai)
#pragma unroll
            for (int m = 0; m < 4; ++m) { unsigned char* rowp = T + (size_t)(row0 + ai * HALF + m * 16) * ldt + col0; float v[8];
                const f32x2p nk2 = {-1.44269504f * 0.03125f, -1.44269504f * 0.03125f}, l2 = {lc, lc}, c2 = {cc, cc};
#pragma unroll
                for (int n = 0; n < 2; ++n)
#pragma unroll
                    for (int h = 0; h < 2; ++h) { const f32x2p a2 = {acc[ai][0][m][n][2 * h], acc[ai][0][m][n][2 * h + 1]}, b2 = {acc[ai][1][m][n][2 * h], acc[ai][1][m][n][2 * h + 1]};
                        const f32x2p x2 = a2 * nk2 + l2; const f32x2p e2 = {__builtin_amdgcn_exp2f(x2[0]), __builtin_amdgcn_exp2f(x2[1])};
                        const f32x2p d2 = e2 + c2; const f32x2p r2 = {__builtin_amdgcn_rcpf(d2[0]), __builtin_amdgcn_rcpf(d2[1])};
                        const f32x2p v2 = (a2 * b2) * r2; v[n * 4 + 2 * h] = v2[0]; v[n * 4 + 2 * h + 1] = v2[1]; }
                u32x2 w; w.x = cvt4_fp8(v[0], v[1], v[2], v[3]); w.y = cvt4_fp8(v[4], v[5], v[6], v[7]);
                *(u32x2*)rowp = w; }
    }
};
struct EpiGate8 {
    static constexpr bool PERM = true, AFTER_DRAIN = false;
    unsigned char* O; int ldo, goff; const float* ssq;
    __device__ __forceinline__ void operator()(const f32x4 (&acc)[2][2][4][2], const Unit& u, int wr, int wc, int, int) const {
        const int lane_ = fresh_lane(), fr = lane_ & 15, fq = lane_ >> 4;
        const int row0 = u.pm * BM + wr * 64 + fr, col0 = u.pn * BM + wc * 32 + 8 * fq;
#pragma unroll
        for (int ai = 0; ai < 2; ++ai)
#pragma unroll
            for (int m = 0; m < 4; ++m) { const int r = row0 + ai * HALF + m * 16; unsigned char* rowp = O + (size_t)r * ldo + goff + col0;
                const float rs = (ssq ? ssq_rs(ssq, r) : 1.0f) * 0.03125f;
#pragma unroll
                for (int bj = 0; bj < 2; ++bj) { const f32x4 v0 = acc[ai][bj][m][0] * rs, v1 = acc[ai][bj][m][1] * rs;
                    u32x2 w; w.x = cvt4_fp8(v0[0], v0[1], v0[2], v0[3]); w.y = cvt4_fp8(v1[0], v1[1], v1[2], v1[3]);
                    *(u32x2*)(rowp + bj * HALF) = w; } }
    }
};
struct EpiScatter {
    static constexpr bool PERM = true, AFTER_DRAIN = false;
    bf16_t* R; int ldc; const int* tok; const float* gate; float scale; float* ssq; unsigned char* r8; bf16_t* Z; int ldz;
    __device__ __forceinline__ void operator()(const f32x4 (&acc)[2][2][4][2], const Unit& u, int wr, int wc, int, int) const {
        const int lane_ = fresh_lane(), fr = lane_ & 15, fq = lane_ >> 4;
        const int row0 = u.prow * BM + wr * 64 + fr, col0 = u.pn * BM + wc * 32 + 8 * fq;
        if (Z) {
#pragma unroll
            for (int ai = 0; ai < 2; ++ai)
#pragma unroll
                for (int m = 0; m < 4; ++m) { const int r = row0 + ai * HALF + m * 16; const int t = tok[r]; const float g = gate[r] * scale;
                    if (t >= 0) { bf16_t* zp = Z + (size_t)t * ldz + u.second * 1024 + col0;
#pragma unroll
                        for (int bj = 0; bj < 2; ++bj) { const f32x4 a0 = acc[ai][bj][m][0] * g, a1 = acc[ai][bj][m][1] * g;
                            u32x4 w; w.x = cvt_pk_bf16(a0[0], a0[1]); w.y = cvt_pk_bf16(a0[2], a0[3]); w.z = cvt_pk_bf16(a1[0], a1[1]); w.w = cvt_pk_bf16(a1[2], a1[3]);
                            *(u32x4*)(zp + bj * HALF) = w; } } }
            return; }
        const __amdgpu_buffer_rsrc_t rsrc = __builtin_amdgcn_make_buffer_rsrc((void*)R, 0, 0x7fffffff, 0x00020000);
        int tk[2][4]; float gg[2][4];
#pragma unroll
        for (int ai = 0; ai < 2; ++ai)
#pragma unroll
            for (int m = 0; m < 4; ++m) { const int r = row0 + ai * HALF + m * 16; tk[ai][m] = tok ? tok[r] : r; gg[ai][m] = tok ? gate[r] * scale : scale; }
#pragma unroll
        for (int ai = 0; ai < 2; ++ai) {
            u32x4 pq[4][2];
#pragma unroll
            for (int m = 0; m < 4; ++m) { const int t = tk[ai][m] < 0 ? 0 : tk[ai][m]; const bf16_t* rp = R + (size_t)t * ldc + col0;
#pragma unroll
                for (int bj = 0; bj < 2; ++bj) pq[m][bj] = __builtin_bit_cast(u32x4, __builtin_amdgcn_raw_buffer_load_b128(rsrc, (int)(((size_t)t * ldc + col0 + bj * HALF) * 2), 0, 16  )); (void)rp; }
#pragma unroll
            for (int m = 0; m < 4; ++m) { const int t = tk[ai][m]; const float g = gg[ai][m];
                if (t >= 0) { bf16_t* rp = R + (size_t)t * ldc + col0; float sq = 0.f;
#pragma unroll
                    for (int bj = 0; bj < 2; ++bj) { const u32x4 p = pq[m][bj]; const f32x4 a0 = acc[ai][bj][m][0] * g, a1 = acc[ai][bj][m][1] * g;
                        const float e0 = bflo(p.x) + a0[0], e1 = bfhi(p.x) + a0[1], e2 = bflo(p.y) + a0[2], e3 = bfhi(p.y) + a0[3], e4 = bflo(p.z) + a1[0], e5 = bfhi(p.z) + a1[1], e6 = bflo(p.w) + a1[2], e7 = bfhi(p.w) + a1[3];
                        sq += (e0 * e0 + e1 * e1) + (e2 * e2 + e3 * e3) + (e4 * e4 + e5 * e5) + (e6 * e6 + e7 * e7);
                        u32x4 w; w.x = cvt_pk_bf16(e0, e1); w.y = cvt_pk_bf16(e2, e3); w.z = cvt_pk_bf16(e4, e5); w.w = cvt_pk_bf16(e6, e7);
                        *(u32x4*)(rp + bj * HALF) = w;
                        if (r8) { u32x2 w8; w8.x = cvt4_fp8(e0, e1, e2, e3); w8.y = cvt4_fp8(e4, e5, e6, e7); *(u32x2*)(r8 + (size_t)t * 1024 + col0 + bj * HALF) = w8; } }
                    if (ssq) ssq_put(ssq, row0 + ai * HALF + m * 16, u.pn * 4 + wc, sq, lane_); } }
        }
    }
};

template <class Epi, class Sched, bool ALIGN_EPI = false, bool FP8 = false>
__device__ __forceinline__ void gemm_phase(PG8_LAS unsigned char* lds, const int tid, const Gemm g, const Sched& S, const Epi& E) {
    const int wid = __builtin_amdgcn_readfirstlane(tid >> 6), lane = tid & 63, wr = wid >> 2, wc = wid & 3, fr = lane & 15, fq = lane >> 4;
    const int K = g.K, nt = K / BK;
    unsigned voffA, voffB;
    { int R, C; stage_rc(tid * 16, R, C); const int Rb = Epi::PERM ? ((R & ~31) + perm32(R & 31)) : R;
      voffA = (unsigned)(R * g.lda + C) * 2u; voffB = (unsigned)(Rb * g.ldb + C) * 2u; }
    const size_t rstepA = (size_t)64 * g.lda * 2, rstepB = (size_t)64 * g.ldb * 2;
    const size_t kstep = (size_t)(BK * 2);
    const size_t hstepA = (size_t)HALF * g.lda * 2, hstepB = (size_t)HALF * g.ldb * 2;
    const unsigned ldsw = (unsigned)wid * 1024u;
    const int aoff = lds_byte(wr * 64 + fr, fq * 8), boff = lds_byte(wc * 32 + fr, fq * 8);
#define PG8_SA(b, h) (((b) * 2 + (h)) * HTB)
#define PG8_SB(b, h) ((4 + (b) * 2 + (h)) * HTB)
#define PG8_STAGE(bufoff, gbase, voff) do { _Pragma("unroll") for (int _i = 0; _i < 2; ++_i) { const char* gb_ = (const char*)(gbase) + (size_t)_i * rstep##voff; asm volatile("" : "+s"(gb_));     \
        __builtin_amdgcn_global_load_lds((const unsigned*)(gb_ + (voff)), (PG8_LAS unsigned*)(lds + (bufoff) + ldsw + _i * 8192), 16, 0, 0); } } while (0)
#define rstepvoffA rstepA
#define rstepvoffB rstepB
#define PG8_LDA(dst, b, h) do { if constexpr (FP8) { _Pragma("unroll") for (int m = 0; m < 4; ++m) dst##8[m] = __builtin_shufflevector(*(const PG8_LAS i32x4*)(lds + PG8_SA(b, h) + aoff + m * 2048), *(const PG8_LAS i32x4*)(lds + PG8_SA(b, h) + aoff + m * 2048 + 1024), 0, 1, 2, 3, 4, 5, 6, 7); } \
        else { _Pragma("unroll") for (int m = 0; m < 4; ++m) _Pragma("unroll") for (int k = 0; k < 2; ++k) dst[m][k] = *(const PG8_LAS bf16x8*)(lds + PG8_SA(b, h) + aoff + m * 2048 + k * 1024); } } while (0)
#define PG8_LDB(dst, b, h) do { if constexpr (FP8) { _Pragma("unroll") for (int n = 0; n < 2; ++n) dst##8[n] = __builtin_shufflevector(*(const PG8_LAS i32x4*)(lds + PG8_SB(b, h) + boff + n * 2048), *(const PG8_LAS i32x4*)(lds + PG8_SB(b, h) + boff + n * 2048 + 1024), 0, 1, 2, 3, 4, 5, 6, 7); } \
        else { _Pragma("unroll") for (int n = 0; n < 2; ++n) _Pragma("unroll") for (int k = 0; k < 2; ++k) dst[n][k] = *(const PG8_LAS bf16x8*)(lds + PG8_SB(b, h) + boff + n * 2048 + k * 1024); } } while (0)
#define PG8_MMA(ai, bj, At, Bt) do { __builtin_amdgcn_s_setprio(1); \
        if constexpr (FP8) { _Pragma("unroll") for (int m = 0; m < 4; ++m) _Pragma("unroll") for (int n = 0; n < 2; ++n) \
            acc[ai][bj][m][n] = __builtin_amdgcn_mfma_scale_f32_16x16x128_f8f6f4(Bt##8[n], At##8[m], acc[ai][bj][m][n], 0, 0, 0, 0x7f7f7f7f, 0, 0x7f7f7f7f); } \
        else { _Pragma("unroll") for (int m = 0; m < 4; ++m) _Pragma("unroll") for (int n = 0; n < 2; ++n) _Pragma("unroll") for (int k = 0; k < 2; ++k) \
            acc[ai][bj][m][n] = __builtin_amdgcn_mfma_f32_16x16x32_bf16(Bt[n][k], At[m][k], acc[ai][bj][m][n], 0, 0, 0); } \
        __builtin_amdgcn_s_setprio(0); } while (0)
#define PG8_WAIT_V(n) asm volatile("s_waitcnt vmcnt(" #n ")" ::: "memory")
#define PG8_WAIT_L(n) asm volatile("s_waitcnt lgkmcnt(" #n ")" ::: "memory")
#define PG8_BAR __builtin_amdgcn_s_barrier()
#define PG8_SCHED __builtin_amdgcn_sched_barrier(0)
    Unit cur, nxt; int ui = 0;
    if (!S.next(0, cur)) return;
    f32x4 acc[2][2][4][2];
#pragma unroll
    for (int a = 0; a < 2; ++a)
#pragma unroll
        for (int b = 0; b < 2; ++b)
#pragma unroll
            for (int m = 0; m < 4; ++m)
#pragma unroll
                for (int n = 0; n < 2; ++n) acc[a][b][m][n] = (f32x4){0.f, 0.f, 0.f, 0.f};
    bf16x8 At[4][2], B0[2][2], B1[2][2]; i32x8 At8[4], B08[2], B18[2];
    const char* cA = (const char*)g.A + cur.aoff; const char* cB = (const char*)g.Bt + cur.boff;
    S.a_ready(cur);
    PG8_STAGE(PG8_SB(0, 0), cB, voffB); PG8_STAGE(PG8_SB(0, 1), cB + hstepB, voffB); PG8_STAGE(PG8_SA(0, 0), cA, voffA); PG8_STAGE(PG8_SA(0, 1), cA + hstepA, voffA);
    if (wr == 1) PG8_BAR;
    PG8_WAIT_V(2); PG8_BAR;
    PG8_STAGE(PG8_SB(1, 0), cB + kstep, voffB); PG8_STAGE(PG8_SA(1, 0), cA + kstep, voffA); PG8_STAGE(PG8_SB(1, 1), cB + hstepB + kstep, voffB);
    PG8_WAIT_V(6); PG8_BAR;
    for (;;) {
        const bool has_next = S.next(ui + 1, nxt);
        const char* nA = has_next ? (const char*)g.A + nxt.aoff : cA; const char* nB = has_next ? (const char*)g.Bt + nxt.boff : cB;
#pragma unroll 1
        for (int t = 0; t < nt; t += 2) {
            const bool last = (t == nt - 2);
            const char* a1 = cA + (size_t)(t + 1) * kstep;
            const char* a2 = last ? nA : cA + (size_t)(t + 2) * kstep; const char* b2 = last ? nB : cB + (size_t)(t + 2) * kstep;
            const char* a3 = a2 + kstep; const char* b3 = b2 + kstep;
            if (last && has_next) S.a_ready(nxt);
            PG8_LDB(B0, 0, 0); PG8_LDB(B1, 0, 1); PG8_SCHED; PG8_LDA(At, 0, 0); PG8_STAGE(PG8_SA(1, 1), a1 + hstepA, voffA);
            PG8_WAIT_V(8); PG8_WAIT_L(0); PG8_BAR; PG8_MMA(0, 0, At, B0); PG8_MMA(0, 1, At, B1); PG8_BAR; PG8_SCHED;
            PG8_LDA(At, 0, 1); PG8_STAGE(PG8_SB(0, 0), b2, voffB); PG8_STAGE(PG8_SB(0, 1), b2 + hstepB, voffB); PG8_STAGE(PG8_SA(0, 0), a2, voffA);
            PG8_WAIT_V(8); PG8_WAIT_L(0); PG8_BAR; PG8_MMA(1, 0, At, B0); PG8_MMA(1, 1, At, B1); PG8_BAR; PG8_SCHED;
            PG8_LDB(B0, 1, 0); PG8_LDB(B1, 1, 1); PG8_SCHED; PG8_LDA(At, 1, 0); PG8_STAGE(PG8_SA(0, 1), a2 + hstepA, voffA);
            PG8_WAIT_V(8); PG8_WAIT_L(0); PG8_BAR; PG8_MMA(0, 0, At, B0); PG8_MMA(0, 1, At, B1); PG8_BAR; PG8_SCHED;
            PG8_LDA(At, 1, 1); PG8_STAGE(PG8_SB(1, 0), b3, voffB); PG8_STAGE(PG8_SB(1, 1), b3 + hstepB, voffB); PG8_STAGE(PG8_SA(1, 0), a3, voffA);
            PG8_WAIT_V(8); PG8_WAIT_L(0); PG8_BAR; PG8_MMA(1, 0, At, B0); PG8_MMA(1, 1, At, B1); PG8_BAR; PG8_SCHED;
        }
        if constexpr (ALIGN_EPI) { if (wr == 0) PG8_BAR; }
        E(acc, cur, wr, wc, fr, fq); S.done(cur);
        if (!has_next) break;
#pragma unroll
        for (int a = 0; a < 2; ++a)
#pragma unroll
            for (int b = 0; b < 2; ++b)
#pragma unroll
                for (int m = 0; m < 4; ++m)
#pragma unroll
                    for (int n = 0; n < 2; ++n) acc[a][b][m][n] = (f32x4){0.f, 0.f, 0.f, 0.f};
        cur = nxt; cA = nA; cB = nB; ++ui;
        if constexpr (ALIGN_EPI) { if (wr == 1) PG8_BAR; }
    }
    PG8_WAIT_V(0);
    if constexpr (!ALIGN_EPI) { if (wr == 0) PG8_BAR; }
    PG8_BAR;
#undef PG8_SA
#undef PG8_SB
#undef PG8_STAGE
#undef rstepvoffA
#undef rstepvoffB
#undef PG8_LDA
#undef PG8_LDB
#undef PG8_MMA
#undef PG8_WAIT_V
#undef PG8_WAIT_L
#undef PG8_BAR
#undef PG8_SCHED
}
}

constexpr int NB = 32, SEQ = 2048, D = 1024, M = NB * SEQ;
constexpr int WIN = 6656, GCOL0 = 2560;
constexpr int UST = 4608;
constexpr int FF0 = 2816, FFE = 3584, NEXP = 8;
constexpr int HROWS = M / 2, HB = NB / 2;
constexpr int CAPROWS = M + NEXP * 256, CAPT = CAPROWS / 256;
constexpr float RMS_EPS = 1e-6f, SUBLN_EPS = 1e-5f;
constexpr int NWAVES = 8;
constexpr int C_QA = 0, C_KA = 256, C_VA = 512, C_XB = 768, C_BB = 1024, C_CB = 1280, C_PC = 1536, C_QD = 1792, C_KD = 2048, C_VD = 2304;

constexpr size_t MiB = 1u << 20;
constexpr size_t WS_CTL = 0, CTL_ZERO_BYTES = 1 * MiB;
constexpr size_t WS_ROUTE = 2 * MiB;
constexpr size_t WS_TOK = 4 * MiB;
constexpr size_t WS_GATE = 5 * MiB;
constexpr size_t WS_TILEE = 6 * MiB;
constexpr size_t WS_KMEAN = 7 * MiB;
constexpr size_t WS_WIN = 8 * MiB;
constexpr size_t WS_WG8 = 24 * MiB;
constexpr size_t WS_BP = 34 * MiB;
constexpr size_t WS_WOUT = 38 * MiB;
constexpr size_t WS_W13D = 42 * MiB;
constexpr size_t WS_W2D = 53 * MiB;
constexpr size_t WS_W13E = 60 * MiB;
constexpr size_t WS_W2E = 116 * MiB;
constexpr size_t WS_R = 144 * MiB;
constexpr size_t WS_H = 272 * MiB;
constexpr size_t WS_U = 400 * MiB;
constexpr size_t WS_A8 = 752 * MiB;
constexpr size_t WS_Y = 816 * MiB;
constexpr size_t WS_MG = 880 * MiB;
constexpr size_t WS_HPERM = 272 * MiB;
constexpr size_t WS_TE = 404 * MiB;
constexpr size_t WS_END = 952 * MiB;
static_assert(WS_W13E + (size_t)8 * 2 * FFE * D <= WS_W2E && WS_W2E + (size_t)8 * D * FFE <= WS_R && WS_U + (size_t)HROWS * UST * 2 <= WS_A8 && WS_A8 + (size_t)M * D <= WS_Y && WS_HPERM + 2 * (size_t)CAPROWS * D <= WS_TE && WS_TE + 2 * (size_t)CAPROWS * FFE <= WS_END - 8 * MiB && WS_U + (size_t)M * FF0 * 2 <= WS_A8 && WS_MG + (size_t)HROWS * D * 2 <= WS_END, "d_ws map");
constexpr int CW_BAR = 4096;
constexpr int CW_QUEUE = 16384;
constexpr int CW_CNT = 20480;
constexpr size_t SSQ0_OFF = 944 * MiB, SSQ1_OFF = 948 * MiB;

constexpr int RING_BYTES = 131072;
constexpr int LUT_OFF = RING_BYTES;
constexpr int LUT_N = 320, LUT_NEG = 96;
constexpr int SLUT_OFF = LUT_OFF + 8 * LUT_N * 4;
constexpr int LDSCTL_OFF = RING_BYTES + 12288, MISC_OFF = LDSCTL_OFF + 320;
constexpr int LDS_BYTES = 147456;

#define GAS __attribute__((address_space(1)))
#define LAS __attribute__((address_space(3)))
typedef unsigned short bf16;
typedef unsigned v4u __attribute__((ext_vector_type(4)));
typedef unsigned v2u __attribute__((ext_vector_type(2)));
typedef float f32x4 __attribute__((ext_vector_type(4)));
typedef GAS unsigned gu32;
#define RLX_AGENT __ATOMIC_RELAXED, __HIP_MEMORY_SCOPE_AGENT
#define LDS_WAIT() asm volatile("s_waitcnt lgkmcnt(0)" ::: "memory")
#define VM_WAIT() asm volatile("s_waitcnt vmcnt(0)" ::: "memory")
__device__ __forceinline__ unsigned f2bf(float f) { unsigned u = __builtin_bit_cast(unsigned, f); return (u + 0x7fffu + ((u >> 16) & 1u)) >> 16; }
__device__ __forceinline__ unsigned pk2(float lo, float hi) { return f2bf(lo) | (f2bf(hi) << 16); }
__device__ __forceinline__ float bflo(unsigned w) { return __uint_as_float(w << 16); }
__device__ __forceinline__ float bfhi(unsigned w) { return __uint_as_float(w & 0xffff0000u); }

#define XB_TMO      128
#define XB_XCNT(j)  (256  + 64 * (j))
#define XB_XSUB(j)  (1280 + 64 * (j))
#define XB_XGEN(j)  (2304 + 64 * (j))
#define XB_TOP      3328
#define XB_TOPGEN   3392
#define XCD_BAR_WORDS 3456
#define XB_SPIN_CAP (1u << 22)

__device__ __forceinline__ unsigned xb_ld(unsigned* p)              { return __hip_atomic_load(p, __ATOMIC_RELAXED, __HIP_MEMORY_SCOPE_AGENT); }
__device__ __forceinline__ unsigned xb_add(unsigned* p, unsigned v) { return __hip_atomic_fetch_add(p, v, __ATOMIC_RELAXED, __HIP_MEMORY_SCOPE_AGENT); }
__device__ __forceinline__ unsigned xb_xcc_id() { return (unsigned)__builtin_amdgcn_s_getreg((3 << 11) | 20) & 0xFu; }
#define XB_SPIN(cond, bar) do { unsigned _sp = 0; while (cond) { __builtin_amdgcn_s_sleep(1); \
    if ((++_sp & 255u) == 0u) { if (xb_ld(&(bar)[XB_TMO])) break; if (_sp > XB_SPIN_CAP) { atomicAdd(&(bar)[XB_TMO], 1u); break; } } } } while (0)

struct XcdBarrier { unsigned* bar; unsigned x; volatile LAS unsigned* st; };

__device__ __forceinline__ XcdBarrier xcd_barrier_post(unsigned* bar, volatile LAS unsigned* st) {
    XcdBarrier b; b.bar = bar; b.x = xb_xcc_id(); b.st = st;
    if (threadIdx.x == 0) (void)xb_add(&bar[XB_XCNT(b.x)], 1u);
    return b;
}
__device__ __forceinline__ void xcd_barrier_complete(unsigned* bar, unsigned x, unsigned& nloc, unsigned& nx) {
    const unsigned G = gridDim.x * gridDim.y * gridDim.z;
    unsigned sum, cnt, mine, sp = 0u;
    for (;;) {
        sum = 0u; cnt = 0u; mine = 0u;
#pragma unroll
        for (unsigned j = 0; j < 16; ++j) { const unsigned c = xb_ld(&bar[XB_XCNT(j)]); sum += c; cnt += (c > 0u) ? 1u : 0u; mine = (j == x) ? c : mine; }
        if (sum == G) break;
        __builtin_amdgcn_s_sleep(1);
        if ((++sp & 255u) == 0u) { if (xb_ld(&bar[XB_TMO])) break; if (sp > XB_SPIN_CAP) { atomicAdd(&bar[XB_TMO], 1u); break; } }
    }
    nloc = mine > 0u ? mine : 1u; nx = cnt > 0u ? cnt : 1u;
}
__device__ __forceinline__ void xcd_barrier(const XcdBarrier& b) {
    asm volatile("s_waitcnt vmcnt(0)" ::: "memory");
    __syncthreads();
    if (threadIdx.x == 0) {
        unsigned* bar = b.bar;
        __builtin_amdgcn_s_waitcnt(0);
        unsigned nloc = b.st[0], nx = b.st[1];
        if (nloc == 0u) { xcd_barrier_complete(bar, b.x, nloc, nx); b.st[0] = nloc; b.st[1] = nx; }
        const unsigned old = xb_add(&bar[XB_XSUB(b.x)], 1u);
        const unsigned gen = old / nloc;
        if (old + 1u == (gen + 1u) * nloc) {
            __builtin_amdgcn_fence(__ATOMIC_RELEASE, "agent");
            asm volatile("s_waitcnt vmcnt(0)" ::: "memory");
            const unsigned og = xb_add(&bar[XB_TOP], 1u);
            const unsigned tg = og / nx;
            if (og + 1u == (tg + 1u) * nx) xb_add(&bar[XB_TOPGEN], 1u);
            else XB_SPIN(xb_ld(&bar[XB_TOPGEN]) == tg, bar);
            __builtin_amdgcn_fence(__ATOMIC_ACQUIRE, "agent");
            xb_add(&bar[XB_XGEN(b.x)], 1u);
            asm volatile("s_waitcnt vmcnt(0)" ::: "memory");
        } else {
            XB_SPIN(xb_ld(&bar[XB_XGEN(b.x)]) == gen, bar);
            __builtin_amdgcn_fence(__ATOMIC_ACQUIRE, "agent");
            asm volatile("s_waitcnt vmcnt(0)" ::: "memory");
        }
    }
    __syncthreads();
}

__device__ __forceinline__ float wave_sum(float v, int lane) {
#pragma unroll
    for (int o = 1; o < 64; o <<= 1) v += __int_as_float(__builtin_amdgcn_ds_bpermute((lane ^ o) << 2, __float_as_int(v)));
    return v;
}
__device__ __forceinline__ void wave_sync() { asm volatile("s_waitcnt lgkmcnt(0)" ::: "memory"); __builtin_amdgcn_wave_barrier(); }

__device__ const unsigned char BKT[129] = {
    0, 1, 2, 3, 4, 5, 6, 7, 8, 9, 10, 11, 12, 13, 14, 15, 16, 16, 16, 17, 17, 18, 18, 18, 19, 19, 19, 20, 20, 20, 20, 21, 21, 21, 21, 22, 22, 22, 22, 22, 23, 23, 23, 23, 23, 23,
    24, 24, 24, 24, 24, 24, 25, 25, 25, 25, 25, 25, 25, 26, 26, 26, 26, 26, 26, 26, 26, 27, 27, 27, 27, 27, 27, 27, 27, 27, 27, 28, 28, 28, 28, 28, 28, 28, 28, 28, 28,
    29, 29, 29, 29, 29, 29, 29, 29, 29, 29, 29, 29, 30, 30, 30, 30, 30, 30, 30, 30, 30, 30, 30, 30, 30, 30, 31, 31, 31, 31, 31, 31, 31, 31, 31, 31, 31, 31, 31, 31, 31, 31 };

__device__ __forceinline__ void transpose_item(const float* W, int K, int N, bf16* WT, int row_off, int il, LAS float* scr, int item, int lane, const float* gk = nullptr, int ldw = 0) {
    if (ldw == 0) ldw = N;
    const int nblk = N / 32, kb = item / nblk, nb = item % nblk, k0 = 64 * kb, n0 = 32 * nb;
#pragma unroll 8
    for (int i = 0; i < 32; ++i) { const int kk = 2 * i + (lane >> 5); scr[kk * 33 + (lane & 31)] = __builtin_nontemporal_load(W + (size_t)(k0 + kk) * ldw + n0 + (lane & 31)) * (gk ? gk[k0 + kk] : 1.0f); }
    LDS_WAIT(); asm volatile("" ::: "memory"); __builtin_amdgcn_wave_barrier();
    const int c = lane & 7;
    const int r0 = il ? ((n0 >> 7) * 256 + row_off + (n0 & 127)) : (row_off + n0);
#pragma unroll
    for (int j = 0; j < 4; ++j) { const int n = (lane >> 3) + 8 * j; const LAS float* s = scr + (8 * c) * 33 + n;
        v4u o; o.x = pk2(s[0 * 33], s[1 * 33]); o.y = pk2(s[2 * 33], s[3 * 33]); o.z = pk2(s[4 * 33], s[5 * 33]); o.w = pk2(s[6 * 33], s[7 * 33]);
        *(GAS v4u*)(WT + (size_t)(r0 + n) * K + k0 + 8 * c) = o; }
    LDS_WAIT(); asm volatile("" ::: "memory"); __builtin_amdgcn_wave_barrier();
}


__device__ __forceinline__ int fresh_tid_w(int wave) { int lane; asm volatile("v_mbcnt_lo_u32_b32 %0, -1, 0\n\tv_mbcnt_hi_u32_b32 %0, -1, %0" : "=v"(lane)); return wave * 64 + lane; }
#define fresh_tid() fresh_tid_w(wave0)

__device__ __forceinline__ unsigned moba_mask(const bf16* u, const float* kmean, int bl, int h, int qc, int lane) {
    const int t = qc * 32 + (lane & 31), own = qc >> 3;
    if (own <= 3) return (1u << own) - 1u;
    const bf16* qp = u + ((size_t)bl * SEQ + t) * UST + C_QA + h * 64;
    float gs[7];
#pragma unroll
    for (int blk = 0; blk < 7; ++blk) gs[blk] = 0.f;
#pragma unroll 1
    for (int i = 0; i < 8; ++i) { const v4u x = *(const GAS v4u*)(qp + 8 * i);
        const float qv[8] = {bflo(x.x), bfhi(x.x), bflo(x.y), bfhi(x.y), bflo(x.z), bfhi(x.z), bflo(x.w), bfhi(x.w)};
#pragma unroll
        for (int blk = 0; blk < 7; ++blk) { const float* km = kmean + ((size_t)(bl * 8 + blk)) * 512 + h * 64 + 8 * i;
#pragma unroll
            for (int k = 0; k < 8; ++k) gs[blk] += qv[k] * (km[k] + km[256 + k]); } }
    unsigned mask = 0u;
#pragma unroll
    for (int k = 0; k < 3; ++k) { float bv = -3.3e38f; int best = 0;
#pragma unroll
        for (int blk = 0; blk < 7; ++blk) { const bool ok = (blk < own) && (((mask >> blk) & 1u) == 0u); if (ok && gs[blk] > bv) { bv = gs[blk]; best = blk; } }
        mask |= 1u << best; }
    return mask;
}

typedef short bf16x8v __attribute__((ext_vector_type(8)));
typedef float f32x16 __attribute__((ext_vector_type(16)));
constexpr int AT_KP = 144, AT_VP = 136, AT_KB = 64 * AT_KP, AT_BUF = AT_KB + 64 * AT_VP;

typedef float f32x2c __attribute__((ext_vector_type(2)));
typedef __bf16 bf16x2c __attribute__((ext_vector_type(2)));
__device__ __forceinline__ unsigned pk2c(float lo, float hi) { const f32x2c f = {lo, hi}; const bf16x2c b = __builtin_convertvector(f, bf16x2c); return __builtin_bit_cast(unsigned, b); }

__device__ __forceinline__ void softmax_step(f32x16 (&e)[2], float& m, float& l, f32x16 (&o)[2], bf16x8v (&pb)[2][2], bool first, int xaddr) {
    float pm = -1.0e30f;
#pragma unroll
    for (int st = 0; st < 2; ++st)
#pragma unroll
        for (int i = 0; i < 16; ++i) pm = fmaxf(pm, e[st][i]);
    pm = fmaxf(pm, __int_as_float(__builtin_amdgcn_ds_bpermute(xaddr, __float_as_int(pm))));
    if (first || __ballot(pm > 8.0f) != 0ull) {
        const float delta = first ? pm : fmaxf(pm, 0.f);
        const float f = __builtin_amdgcn_exp2f(-delta);
        m += delta; l *= f;
#pragma unroll
        for (int mb = 0; mb < 2; ++mb)
#pragma unroll
            for (int i = 0; i < 16; ++i) o[mb][i] *= f;
#pragma unroll
        for (int st = 0; st < 2; ++st)
#pragma unroll
            for (int i = 0; i < 16; ++i) e[st][i] -= delta;
    }
#pragma unroll
    for (int st = 0; st < 2; ++st)
#pragma unroll
        for (int sp = 0; sp < 2; ++sp) { float pv[8];
#pragma unroll
            for (int j = 0; j < 8; ++j) { pv[j] = __builtin_amdgcn_exp2f(e[st][8 * sp + j]); l += pv[j]; }
            union { v4u u; bf16x8v b; } cv; cv.u.x = pk2c(pv[0], pv[1]); cv.u.y = pk2c(pv[2], pv[3]); cv.u.z = pk2c(pv[4], pv[5]); cv.u.w = pk2c(pv[6], pv[7]); pb[st][sp] = cv.b; }
}

template <bool DIFF>
__device__ __forceinline__ void attn_unit(const bf16* U, const float* kmean, bf16* Y, const LAS float* lut, LAS unsigned char* lds, int bl, int h, int qb, const int wave0, float lam, float outscale, const float* subg) {
    const int tid = fresh_tid(), lane = tid & 63, w = wave0, c = lane & 31, hh = lane >> 5;
    const int qcol = (DIFF ? C_QD : C_QA) + h * 64, kcol = (DIFF ? C_KD : C_KA) + h * 64, vcol = (DIFF ? C_VD : C_VA) + h * 64;
    const int q0w = qb * 256 + 32 * w, tq = q0w + c;
    const size_t qrow = (size_t)bl * SEQ + tq;
    bf16x8v qf[4];
#pragma unroll
    for (int s = 0; s < 4; ++s) qf[s] = *(const GAS bf16x8v*)(U + qrow * UST + qcol + 16 * s + 8 * hh);
    unsigned mask = 0xffu;
    if (!DIFF) mask = moba_mask(U, kmean, bl, h, qb * 8 + w, lane);
    const LAS float* lh = lut + (DIFF ? 4 + h : h) * LUT_N;
    const float cfar = lh[LUT_NEG + 128];
    const float qs2 = (DIFF ? 0.17677669529663687f : 0.125f) * 1.4426950408889634f;
    f32x16 o1[2], o2[2];
#pragma unroll
    for (int mb = 0; mb < 2; ++mb)
#pragma unroll
        for (int i = 0; i < 16; ++i) { o1[mb][i] = 0.f; o2[mb][i] = 0.f; }
    float m1 = 0.f, l1 = 0.f, m2 = 0.f, l2 = 0.f;
    const int ntiles = 4 * (qb + 1), my_last = qb * 4 + (w >> 1);
    const int xaddr = (lane ^ 32) << 2;
#define AT_KT(it) ((it) < 4 ? 4 * qb + (it) : (it) - 4)
    const bf16* kg = U + ((size_t)bl * SEQ + (tid >> 3)) * UST + kcol + 8 * (tid & 7);
    const bf16* vg = U + ((size_t)bl * SEQ + (tid & 63)) * UST + vcol + 8 * (tid >> 6);
    const int kst = (tid >> 3) * AT_KP + (tid & 7) * 16;
    const int vst = AT_KB + (8 * (tid >> 6)) * AT_VP + (tid & 63) * 2;
    v4u kreg = *(const GAS v4u*)(kg + (size_t)AT_KT(0) * 64 * UST), vreg = *(const GAS v4u*)(vg + (size_t)AT_KT(0) * 64 * UST);
#define AT_WRITE(bufb) do { LAS unsigned char* b_ = lds + (bufb) * AT_BUF; *(LAS v4u*)(b_ + kst) = kreg; \
        LAS unsigned short* v_ = (LAS unsigned short*)(b_ + vst); \
        v_[0 * (AT_VP / 2)] = (unsigned short)(vreg.x & 0xffffu); v_[1 * (AT_VP / 2)] = (unsigned short)(vreg.x >> 16); v_[2 * (AT_VP / 2)] = (unsigned short)(vreg.y & 0xffffu); v_[3 * (AT_VP / 2)] = (unsigned short)(vreg.y >> 16); \
        v_[4 * (AT_VP / 2)] = (unsigned short)(vreg.z & 0xffffu); v_[5 * (AT_VP / 2)] = (unsigned short)(vreg.z >> 16); v_[6 * (AT_VP / 2)] = (unsigned short)(vreg.w & 0xffffu); v_[7 * (AT_VP / 2)] = (unsigned short)(vreg.w >> 16); } while (0)
    AT_WRITE(0);
    __syncthreads();
    for (int it = 0; it < ntiles; ++it) {
        const bool more = (it + 1 < ntiles);
        if (more) { const int ktn = AT_KT(it + 1); kreg = *(const GAS v4u*)(kg + (size_t)ktn * 64 * UST); vreg = *(const GAS v4u*)(vg + (size_t)ktn * 64 * UST); }
        const int kt = AT_KT(it);
        const int blk = kt >> 2; const bool past = blk < qb;
        const bool lane_on = past ? (((mask >> blk) & 1u) != 0u) : true;
        if (kt <= my_last && (DIFF || !past || __ballot(lane_on) != 0ull)) {
            const LAS unsigned char* kb = lds + (it & 1) * AT_BUF; const LAS unsigned char* vb = kb + AT_KB;
            const int key0 = kt * 64;
            f32x16 s1[2], s2[2];
#pragma unroll
            for (int st = 0; st < 2; ++st) {
#pragma unroll
                for (int i = 0; i < 16; ++i) { s1[st][i] = 0.f; s2[st][i] = 0.f; }
#pragma unroll
                for (int s = 0; s < 4; ++s) { const bf16x8v a = *(const LAS bf16x8v*)(kb + (32 * st + c) * AT_KP + (16 * s + 8 * hh) * 2);
                    if (DIFF && s >= 2) s2[st] = __builtin_amdgcn_mfma_f32_32x32x16_bf16(a, qf[s], s2[st], 0, 0, 0);
                    else s1[st] = __builtin_amdgcn_mfma_f32_32x32x16_bf16(a, qf[s], s1[st], 0, 0, 0); }
            }
            const float off1 = lane_on ? -m1 : -1.0e30f, off2 = -m2;
            if (key0 + 63 + 128 <= q0w) {
                const float x1 = cfar + off1, x2 = cfar + off2;
#pragma unroll
                for (int st = 0; st < 2; ++st)
#pragma unroll
                    for (int i = 0; i < 16; ++i) { s1[st][i] = s1[st][i] * qs2 + x1; if (DIFF) s2[st][i] = s2[st][i] * qs2 + x2; }
            } else {
                const LAS float* lp = lh + (LUT_NEG + tq - key0 - 4 * hh);
#pragma unroll
                for (int st = 0; st < 2; ++st)
#pragma unroll
                    for (int i = 0; i < 16; ++i) { const float b = lp[-(32 * st + (i & 3) + 8 * (i >> 2))]; s1[st][i] = s1[st][i] * qs2 + (b + off1); if (DIFF) s2[st][i] = s2[st][i] * qs2 + (b + off2); }
            }
            bf16x8v p1[2][2], p2[2][2];
            softmax_step(s1, m1, l1, o1, p1, it == 0, xaddr);
            if (DIFF) softmax_step(s2, m2, l2, o2, p2, it == 0, xaddr);
#pragma unroll
            for (int mb = 0; mb < 2; ++mb)
#pragma unroll
                for (int s = 0; s < 4; ++s) { const LAS unsigned char* vr = vb + (32 * mb + c) * AT_VP + (16 * s + 4 * hh) * 2;
                    const v2u lo = *(const LAS v2u*)vr, hi = *(const LAS v2u*)(vr + 16);
                    union { v4u u; bf16x8v b; } cv; cv.u.x = lo.x; cv.u.y = lo.y; cv.u.z = hi.x; cv.u.w = hi.y;
                    o1[mb] = __builtin_amdgcn_mfma_f32_32x32x16_bf16(cv.b, p1[s >> 1][s & 1], o1[mb], 0, 0, 0);
                    if (DIFF) o2[mb] = __builtin_amdgcn_mfma_f32_32x32x16_bf16(cv.b, p2[s >> 1][s & 1], o2[mb], 0, 0, 0); }
        }
        if (more) AT_WRITE((it + 1) & 1);
        __syncthreads();
    }
#undef AT_WRITE
#undef AT_KT
    l1 += __int_as_float(__builtin_amdgcn_ds_bpermute(xaddr, __float_as_int(l1)));
    const float i1 = 1.0f / l1;
    bf16* yp = Y + qrow * 1024 + (DIFF ? 768 : 0) + h * 64;
    if (!DIFF) {
#pragma unroll
        for (int mb = 0; mb < 2; ++mb)
#pragma unroll
            for (int g = 0; g < 4; ++g) { v2u wv; wv.x = pk2c(o1[mb][4 * g] * i1, o1[mb][4 * g + 1] * i1); wv.y = pk2c(o1[mb][4 * g + 2] * i1, o1[mb][4 * g + 3] * i1);
                *(GAS v2u*)(yp + 32 * mb + 8 * g + 4 * hh) = wv; }
    } else {
        l2 += __int_as_float(__builtin_amdgcn_ds_bpermute(xaddr, __float_as_int(l2)));
        const float i2 = lam / l2; float ss = 0.f;
#pragma unroll
        for (int mb = 0; mb < 2; ++mb)
#pragma unroll
            for (int i = 0; i < 16; ++i) { const float v = o1[mb][i] * i1 - o2[mb][i] * i2; o1[mb][i] = v; ss += v * v; }
        ss += __int_as_float(__builtin_amdgcn_ds_bpermute(xaddr, __float_as_int(ss)));
        const float r = outscale / sqrtf(ss * (1.0f / 64.0f) + SUBLN_EPS);
#pragma unroll
        for (int mb = 0; mb < 2; ++mb)
#pragma unroll
            for (int g = 0; g < 4; ++g) { const int d = 32 * mb + 8 * g + 4 * hh; const f32x4 sg = *(const f32x4*)(subg + d);
                v2u wv; wv.x = pk2c(o1[mb][4 * g] * r * sg.x, o1[mb][4 * g + 1] * r * sg.y); wv.y = pk2c(o1[mb][4 * g + 2] * r * sg.z, o1[mb][4 * g + 3] * r * sg.w);
                *(GAS v2u*)(yp + d) = wv; }
    }
}

__device__ __forceinline__ unsigned cvt4_fp8g(float a, float b, float c, float d) { int w = 0; w = __builtin_amdgcn_cvt_pk_fp8_f32(a, b, w, false); w = __builtin_amdgcn_cvt_pk_fp8_f32(c, d, w, true); return (unsigned)w; }
__device__ __forceinline__ void transpose_item8(const float* W, int K, int N, unsigned char* WT, int row_off, int il, LAS float* scr, int item, int lane, const float* gk = nullptr, int ldw = 0) {
    if (ldw == 0) ldw = N;
    const int nblk = N / 32, kb = item / nblk, nb = item % nblk, k0 = 64 * kb, n0 = 32 * nb;
#pragma unroll 8
    for (int i = 0; i < 32; ++i) { const int kk = 2 * i + (lane >> 5); scr[kk * 33 + (lane & 31)] = __builtin_nontemporal_load(W + (size_t)(k0 + kk) * ldw + n0 + (lane & 31)) * (gk ? gk[k0 + kk] : 1.0f); }
    LDS_WAIT(); asm volatile("" ::: "memory"); __builtin_amdgcn_wave_barrier();
    const int c = lane & 7;
    const int r0 = il ? ((n0 >> 7) * 256 + row_off + (n0 & 127)) : (row_off + n0);
#pragma unroll
    for (int j = 0; j < 4; ++j) { const int n = (lane >> 3) + 8 * j; const LAS float* sp = scr + (8 * c) * 33 + n;
        v2u o; o.x = cvt4_fp8g(32.f * sp[0 * 33], 32.f * sp[1 * 33], 32.f * sp[2 * 33], 32.f * sp[3 * 33]); o.y = cvt4_fp8g(32.f * sp[4 * 33], 32.f * sp[5 * 33], 32.f * sp[6 * 33], 32.f * sp[7 * 33]);
        *(GAS v2u*)(WT + (size_t)(r0 + n) * K + k0 + 8 * c) = o; }
    LDS_WAIT(); asm volatile("" ::: "memory"); __builtin_amdgcn_wave_barrier();
}

struct Args {
    const float* in[20]; float* out; unsigned char* ws; int ph_lo, ph_hi, li, pad;
};
typedef const __attribute__((address_space(4))) Args CArgs;

__device__ __forceinline__ float row_rms_load(const float* xrow, const float* g, int lane, f32x4 (&v)[4]) {
    const GAS f32x4* xr = (const GAS f32x4*)xrow + lane; float s = 0.f;
#pragma unroll
    for (int j = 0; j < 4; ++j) { v[j] = __builtin_nontemporal_load(xr + 64 * j); s += (v[j].x * v[j].x + v[j].y * v[j].y) + (v[j].z * v[j].z + v[j].w * v[j].w); }
    const float r = 1.0f / sqrtf(wave_sum(s, lane) * (1.f / D) + RMS_EPS);
    const GAS f32x4* gr = (const GAS f32x4*)g + lane;
#pragma unroll
    for (int j = 0; j < 4; ++j) { const f32x4 gg = gr[64 * j]; v[j] = v[j] * r * gg; }
    return r;
}
__device__ __forceinline__ void row_store_bf16(bf16* orow, int lane, const f32x4 (&v)[4]) {
    GAS unsigned long long* o8 = (GAS unsigned long long*)orow + lane;
#pragma unroll
    for (int j = 0; j < 4; ++j) o8[64 * j] = (unsigned long long)pk2(v[j].x, v[j].y) | ((unsigned long long)pk2(v[j].z, v[j].w) << 32);
}

__device__ __forceinline__ float rowb_rms_load(const bf16* xrow, const float* g, int lane, float (&v)[16]) {
    float s = 0.f;
#pragma unroll
    for (int j = 0; j < 2; ++j) { const v4u x = *(const GAS v4u*)(xrow + 8 * lane + 512 * j);
        v[8 * j + 0] = bflo(x.x); v[8 * j + 1] = bfhi(x.x); v[8 * j + 2] = bflo(x.y); v[8 * j + 3] = bfhi(x.y); v[8 * j + 4] = bflo(x.z); v[8 * j + 5] = bfhi(x.z); v[8 * j + 6] = bflo(x.w); v[8 * j + 7] = bfhi(x.w); }
#pragma unroll
    for (int k = 0; k < 16; ++k) s += v[k] * v[k];
    const float r = 1.0f / sqrtf(wave_sum(s, lane) * (1.f / D) + RMS_EPS);
#pragma unroll
    for (int j = 0; j < 2; ++j) { const f32x4 g0 = *(const GAS f32x4*)(g + 8 * lane + 512 * j), g1 = *(const GAS f32x4*)(g + 8 * lane + 512 * j + 4);
        v[8 * j + 0] *= r * g0.x; v[8 * j + 1] *= r * g0.y; v[8 * j + 2] *= r * g0.z; v[8 * j + 3] *= r * g0.w; v[8 * j + 4] *= r * g1.x; v[8 * j + 5] *= r * g1.y; v[8 * j + 6] *= r * g1.z; v[8 * j + 7] *= r * g1.w; }
    return r;
}
__device__ __forceinline__ float rowb_rms_from(const v4u (&x)[2], const float* g, int lane, float (&v)[16]) {
    float s = 0.f;
#pragma unroll
    for (int j = 0; j < 2; ++j) { v[8 * j + 0] = bflo(x[j].x); v[8 * j + 1] = bfhi(x[j].x); v[8 * j + 2] = bflo(x[j].y); v[8 * j + 3] = bfhi(x[j].y); v[8 * j + 4] = bflo(x[j].z); v[8 * j + 5] = bfhi(x[j].z); v[8 * j + 6] = bflo(x[j].w); v[8 * j + 7] = bfhi(x[j].w); }
#pragma unroll
    for (int k = 0; k < 16; ++k) s += v[k] * v[k];
    const float r = 1.0f / sqrtf(wave_sum(s, lane) * (1.f / D) + RMS_EPS);
#pragma unroll
    for (int j = 0; j < 2; ++j) { const f32x4 g0 = *(const GAS f32x4*)(g + 8 * lane + 512 * j), g1 = *(const GAS f32x4*)(g + 8 * lane + 512 * j + 4);
        v[8 * j + 0] *= r * g0.x; v[8 * j + 1] *= r * g0.y; v[8 * j + 2] *= r * g0.z; v[8 * j + 3] *= r * g0.w; v[8 * j + 4] *= r * g1.x; v[8 * j + 5] *= r * g1.y; v[8 * j + 6] *= r * g1.z; v[8 * j + 7] *= r * g1.w; }
    return r;
}
__device__ __forceinline__ void rowb_store_bf16(bf16* orow, int lane, const float (&v)[16]) {
#pragma unroll
    for (int j = 0; j < 2; ++j) { v4u w; w.x = pk2(v[8 * j], v[8 * j + 1]); w.y = pk2(v[8 * j + 2], v[8 * j + 3]); w.z = pk2(v[8 * j + 4], v[8 * j + 5]); w.w = pk2(v[8 * j + 6], v[8 * j + 7]);
        *(GAS v4u*)(orow + 8 * lane + 512 * j) = w; }
}
__device__ __forceinline__ void rowb_store_fp8(unsigned char* orow, int lane, const float (&v)[16]) {
#pragma unroll
    for (int j = 0; j < 2; ++j) { v2u w; w.x = cvt4_fp8g(v[8 * j], v[8 * j + 1], v[8 * j + 2], v[8 * j + 3]); w.y = cvt4_fp8g(v[8 * j + 4], v[8 * j + 5], v[8 * j + 6], v[8 * j + 7]);
        *(GAS v2u*)(orow + 8 * lane + 512 * j) = w; }
}
__device__ __forceinline__ void row_store_fp8(unsigned char* orow, int lane, const f32x4 (&v)[4]) {
    GAS unsigned* o4 = (GAS unsigned*)orow + lane;
#pragma unroll
    for (int j = 0; j < 4; ++j) o4[64 * j] = cvt4_fp8g(v[j].x, v[j].y, v[j].z, v[j].w);
}
__device__ __forceinline__ void ph_prologue(CArgs& args, LAS unsigned char* lds, const int wave0) {
    const int tid = fresh_tid(), lane = tid & 63, wave = __builtin_amdgcn_readfirstlane(tid >> 6), gw = blockIdx.x * NWAVES + wave, NGW = gridDim.x * NWAVES;
    unsigned char* ws = args.ws;
    LAS float* scr = (LAS float*)(lds + wave * 16384);
    constexpr int I_WIN = 16 * (GCOL0 / 32), I_WG = 16 * ((WIN - GCOL0) / 32), I_BP = 4 * 32, I_WO = 16 * 32, I_D1 = 16 * (FF0 / 32), I_D2 = (FF0 / 64) * 32, I_E1 = 16 * (FFE / 32), I_E2 = (FFE / 64) * 32;
    constexpr int NIT = 2 * I_WIN + 2 * I_WG + 8 * I_BP + 2 * I_WO + 2 * I_D1 + I_D2 + 16 * I_E1 + 8 * I_E2;
    for (int it = gw; it < NIT; it += NGW) {
        int r = it;
        if (r < 2 * I_WIN) { const int l = r / I_WIN; transpose_item(args.in[3] + (size_t)l * D * WIN, D, GCOL0, (bf16*)(ws + WS_WIN) + (size_t)l * GCOL0 * D, 0, 0, scr, r % I_WIN, lane, l ? args.in[2] + D : nullptr, WIN); continue; } r -= 2 * I_WIN;
        if (r < 2 * I_WG) { const int l = r / I_WG; transpose_item8(args.in[3] + (size_t)l * D * WIN + GCOL0, D, WIN - GCOL0, ws + WS_WG8 + (size_t)l * (WIN - GCOL0) * D, 0, 0, scr, r % I_WG, lane, l ? args.in[2] + D : nullptr, WIN); continue; } r -= 2 * I_WG;
        if (r < 8 * I_BP) { const int q = r / I_BP;
            if ((q & 3) != 2) { transpose_item(args.in[9] + (size_t)q * 256 * D, 256, D, (bf16*)(ws + WS_BP) + (size_t)q * D * 256, 0, 0, scr, r % I_BP, lane); continue; }
            const int it2 = r % I_BP; if (it2 < 64) { const int l = q >> 2, g = it2 >> 4, n = (it2 & 15) * 64 + lane;
                const float* pw = args.in[5] + ((size_t)l * 4 + g) * 64 * 64; const float* psc = args.in[6] + (size_t)l * 256 + g * 64; const float* b2 = args.in[9] + ((size_t)q * 256 + g * 64) * D + n;
                bf16* dst = (bf16*)(ws + WS_BP) + (size_t)q * D * 256 + (size_t)n * 256 + g * 64;
#pragma unroll 1
                for (int ch = 0; ch < 4; ++ch) {
                    float accw[16];
#pragma unroll
                    for (int c = 0; c < 16; ++c) accw[c] = 0.f;
#pragma unroll 4
                    for (int d = 0; d < 64; ++d) { const float bv = b2[(size_t)d * D] * psc[d];
#pragma unroll
                        for (int c = 0; c < 16; ++c) accw[c] += pw[(ch * 16 + c) * 64 + d] * bv; }
#pragma unroll
                    for (int c8 = 0; c8 < 2; ++c8) { v4u w; w.x = pk2(accw[8 * c8], accw[8 * c8 + 1]); w.y = pk2(accw[8 * c8 + 2], accw[8 * c8 + 3]); w.z = pk2(accw[8 * c8 + 4], accw[8 * c8 + 5]); w.w = pk2(accw[8 * c8 + 6], accw[8 * c8 + 7]);
                        *(GAS v4u*)(dst + ch * 16 + 8 * c8) = w; } } }
            continue; } r -= 8 * I_BP;
        if (r < 2 * I_WO) { const int l = r / I_WO; transpose_item(args.in[10] + (size_t)l * D * D, D, D, (bf16*)(ws + WS_WOUT) + (size_t)l * D * D, 0, 0, scr, r % I_WO, lane); continue; } r -= 2 * I_WO;
        if (r < I_D1) { transpose_item(args.in[12], D, FF0, (bf16*)(ws + WS_W13D), 0, 1, scr, r, lane, args.in[11]); continue; } r -= I_D1;
        if (r < I_D1) { transpose_item(args.in[13], D, FF0, (bf16*)(ws + WS_W13D), 128, 1, scr, r, lane, args.in[11]); continue; } r -= I_D1;
        if (r < I_D2) { transpose_item(args.in[14], FF0, D, (bf16*)(ws + WS_W2D), 0, 0, scr, r, lane); continue; } r -= I_D2;
        if (r < 8 * I_E1) { const int e = r / I_E1; transpose_item8(args.in[16] + (size_t)e * D * FFE, D, FFE, ws + WS_W13E + (size_t)e * 2 * FFE * D, 0, 1, scr, r % I_E1, lane); continue; } r -= 8 * I_E1;
        if (r < 8 * I_E1) { const int e = r / I_E1; transpose_item8(args.in[17] + (size_t)e * D * FFE, D, FFE, ws + WS_W13E + (size_t)e * 2 * FFE * D, 128, 1, scr, r % I_E1, lane); continue; } r -= 8 * I_E1;
        { const int e = r / I_E2; transpose_item8(args.in[18] + (size_t)e * FFE * D, FFE, D, ws + WS_W2E + (size_t)e * D * FFE, 0, 0, scr, r % I_E2, lane); }
    }
}

__device__ __forceinline__ void ph_norm_rb(const bf16* src, const float* g, bf16* dst, const int wave0) {
    const int tid = fresh_tid(), lane = tid & 63, wave = __builtin_amdgcn_readfirstlane(tid >> 6), gw = blockIdx.x * NWAVES + wave, NGW = gridDim.x * NWAVES;
    for (int m = gw; m < M; m += NGW) { float v[16]; (void)rowb_rms_load(src + (size_t)m * D, g, lane, v); rowb_store_bf16(dst + (size_t)m * D, lane, v); }
}
__device__ __forceinline__ void ph_norm_bf16(const float* src, const float* g, bf16* dst, unsigned char* dst8, const int wave0) {
    const int tid = fresh_tid(), lane = tid & 63, wave = __builtin_amdgcn_readfirstlane(tid >> 6), gw = blockIdx.x * NWAVES + wave, NGW = gridDim.x * NWAVES;
    for (int m = gw; m < M; m += NGW) { f32x4 v[4]; (void)row_rms_load(src + (size_t)m * D, g, lane, v); row_store_bf16(dst + (size_t)m * D, lane, v); row_store_fp8(dst8 + (size_t)m * D, lane, v); }
}
__device__ __forceinline__ void ph_final_norm(const bf16* R, const float* g, float* out, const int wave0) {
    const int tid = fresh_tid(), lane = tid & 63, wave = __builtin_amdgcn_readfirstlane(tid >> 6), gw = blockIdx.x * NWAVES + wave, NGW = gridDim.x * NWAVES;
    f32x4 gg[4];
#pragma unroll
    for (int j = 0; j < 2; ++j) { gg[2 * j] = *(const GAS f32x4*)(g + 8 * lane + 512 * j); gg[2 * j + 1] = *(const GAS f32x4*)(g + 8 * lane + 512 * j + 4); }
    for (int m0 = gw; m0 < M; m0 += 2 * NGW) {
        v4u x[2][2], z[2][2], z0[2][2];
#pragma unroll
        for (int q = 0; q < 2; ++q)
#pragma unroll
            for (int j = 0; j < 2; ++j) { x[q][j] = *(const GAS v4u*)(R + (size_t)(m0 + q * NGW) * D + 8 * lane + 512 * j);
                z[q][j] = *(const GAS v4u*)((const bf16*)(out + (size_t)(m0 + q * NGW) * D + 512) + 8 * lane + 512 * j);
                z0[q][j] = *(const GAS v4u*)((const bf16*)(out + (size_t)(m0 + q * NGW) * D) + 8 * lane + 512 * j); }
#pragma unroll
        for (int q = 0; q < 2; ++q) { float v[16];
#pragma unroll
            for (int j = 0; j < 2; ++j) { const v4u w = x[q][j], y = z[q][j], y0 = z0[q][j];
                v[8 * j + 0] = bflo(w.x) + (bflo(y0.x) + bflo(y.x)); v[8 * j + 1] = bfhi(w.x) + (bfhi(y0.x) + bfhi(y.x)); v[8 * j + 2] = bflo(w.y) + (bflo(y0.y) + bflo(y.y)); v[8 * j + 3] = bfhi(w.y) + (bfhi(y0.y) + bfhi(y.y));
                v[8 * j + 4] = bflo(w.z) + (bflo(y0.z) + bflo(y.z)); v[8 * j + 5] = bfhi(w.z) + (bfhi(y0.z) + bfhi(y.z)); v[8 * j + 6] = bflo(w.w) + (bflo(y0.w) + bflo(y.w)); v[8 * j + 7] = bfhi(w.w) + (bfhi(y0.w) + bfhi(y.w)); }
            float s = 0.f;
#pragma unroll
            for (int k = 0; k < 16; ++k) s += v[k] * v[k];
            const float r = 1.0f / sqrtf(wave_sum(s, lane) * (1.f / D) + RMS_EPS);
            float* o = out + (size_t)(m0 + q * NGW) * D + 8 * lane;
#pragma unroll
            for (int j = 0; j < 2; ++j) { const f32x4 a = gg[2 * j], b = gg[2 * j + 1];
                *(GAS f32x4*)(o + 512 * j) = (f32x4){v[8 * j] * r * a.x, v[8 * j + 1] * r * a.y, v[8 * j + 2] * r * a.z, v[8 * j + 3] * r * a.w};
                *(GAS f32x4*)(o + 512 * j + 4) = (f32x4){v[8 * j + 4] * r * b.x, v[8 * j + 5] * r * b.y, v[8 * j + 6] * r * b.z, v[8 * j + 7] * r * b.w}; } }
    }
}

__device__ __forceinline__ void ph_kmean(const bf16* U, float* kmean, LAS unsigned char* lds, const int wave0) {
    const int tid = fresh_tid();
    LAS float* red = (LAS float*)lds;
    for (int task = blockIdx.x; task < HB * 8; task += gridDim.x) {
        const int bl = task >> 3, blk = task & 7, cg = tid & 31, rq = tid >> 5;
        const bf16* kp = U + ((size_t)bl * SEQ + blk * 256 + rq * 16) * UST + C_KA + 8 * cg;
        v4u x[16];
#pragma unroll
        for (int i = 0; i < 16; ++i) x[i] = *(const GAS v4u*)(kp + (size_t)i * UST);
        float sm[8];
#pragma unroll
        for (int k = 0; k < 8; ++k) sm[k] = 0.f;
#pragma unroll
        for (int i = 0; i < 16; ++i) { sm[0] += bflo(x[i].x); sm[1] += bfhi(x[i].x); sm[2] += bflo(x[i].y); sm[3] += bfhi(x[i].y); sm[4] += bflo(x[i].z); sm[5] += bfhi(x[i].z); sm[6] += bflo(x[i].w); sm[7] += bfhi(x[i].w); }
#pragma unroll
        for (int k = 0; k < 8; ++k) red[rq * 256 + 8 * cg + k] = sm[k];
        __syncthreads();
        if (tid < 256) { float t = 0.f;
#pragma unroll
            for (int q = 0; q < 16; ++q) t += red[q * 256 + tid];
            kmean[(size_t)task * 256 + tid] = t * (1.0f / 256.0f); }
        __syncthreads();
    }
}

__device__ __forceinline__ void ph_conv_pool(CArgs& args, int l, const bf16* U, bf16* Y, LAS unsigned char* lds, const int wave0) {
    const int tid = fresh_tid(), lane = tid & 63, wave = __builtin_amdgcn_readfirstlane(tid >> 6), gw = blockIdx.x * NWAVES + wave, NGW = gridDim.x * NWAVES;
    {
        const float* cw = args.in[4] + (size_t)l * 3 * 256; const int c0 = (lane & 31) * 8;
        float w0[8], w1[8], w2[8];
#pragma unroll
        for (int k = 0; k < 8; ++k) { w0[k] = cw[c0 + k]; w1[k] = cw[256 + c0 + k]; w2[k] = cw[512 + c0 + k]; }
        for (int ch = gw; ch < HROWS / 8; ch += NGW) {
            const int rl0 = ch * 8 + (lane >> 5) * 4, t = rl0 & (SEQ - 1);
            const bf16* up = U + (size_t)rl0 * UST; const int back = t > 0 ? 1 : 0; const float mb = t > 0 ? 1.f : 0.f;
            v4u xv[6], gv[6], bv[4];
#pragma unroll
            for (int k = 0; k < 6; ++k) { const long ro = (k < 2) ? (long)(k - 2) * back : (long)(k - 2); xv[k] = *(const GAS v4u*)(up + ro * UST + C_XB + c0); gv[k] = *(const GAS v4u*)(up + ro * UST + C_CB + c0); }
#pragma unroll
            for (int i = 0; i < 4; ++i) bv[i] = *(const GAS v4u*)(up + (size_t)i * UST + C_BB + c0);
            float uu[6][8];
#pragma unroll
            for (int k = 0; k < 6; ++k) { const float mk = (k < 2) ? mb : 1.f;
                uu[k][0] = mk * bflo(xv[k].x) * bflo(gv[k].x); uu[k][1] = mk * bfhi(xv[k].x) * bfhi(gv[k].x); uu[k][2] = mk * bflo(xv[k].y) * bflo(gv[k].y); uu[k][3] = mk * bfhi(xv[k].y) * bfhi(gv[k].y);
                uu[k][4] = mk * bflo(xv[k].z) * bflo(gv[k].z); uu[k][5] = mk * bfhi(xv[k].z) * bfhi(gv[k].z); uu[k][6] = mk * bflo(xv[k].w) * bflo(gv[k].w); uu[k][7] = mk * bfhi(xv[k].w) * bfhi(gv[k].w); }
#pragma unroll
            for (int i = 0; i < 4; ++i) { float cv[8];
#pragma unroll
                for (int k = 0; k < 8; ++k) cv[k] = w2[k] * uu[i + 2][k] + w1[k] * uu[i + 1][k] + w0[k] * uu[i][k];
                v4u w; w.x = pk2(cv[0] * bflo(bv[i].x), cv[1] * bfhi(bv[i].x)); w.y = pk2(cv[2] * bflo(bv[i].y), cv[3] * bfhi(bv[i].y)); w.z = pk2(cv[4] * bflo(bv[i].z), cv[5] * bfhi(bv[i].z)); w.w = pk2(cv[6] * bflo(bv[i].w), cv[7] * bfhi(bv[i].w));
                *(GAS v4u*)(Y + (size_t)(rl0 + i) * 1024 + 256 + c0) = w; }
        }
    }
    {
        const int gq = lane >> 4, c4 = (lane & 15) * 4, wlen = 2 << gq;
        for (int ch = gw; ch < HROWS / 8; ch += NGW) {
            const int rl0 = ch * 8, t0 = rl0 & (SEQ - 1); const bf16* pp = U + (size_t)rl0 * UST + C_PC + gq * 64 + c4;
            v2u xr[23];
#pragma unroll
            for (int i = 0; i < 23; ++i) { const int d = i - 15; const long ro = (t0 + d >= 0) ? (long)d : 0; xr[i] = *(const GAS v2u*)(pp + ro * UST); }
            float xf[23][4];
#pragma unroll
            for (int i = 0; i < 23; ++i) { const float mk = (t0 + i - 15 >= 0) ? 1.f : 0.f; xf[i][0] = mk * bflo(xr[i].x); xf[i][1] = mk * bfhi(xr[i].x); xf[i][2] = mk * bflo(xr[i].y); xf[i][3] = mk * bfhi(xr[i].y); }
#pragma unroll
            for (int tk = 0; tk < 8; ++tk) { float s0 = 0.f, s1 = 0.f, s2 = 0.f, s3 = 0.f;
#pragma unroll
                for (int j = 0; j < 16; ++j) { const float mk = j < wlen ? 1.f : 0.f; s0 += mk * xf[15 + tk - j][0]; s1 += mk * xf[15 + tk - j][1]; s2 += mk * xf[15 + tk - j][2]; s3 += mk * xf[15 + tk - j][3]; }
                const int t = t0 + tk; const int cnt = (t + 1) < wlen ? (t + 1) : wlen; const float ic = 1.0f / (float)cnt;
                v2u w; w.x = pk2(s0 * ic - xf[15 + tk][0], s1 * ic - xf[15 + tk][1]); w.y = pk2(s2 * ic - xf[15 + tk][2], s3 * ic - xf[15 + tk][3]);
                *(GAS v2u*)(Y + (size_t)(rl0 + tk) * 1024 + 512 + gq * 64 + c4) = w; }
        }
    }
    __syncthreads();
}

__device__ __forceinline__ void ph_attn(CArgs& args, int l, const bf16* U, const float* kmean, bf16* Y, LAS unsigned char* lds, const int wave0) {
    const float* dl = args.in[7] + (size_t)l * 128; const float* subg = args.in[8] + (size_t)l * 64;
    float a = 0.f, b = 0.f;
    for (int i = 0; i < 32; ++i) { a += dl[i] * dl[32 + i]; b += dl[64 + i] * dl[96 + i]; }
    int l_s = l; asm volatile("" : "+s"(l_s));
    const float lam_init = (l_s == 0) ? 0.2f : 0.35550906759096926f;
    const float lam = __expf(a) - __expf(b) + lam_init, outscale = 1.0f - lam_init;
    const LAS float* lut = (const LAS float*)(lds + LUT_OFF);
    for (int cu0 = blockIdx.x; cu0 < HB * 4 * 4; cu0 += gridDim.x) {
        const int cu = (gridDim.x == 256) ? ((cu0 & 7) * 32 + (cu0 >> 3)) : cu0;
        const int bh = cu >> 2, pr = cu & 3, bl = bh >> 2, h = bh & 3;
#pragma unroll 1
        for (int k = 0; k < 2; ++k) attn_unit<false>(U, kmean, Y, lut, lds, bl, h, k ? 7 - pr : pr, wave0, 0.f, 0.f, subg);
#pragma unroll 1
        for (int k = 0; k < 2; ++k) attn_unit<true>(U, kmean, Y, lut, lds, bl, h, k ? 7 - pr : pr, wave0, lam, outscale, subg);
    }
}

__device__ __forceinline__ void ph_route(CArgs& args, int l, const bf16* R, unsigned* route, int* tokp, gu32* ctl, LAS unsigned char* lds, const int wave0) {
    const int tid = fresh_tid(), lane = tid & 63, wave = __builtin_amdgcn_readfirstlane(tid >> 6), gw = blockIdx.x * NWAVES + wave, NGW = gridDim.x * NWAVES;
    const float* g = args.in[11] + (size_t)l * D;
    f32x4 rwa[16], rwb[16];
    { const float* rw = args.in[15];
#pragma unroll
      for (int j = 0; j < 2; ++j)
#pragma unroll
          for (int k = 0; k < 8; ++k) { const int c = 8 * lane + 512 * j + k; const float gc = g[c]; rwa[8 * j + k] = *(const GAS f32x4*)(rw + c * 8) * gc; rwb[8 * j + k] = *(const GAS f32x4*)(rw + c * 8 + 4) * gc; } }
    for (int i = blockIdx.x * NWAVES * 64 + tid; i < 2 * CAPROWS; i += gridDim.x * NWAVES * 64) tokp[i] = -1;
    __syncthreads();
    for (int m0 = gw; m0 < M; m0 += 4 * NGW) {
        v4u xr[4][2];
#pragma unroll
        for (int q = 0; q < 4; ++q)
#pragma unroll
            for (int j = 0; j < 2; ++j) xr[q][j] = *(const GAS v4u*)(R + (size_t)(m0 + q * NGW) * D + 8 * lane + 512 * j);
        int i0q[4], i1q[4]; float w0q[4], w1q[4], rq[4];
#pragma unroll
        for (int q = 0; q < 4; ++q) {
            float v[16], ss = 0.f;
#pragma unroll
            for (int j = 0; j < 2; ++j) { v[8 * j + 0] = bflo(xr[q][j].x); v[8 * j + 1] = bfhi(xr[q][j].x); v[8 * j + 2] = bflo(xr[q][j].y); v[8 * j + 3] = bfhi(xr[q][j].y); v[8 * j + 4] = bflo(xr[q][j].z); v[8 * j + 5] = bfhi(xr[q][j].z); v[8 * j + 6] = bflo(xr[q][j].w); v[8 * j + 7] = bfhi(xr[q][j].w); }
#pragma unroll
            for (int k = 0; k < 16; ++k) ss += v[k] * v[k];
            float lg[8];
#pragma unroll
            for (int e = 0; e < 8; ++e) lg[e] = 0.f;
#pragma unroll
            for (int j = 0; j < 2; ++j)
#pragma unroll
                for (int k = 0; k < 8; ++k) { const f32x4 ra = rwa[8 * j + k], rb = rwb[8 * j + k]; const float xv = v[8 * j + k];
                    lg[0] += xv * ra.x; lg[1] += xv * ra.y; lg[2] += xv * ra.z; lg[3] += xv * ra.w; lg[4] += xv * rb.x; lg[5] += xv * rb.y; lg[6] += xv * rb.z; lg[7] += xv * rb.w; }
#define RT_X(k_, val_) __int_as_float(__builtin_amdgcn_ds_bpermute((lane ^ (k_)) << 2, __float_as_int(val_)))
            { const bool b1 = (lane & 1) != 0, b2 = (lane & 2) != 0, b3 = (lane & 4) != 0;
              float a4[4], c2[2], d1;
#pragma unroll
              for (int i = 0; i < 4; ++i) { const float snd = b1 ? lg[i] : lg[4 + i], kp = b1 ? lg[4 + i] : lg[i]; a4[i] = kp + RT_X(1, snd); }
#pragma unroll
              for (int i = 0; i < 2; ++i) { const float snd = b2 ? a4[i] : a4[2 + i], kp = b2 ? a4[2 + i] : a4[i]; c2[i] = kp + RT_X(2, snd); }
              { const float snd = b3 ? c2[0] : c2[1], kp = b3 ? c2[1] : c2[0]; d1 = kp + RT_X(4, snd); }
              d1 += RT_X(8, d1); d1 += RT_X(16, d1); d1 += RT_X(32, d1);
              const float r = 1.0f / sqrtf(wave_sum(ss, lane) * (1.f / D) + RMS_EPS); rq[q] = r;
#pragma unroll
              for (int e = 0; e < 8; ++e) lg[e] = r * __int_as_float(__builtin_amdgcn_readlane(__float_as_int(d1), ((e >> 2) & 1) | (((e >> 1) & 1) << 1) | ((e & 1) << 2))); }
#undef RT_X
            int i0 = 0; float v0 = lg[0];
#pragma unroll
            for (int e = 1; e < 8; ++e) if (lg[e] > v0) { v0 = lg[e]; i0 = e; }
            int i1 = 0; float v1 = -3.0e38f;
#pragma unroll
            for (int e = 0; e < 8; ++e) if (e != i0 && lg[e] > v1) { v1 = lg[e]; i1 = e; }
            const float e1 = __expf(v1 - v0); w0q[q] = 1.0f / (1.0f + e1); w1q[q] = e1 * w0q[q]; i0q[q] = i0; i1q[q] = i1;
        }
        if (lane == 0) {
            unsigned s0[4], s1[4];
#pragma unroll
            for (int q = 0; q < 4; ++q) { s0[q] = atomicAdd((unsigned*)(ctl + CW_CNT + (0 * 8 + i0q[q]) * 64), 1u); s1[q] = atomicAdd((unsigned*)(ctl + CW_CNT + (1 * 8 + i1q[q]) * 64), 1u); }
#pragma unroll
            for (int q = 0; q < 4; ++q) { unsigned* rec = route + (size_t)(m0 + q * NGW) * 8; rec[0] = (unsigned)i0q[q] | ((unsigned)i1q[q] << 8); rec[1] = s0[q]; rec[2] = s1[q]; rec[3] = __float_as_uint(w0q[q]); rec[4] = __float_as_uint(w1q[q]); rec[5] = __float_as_uint(rq[q]); }
        }
    }
}

__device__ __forceinline__ void ph_gather(CArgs& args, int l, const bf16* R, const unsigned* route, int* tokp, float* gatep, int* tile_e, int* n_rt, unsigned char* hperm, gu32* ctl, LAS unsigned char* lds, const int wave0) {
    const int tid = fresh_tid(), lane = tid & 63, wave = __builtin_amdgcn_readfirstlane(tid >> 6), gw = blockIdx.x * NWAVES + wave, NGW = gridDim.x * NWAVES;
    const float* g = args.in[11] + (size_t)l * D;
    LAS int* base = (LAS int*)lds;
    if (tid < 2) { int acc = 0;
        for (int e = 0; e < 8; ++e) { base[tid * 8 + e] = acc; const int c = (int)__hip_atomic_load((unsigned*)(ctl + CW_CNT + (tid * 8 + e) * 64), RLX_AGENT); acc += (c + 255) & ~255; }
        base[16 + tid] = acc; }
    __syncthreads();
    if (blockIdx.x == 0 && tid < 2) { const int p = tid, nt = base[16 + p] >> 8; n_rt[p] = nt;
        for (int rt = 0; rt < nt; ++rt) { int e = 0; for (int k = 1; k < 8; ++k) if (rt * 256 >= base[p * 8 + k]) e = k; tile_e[p * 512 + rt] = e; } }
    for (int m0 = gw; m0 < M; m0 += 4 * NGW) {
        v4u xr[4][2]; unsigned ee[4], sl0[4], sl1[4], gw0[4], gw1[4], rs5[4];
#pragma unroll
        for (int q = 0; q < 4; ++q) { const size_t m = (size_t)(m0 + q * NGW);
#pragma unroll
            for (int j = 0; j < 2; ++j) xr[q][j] = *(const GAS v4u*)(R + m * D + 8 * lane + 512 * j);
            const unsigned* rec = route + m * 8; ee[q] = rec[0]; sl0[q] = rec[1]; sl1[q] = rec[2]; gw0[q] = rec[3]; gw1[q] = rec[4]; rs5[q] = rec[5]; }
#pragma unroll
        for (int q = 0; q < 4; ++q) { const int m = m0 + q * NGW;
            float v[16]; const float r = __uint_as_float(rs5[q]);
#pragma unroll
            for (int j = 0; j < 2; ++j) { const f32x4 g0 = *(const GAS f32x4*)(g + 8 * lane + 512 * j), g1 = *(const GAS f32x4*)(g + 8 * lane + 512 * j + 4); const v4u x = xr[q][j];
                v[8 * j + 0] = bflo(x.x) * (r * g0.x); v[8 * j + 1] = bfhi(x.x) * (r * g0.y); v[8 * j + 2] = bflo(x.y) * (r * g0.z); v[8 * j + 3] = bfhi(x.y) * (r * g0.w);
                v[8 * j + 4] = bflo(x.z) * (r * g1.x); v[8 * j + 5] = bfhi(x.z) * (r * g1.y); v[8 * j + 6] = bflo(x.w) * (r * g1.z); v[8 * j + 7] = bfhi(x.w) * (r * g1.w); }
            const int e0 = ee[q] & 255, e1 = (ee[q] >> 8) & 255;
            const int pos0 = base[e0] + (int)sl0[q], pos1 = base[8 + e1] + (int)sl1[q];
            rowb_store_fp8(hperm + (size_t)pos0 * D, lane, v); rowb_store_fp8(hperm + ((size_t)CAPROWS + pos1) * D, lane, v);
            if (lane == 0) { tokp[pos0] = m; tokp[CAPROWS + pos1] = m; gatep[pos0] = __uint_as_float(gw0[q]); gatep[CAPROWS + pos1] = __uint_as_float(gw1[q]); } }
    }
    __syncthreads();
}

__global__ void __launch_bounds__(NWAVES * 64, 2) mega_fwd(Args args0) {
    extern __shared__ __attribute__((aligned(16))) unsigned char lds_raw[];
    LAS unsigned char* lds = (LAS unsigned char*)lds_raw;
    volatile LAS unsigned* MISC = (volatile LAS unsigned*)(lds + MISC_OFF);
    const int G = gridDim.x;
    const int wave0 = __builtin_amdgcn_readfirstlane((int)(threadIdx.x >> 6));
    gu32* ctl = (gu32*)(args0.ws + WS_CTL);
    { const int tid = threadIdx.x;
      for (int i = tid; i < (LDS_BYTES - LDSCTL_OFF) / 4; i += NWAVES * 64) ((LAS unsigned*)(lds + LDSCTL_OFF))[i] = 0u;
      LAS float* lut = (LAS float*)(lds + LUT_OFF); const float* bt = args0.in[1];
      for (int i = tid; i < 8 * LUT_N; i += NWAVES * 64) { const int hd = i / LUT_N, n = i % LUT_N - LUT_NEG; lut[i] = (n < 0) ? -1.0e30f : 1.4426950408889634f * bt[(int)BKT[n > 128 ? 128 : n] * 8 + hd]; }
      if (tid < 256) { const float gv = __builtin_amdgcn_cvt_f32_fp8(tid, 0); ((LAS float*)(lds + SLUT_OFF))[tid] = 1.0f / (1.0f + __expf(-gv)); } }
    __syncthreads();
    XcdBarrier bar; bar.bar = (unsigned*)(ctl + CW_BAR) + args0.li * XCD_BAR_WORDS; bar.x = 0; bar.st = nullptr;
#if MK_ONE_LAUNCH
    bar = xcd_barrier_post((unsigned*)(ctl + CW_BAR) + args0.li * XCD_BAR_WORDS, MISC + 8);
#define GRID_BAR() xcd_barrier(bar)
#else
    (void)MISC;
#define GRID_BAR() do { } while (0)
#endif
    const int lo = args0.ph_lo, hi = args0.ph_hi;
#define IN(k) (lo <= (k) && (k) < hi)
#define BOTH(k) (IN(k) && IN((k) + 1))

#define OPQ_PTRS CArgs* ka_ = (CArgs*)__builtin_amdgcn_kernarg_segment_ptr(); asm volatile("" : "+s"(ka_)); CArgs& args = *ka_; unsigned char* ws = args.ws; bf16* R = (bf16*)(ws + WS_R); \
        bf16* Hn = (bf16*)(ws + WS_H); bf16* U = (bf16*)(ws + WS_U); bf16* Y = (bf16*)(ws + WS_Y); bf16* MG = (bf16*)(ws + WS_MG); float* kmean = (float*)(ws + WS_KMEAN); \
        unsigned* route = (unsigned*)(ws + WS_ROUTE); int* tokp = (int*)(ws + WS_TOK); float* gatep = (float*)(ws + WS_GATE); int* tile_e = (int*)(ws + WS_TILEE); int* n_rt = (int*)(ws + WS_TILEE + 4096); \
        (void)Hn; (void)U; (void)Y; (void)MG; (void)kmean; (void)route; (void)tokp; (void)gatep; (void)tile_e; (void)n_rt; (void)R
#define OPQ_I(name, v) int name = (v); asm volatile("" : "+s"(name))

    if (IN(0)) { OPQ_PTRS; ph_prologue(args, lds, wave0); ph_norm_bf16(args.in[0], args.in[2], Hn, ws + WS_A8, wave0); if (BOTH(0)) GRID_BAR(); }

    for (int l_ = 0; l_ < 2; ++l_) {
        const int pb = 1 + 17 * l_;
        for (int hf_ = 0; hf_ < 2; ++hf_) {
            const int p2 = pb + 1 + 5 * hf_;
            if (IN(p2)) {
                OPQ_PTRS; OPQ_I(l, l_); OPQ_I(hf, hf_); const size_t r0 = (size_t)hf * HROWS;
                const float* ssq1 = l == 0 ? (const float*)nullptr : (const float*)(ws + SSQ1_OFF) + r0 * 16;
                {
                    pg8::Gemm g{(l == 0 ? Hn : R) + r0 * D, (const bf16*)(ws + WS_WIN) + (size_t)l * GCOL0 * D, D, D, D};
                    pg8::Order S; S.init(HROWS / 256, GCOL0 / 256, G, (int)blockIdx.x, 0, D, D, nullptr, 0);
                    pg8::EpiWin E{U, UST, ssq1, 1 << 20, kmean, C_KA / 256};
                    pg8::gemm_phase<pg8::EpiWin, pg8::Order, true>(lds, fresh_tid(), g, S, E);
                }
                {
                    pg8::Gemm g{(const bf16*)(ws + WS_A8 + r0 * D), (const bf16*)(ws + WS_WG8 + (size_t)l * (WIN - GCOL0) * D), D / 2, D / 2, D / 2};
                    pg8::Order S; S.init(HROWS / 256, (WIN - GCOL0) / 256, G, (int)blockIdx.x, 0, D / 2, D / 2, nullptr, 0);
                    pg8::EpiGate8 E{(unsigned char*)U, 2 * UST, 2 * GCOL0, ssq1};
                    pg8::gemm_phase<pg8::EpiGate8, pg8::Order, true, true>(lds, fresh_tid(), g, S, E);
                }
                if (BOTH(p2)) GRID_BAR();
            }
            if (IN(p2 + 2)) {
                OPQ_PTRS; OPQ_I(l, l_);
                ph_conv_pool(args, l, U, Y, lds, wave0);
                ph_attn(args, l, U, kmean, Y, lds, wave0);
                if (BOTH(p2 + 2)) GRID_BAR();
            }
            if (IN(p2 + 3)) {
                OPQ_PTRS; OPQ_I(l, l_);
                pg8::Gemm g{Y, (const bf16*)(ws + WS_BP) + (size_t)l * 4 * D * 256, 1024, 256, 256};
                pg8::Order S; S.init(HROWS / 256, 4, G, (int)blockIdx.x, 1, 1024, 256, nullptr, (size_t)D * 256 * 2);
                pg8::EpiMerge E{U, UST, GCOL0, MG, 1024, (const LAS float*)(lds + SLUT_OFF)};
                pg8::gemm_phase<pg8::EpiMerge, pg8::Order, true>(lds, fresh_tid(), g, S, E);
                if (BOTH(p2 + 3)) GRID_BAR();
            }
            if (IN(p2 + 4)) {
                OPQ_PTRS; OPQ_I(l, l_); OPQ_I(hf, hf_); const size_t r0 = (size_t)hf * HROWS;
                pg8::Gemm g{MG, (const bf16*)(ws + WS_WOUT) + (size_t)l * D * D, D, D, D};
                pg8::Order S; S.init(HROWS / 256, 4, G, (int)blockIdx.x, 0, D, D, nullptr, 0);
                pg8::EpiRes E{args.in[0] + r0 * D, (l == 0) ? (const bf16*)nullptr : (const bf16*)(R + r0 * D), R + r0 * D, D, (l == 0) ? (float*)(ws + SSQ0_OFF) + r0 * 16 : (float*)nullptr};
                pg8::gemm_phase<pg8::EpiRes, pg8::Order, true>(lds, fresh_tid(), g, S, E);
                if (hf == 1 && BOTH(p2 + 4)) GRID_BAR();
            }
        }
        if (IN(pb + 11)) {
            OPQ_PTRS; OPQ_I(l, l_);
            if (l == 1) { ph_route(args, l, R, route, tokp, ctl, lds, wave0); if (BOTH(pb + 11)) GRID_BAR(); }
        }
        if (IN(pb + 12)) {
            OPQ_PTRS; OPQ_I(l, l_);
            if (l == 1) { ph_gather(args, l, R, route, tokp, gatep, tile_e, n_rt, ws + WS_HPERM, ctl, lds, wave0); if (BOTH(pb + 12)) GRID_BAR(); }
        }
        for (int ps_ = 0; ps_ < 2; ++ps_) {
            const int p3 = pb + 13 + 2 * ps_;
            if (IN(p3)) {
                OPQ_PTRS; OPQ_I(l, l_); OPQ_I(ps, ps_);
                if (l == 1) {
                    if (ps == 0) {
                        const int n0 = __builtin_amdgcn_readfirstlane(n_rt[0]), n1 = __builtin_amdgcn_readfirstlane(n_rt[1]);
                        pg8::Gemm g{(const bf16*)(ws + WS_HPERM), (const bf16*)(ws + WS_W13E), D / 2, D / 2, D / 2};
                        pg8::Order S; S.init(n0 + n1, 2 * FFE / 256, G, (int)blockIdx.x, 0, D / 2, D / 2, tile_e, (size_t)2 * FFE * D, n0, CAPT);
                        pg8::EpiSwiGLU8 E{ws + WS_TE, FFE, 256.0f, 8.0f};
                        pg8::gemm_phase<pg8::EpiSwiGLU8, pg8::Order, true, true>(lds, fresh_tid(), g, S, E);
                        if (BOTH(p3)) GRID_BAR();
                    }
                } else if (ps == 0) {
                    pg8::Gemm g{R, (const bf16*)(ws + WS_W13D), D, D, D};
                    pg8::Order S; S.init(M / 256, 2 * FF0 / 256, G, (int)blockIdx.x, 0, D, D, nullptr, 0);
                    pg8::EpiSwiGLU E{U, FF0, (const float*)(ws + SSQ0_OFF)};
                    pg8::gemm_phase<pg8::EpiSwiGLU, pg8::Order, true>(lds, fresh_tid(), g, S, E);
                    if (BOTH(p3)) GRID_BAR();
                }
            }
            if (IN(p3 + 1)) {
                OPQ_PTRS; OPQ_I(l, l_); OPQ_I(ps, ps_);
                if (l == 1) {
                    if (ps == 0) {
                        const int n0 = __builtin_amdgcn_readfirstlane(n_rt[0]), n1 = __builtin_amdgcn_readfirstlane(n_rt[1]);
                        pg8::Gemm g{(const bf16*)(ws + WS_TE), (const bf16*)(ws + WS_W2E), FFE / 2, FFE / 2, FFE / 2};
                        pg8::Order S; S.init(n0 + n1, 4, G, (int)blockIdx.x, 0, FFE / 2, FFE / 2, tile_e, (size_t)D * FFE, n0, CAPT);
                        pg8::EpiScatter E{R, D, tokp, gatep, 1.0f / 128.0f, nullptr, nullptr, (bf16*)args.out, 2048};
                        pg8::gemm_phase<pg8::EpiScatter, pg8::Order, true, true>(lds, fresh_tid(), g, S, E);
                        if (BOTH(p3 + 1)) GRID_BAR();
                    }
                } else if (ps == 0) {
                    pg8::Gemm g{U, (const bf16*)(ws + WS_W2D), FF0, FF0, FF0};
                    pg8::Order S; S.init(M / 256, 4, G, (int)blockIdx.x, 0, FF0, FF0, nullptr, 0);
                    pg8::EpiScatter E{R, D, nullptr, nullptr, 1.0f, (float*)(ws + SSQ1_OFF), ws + WS_A8, nullptr, 0};
                    pg8::gemm_phase<pg8::EpiScatter, pg8::Order, true>(lds, fresh_tid(), g, S, E);
                    if (BOTH(p3 + 1)) GRID_BAR();
                }
            }
        }
    }
    if (IN(35)) { OPQ_PTRS; ph_final_norm(R, args.in[19], args.out, wave0); }
#undef IN
#undef BOTH
}

extern "C" void kernel_launch(void* const* d_in, const int* in_sizes, int n_in, void* d_out, int out_size, void* d_ws, size_t ws_size, hipStream_t stream) {
    static int grid = 0;
    if (grid == 0) {
        if (n_in != 20 || in_sizes[0] != M * D || out_size != M * D || ws_size < WS_END) { fprintf(stderr, "kernel_launch: unexpected shapes / workspace (n_in %d, ws %zu); nothing launched\n", n_in, ws_size); grid = -1; return; }
        int dev = 0, cus = 0, per_cu = 0;
        if (hipGetDevice(&dev) != hipSuccess || hipDeviceGetAttribute(&cus, hipDeviceAttributeMultiprocessorCount, dev) != hipSuccess) { grid = -1; return; }
        if (hipFuncSetAttribute((const void*)mega_fwd, hipFuncAttributeMaxDynamicSharedMemorySize, LDS_BYTES) != hipSuccess) { fprintf(stderr, "kernel_launch: hipFuncSetAttribute failed\n"); grid = -1; return; }
        if (hipOccupancyMaxActiveBlocksPerMultiprocessor(&per_cu, (const void*)mega_fwd, NWAVES * 64, LDS_BYTES) != hipSuccess || per_cu < 1) { fprintf(stderr, "kernel_launch: occupancy query reports %d\n", per_cu); }
        (void)hipGetLastError();
        grid = cus;
    }
    if (grid < 0) return;
    if (hipMemsetAsync((char*)d_ws + WS_CTL, 0, CTL_ZERO_BYTES, stream) != hipSuccess) return;
    Args a{};
    for (int i = 0; i < 20; ++i) a.in[i] = (const float*)d_in[i];
    a.out = (float*)d_out; a.ws = (unsigned char*)d_ws;
#if MK_ONE_LAUNCH
#ifdef PROBE_DUP
    { const int dup[] = {PROBE_DUP}; const int nd = (int)(sizeof(dup) / sizeof(int)); int lo = 0;
      for (int i = 0; i <= nd; ++i) { a.ph_lo = lo; a.ph_hi = (i < nd) ? dup[i] + 1 : 36; a.li = i; hipLaunchKernelGGL(mega_fwd, dim3(grid), dim3(NWAVES * 64), LDS_BYTES, stream, a); if (i < nd) lo = dup[i]; } }
#else
    a.ph_lo = 0; a.ph_hi = 36;
    hipLaunchKernelGGL(mega_fwd, dim3(grid), dim3(NWAVES * 64), LDS_BYTES, stream, a);
#endif
#else
    for (int p = 0; p < 36; ++p) {
        if (p == 1 + 12 || p == 1 + 15 || p == 1 + 16) continue;
        a.ph_lo = p; a.ph_hi = p + 1;
        hipLaunchKernelGGL(mega_fwd, dim3(grid), dim3(NWAVES * 64), LDS_BYTES, stream, a);
    }
#endif
}
```

```cpp
#include <hip/hip_runtime.h>
#include <cstdio>
#include <cstdint>

#ifndef MK_ONE_LAUNCH
#define MK_ONE_LAUNCH 1
#endif

namespace pg8 {
#define PG8_LAS __attribute__((address_space(3)))
typedef unsigned short bf16_t;
typedef short bf16x8 __attribute__((ext_vector_type(8)));
typedef float f32x4 __attribute__((ext_vector_type(4)));
typedef unsigned u32x4 __attribute__((ext_vector_type(4)));
typedef unsigned u32x2 __attribute__((ext_vector_type(2)));
typedef int i32x4 __attribute__((ext_vector_type(4)));
typedef int i32x8 __attribute__((ext_vector_type(8)));
constexpr int BM = 256, BK = 64, HALF = 128, HTB = HALF * BK * 2  , STAGE_BYTES = 8 * HTB, NXCD = 8, WGM = 8;

__host__ __device__ __forceinline__ int lds_byte(int r, int c) { const int st = (r >> 4) * 2 + (c >> 5), rr = r & 15, cc = c & 31, ob = rr * 64 + cc * 2; return st * 1024 + (ob ^ (((ob >> 9) & 1) << 5)); }
__host__ __device__ __forceinline__ void stage_rc(int b, int& R, int& C) { const int st = b / 1024, sb = b % 1024, swz = sb ^ (((sb >> 9) & 1) << 5); R = (st >> 1) * 16 + swz / 64; C = (st & 1) * 32 + (swz % 64) / 2; }
__host__ __device__ __forceinline__ int perm32(int rho) { const int n = rho >> 4, i = rho & 15; return 8 * (i >> 2) + 4 * n + (i & 3); }

struct Unit { int pm, pn, e, prow, second; size_t aoff, boff; };
struct Gemm { const bf16_t* A; const bf16_t* Bt; int lda, ldb, K; };

struct Order {
    int nM, nN, nwg, G, c, mode, n0, skip; size_t arow  , brow  , estride; const int* tile_e;
    __device__ __forceinline__ void init(int nM_, int nN_, int G_, int c_, int mode_, int lda, int ldb, const int* te, size_t es, int n0_ = 1 << 30, int skip_ = 0) {
        nM = nM_; nN = nN_; nwg = nM * nN; G = G_; c = c_; mode = mode_; arow = (size_t)BM * lda * 2; brow = (size_t)BM * ldb * 2; tile_e = te; estride = es; n0 = n0_; skip = skip_; }
    __device__ __forceinline__ bool base(int i, Unit& u) const {
        const long L = (long)i * G + c; if (L >= nwg) return false;
        int wgid = (int)L; { const int q = nwg / NXCD, r = nwg % NXCD, xcd = wgid % NXCD, off = wgid / NXCD; wgid = (xcd < r ? xcd * (q + 1) : r * (q + 1) + (xcd - r) * q) + off; }
        const int nig = WGM * nN, gid = wgid / nig, fm = gid * WGM, gsz = (nM - fm) < WGM ? (nM - fm) : WGM;
        u.pm = fm + ((wgid % nig) % gsz); u.pn = (wgid % nig) / gsz; return true;
    }
    __device__ __forceinline__ bool next(int i, Unit& u) const {
        if (mode == 1) { if (!base(i >> 2, u)) return false; u.e = i & 3; u.prow = u.pm; u.second = 0; u.aoff = (size_t)u.pm * arow + (size_t)u.e * 512; u.boff = (size_t)u.e * estride + (size_t)u.pn * brow; return true; }
        if (!base(i, u)) return false;
        const bool second = u.pm >= n0; u.prow = second ? skip + (u.pm - n0) : u.pm; u.second = second ? 1 : 0;
        u.e = tile_e ? __builtin_amdgcn_readfirstlane(tile_e[second ? 512 + (u.pm - n0) : u.pm]) : 0; u.aoff = (size_t)u.prow * arow; u.boff = (size_t)u.e * estride + (size_t)u.pn * brow; return true;
    }
    __device__ __forceinline__ void a_ready(const Unit&) const {}
    __device__ __forceinline__ void done(const Unit&) const {}
};

__device__ __forceinline__ int fresh_lane() { int lane; asm volatile("v_mbcnt_lo_u32_b32 %0, -1, 0\n\tv_mbcnt_hi_u32_b32 %0, -1, %0" : "=v"(lane)); return lane; }
typedef float f32x2p __attribute__((ext_vector_type(2)));
typedef __bf16 bf16x2p __attribute__((ext_vector_type(2)));
__device__ __forceinline__ unsigned cvt_pk_bf16(float lo, float hi) { const f32x2p f = {lo, hi}; const bf16x2p b = __builtin_convertvector(f, bf16x2p); return __builtin_bit_cast(unsigned, b); }
__device__ __forceinline__ float bflo(unsigned w) { return __uint_as_float(w << 16); }
__device__ __forceinline__ float bfhi(unsigned w) { return __uint_as_float(w & 0xffff0000u); }
__device__ __forceinline__ float sigmoidf_(float x) { return __builtin_amdgcn_rcpf(1.0f + __expf(-x)); }

__device__ __forceinline__ void ssq_put(float* ssq, int row, int slot, float part, int lane_) {
    part += __int_as_float(__builtin_amdgcn_ds_bpermute((lane_ ^ 16) << 2, __float_as_int(part)));
    part += __int_as_float(__builtin_amdgcn_ds_bpermute((lane_ ^ 32) << 2, __float_as_int(part)));
    if (lane_ < 16) ssq[(size_t)row * 16 + slot] = part;
}
__device__ __forceinline__ float ssq_rs(const float* ssq, int row) {
    const f32x4* p = (const f32x4*)(ssq + (size_t)row * 16); const f32x4 a = p[0], b = p[1], c = p[2], d = p[3];
    const float t = (((a[0] + a[1]) + (a[2] + a[3])) + ((b[0] + b[1]) + (b[2] + b[3]))) + (((c[0] + c[1]) + (c[2] + c[3])) + ((d[0] + d[1]) + (d[2] + d[3])));
    return __builtin_amdgcn_rsqf(t * (1.0f / 1024.0f) + 1e-6f);
}
__device__ __forceinline__ float ssq_ms(const float* ssq, int row) {
    const f32x4* p = (const f32x4*)(ssq + (size_t)row * 16); const f32x4 a = p[0], b = p[1], c = p[2], d = p[3];
    const float t = (((a[0] + a[1]) + (a[2] + a[3])) + ((b[0] + b[1]) + (b[2] + b[3]))) + (((c[0] + c[1]) + (c[2] + c[3])) + ((d[0] + d[1]) + (d[2] + d[3])));
    return t * (1.0f / 1024.0f) + 1e-6f;
}
struct EpiWin {
    static constexpr bool PERM = true, AFTER_DRAIN = false;
    bf16_t* O; int ldc; const float* ssq; int gate_pn; float* kmp; int kpn;
    __device__ __forceinline__ void operator()(const f32x4 (&acc)[2][2][4][2], const Unit& u, int wr, int wc, int, int) const {
        const int lane_ = fresh_lane(), fr = lane_ & 15, fq = lane_ >> 4;
        const int row0 = u.pm * BM + wr * 64 + fr, col0 = u.pn * BM + wc * 32 + 8 * fq; const bool gt = u.pn >= gate_pn;
        const bool km = (u.pn == kpn); float cs[2][8];
#pragma unroll
        for (int b_ = 0; b_ < 2; ++b_)
#pragma unroll
            for (int k_ = 0; k_ < 8; ++k_) cs[b_][k_] = 0.f;
#pragma unroll
        for (int ai = 0; ai < 2; ++ai)
#pragma unroll
            for (int m = 0; m < 4; ++m) { const int r = row0 + ai * HALF + m * 16; bf16_t* rowp = O + (size_t)r * ldc;
                const float rs = ssq ? ssq_rs(ssq, r) : 1.0f;
#pragma unroll
                for (int bj = 0; bj < 2; ++bj) { const f32x4 v0 = acc[ai][bj][m][0] * rs, v1 = acc[ai][bj][m][1] * rs;
                    if (km) { cs[bj][0] += v0[0]; cs[bj][1] += v0[1]; cs[bj][2] += v0[2]; cs[bj][3] += v0[3]; cs[bj][4] += v1[0]; cs[bj][5] += v1[1]; cs[bj][6] += v1[2]; cs[bj][7] += v1[3]; }
                    if (gt) { u32x2 w; { int t_ = 0; t_ = __builtin_amdgcn_cvt_pk_fp8_f32(v0[0], v0[1], t_, false); t_ = __builtin_amdgcn_cvt_pk_fp8_f32(v0[2], v0[3], t_, true); w.x = (unsigned)t_; }
                        { int t_ = 0; t_ = __builtin_amdgcn_cvt_pk_fp8_f32(v1[0], v1[1], t_, false); t_ = __builtin_amdgcn_cvt_pk_fp8_f32(v1[2], v1[3], t_, true); w.y = (unsigned)t_; }
                        *(u32x2*)((unsigned char*)rowp + 512 * gate_pn + (col0 - BM * gate_pn) + bj * HALF) = w; }
                    else { u32x4 w; w.x = cvt_pk_bf16(v0[0], v0[1]); w.y = cvt_pk_bf16(v0[2], v0[3]); w.z = cvt_pk_bf16(v1[0], v1[1]); w.w = cvt_pk_bf16(v1[2], v1[3]);
                        *(u32x4*)(rowp + col0 + bj * HALF) = w; } } }
        if (km) {
#pragma unroll
            for (int b_ = 0; b_ < 2; ++b_)
#pragma unroll
                for (int k_ = 0; k_ < 8; ++k_) { float x = cs[b_][k_];
#pragma unroll
                    for (int o_ = 1; o_ < 16; o_ <<= 1) x += __int_as_float(__builtin_amdgcn_ds_bpermute((lane_ ^ o_) << 2, __float_as_int(x)));
                    cs[b_][k_] = x; }
            if (fr == 0) { float* kp = kmp + ((size_t)u.pm * 2 + wr) * 256 + wc * 32 + 8 * fq;
#pragma unroll
                for (int b_ = 0; b_ < 2; ++b_) { *(f32x4*)(kp + b_ * HALF) = (f32x4){cs[b_][0], cs[b_][1], cs[b_][2], cs[b_][3]}; *(f32x4*)(kp + b_ * HALF + 4) = (f32x4){cs[b_][4], cs[b_][5], cs[b_][6], cs[b_][7]}; } }
        }
    }
};
struct EpiMerge {
    static constexpr bool PERM = true, AFTER_DRAIN = false;
    const bf16_t* U; int ldu, gcol0; bf16_t* O; int ldc; const PG8_LAS float* slut;
    __device__ __forceinline__ void operator()(const f32x4 (&acc)[2][2][4][2], const Unit& u, int wr, int wc, int, int) const {
        const int lane_ = fresh_lane(), fr = lane_ & 15, fq = lane_ >> 4;
        const int row0 = u.pm * BM + wr * 64 + fr, col0 = u.pn * BM + wc * 32 + 8 * fq;
        typedef float f32x2g __attribute__((ext_vector_type(2)));
        const __amdgpu_buffer_rsrc_t rsrc = __builtin_amdgcn_make_buffer_rsrc((void*)O, 0, 0x7fffffff, 0x00020000);
#pragma unroll
        for (int ai = 0; ai < 2; ++ai) {
            u32x2 gq[4][2]; u32x4 pq[4][2];
#pragma unroll
            for (int m = 0; m < 4; ++m) { const size_t r = (size_t)(row0 + ai * HALF + m * 16); const unsigned char* gp = (const unsigned char*)(U + r * ldu) + 2 * gcol0 + u.e * 1024 + col0; const bf16_t* rowp = O + r * ldc + col0;
#pragma unroll
                for (int bj = 0; bj < 2; ++bj) { gq[m][bj] = *(const u32x2*)(gp + bj * HALF); if (u.e != 0) pq[m][bj] = __builtin_bit_cast(u32x4, __builtin_amdgcn_raw_buffer_load_b128(rsrc, (int)((r * ldc + col0 + bj * HALF) * 2), 0, 16  )); else pq[m][bj] = (u32x4){0u, 0u, 0u, 0u}; } }
#pragma unroll
            for (int m = 0; m < 4; ++m) { const size_t r = (size_t)(row0 + ai * HALF + m * 16); bf16_t* rowp = O + r * ldc + col0;
#pragma unroll
                for (int bj = 0; bj < 2; ++bj) { const f32x4 a0 = acc[ai][bj][m][0], a1 = acc[ai][bj][m][1]; const u32x2 g = gq[m][bj]; const u32x4 p = pq[m][bj];
                    const float s0 = slut[g.x & 0xffu], s1 = slut[(g.x >> 8) & 0xffu], s2 = slut[(g.x >> 16) & 0xffu], s3 = slut[g.x >> 24], s4 = slut[g.y & 0xffu], s5 = slut[(g.y >> 8) & 0xffu], s6 = slut[(g.y >> 16) & 0xffu], s7 = slut[g.y >> 24];
                    const float v0 = a0[0] * s0 + bflo(p.x), v1 = a0[1] * s1 + bfhi(p.x), v2 = a0[2] * s2 + bflo(p.y), v3 = a0[3] * s3 + bfhi(p.y);
                    const float v4 = a1[0] * s4 + bflo(p.z), v5 = a1[1] * s5 + bfhi(p.z), v6 = a1[2] * s6 + bflo(p.w), v7 = a1[3] * s7 + bfhi(p.w);
                    u32x4 w; w.x = cvt_pk_bf16(v0, v1); w.y = cvt_pk_bf16(v2, v3); w.z = cvt_pk_bf16(v4, v5); w.w = cvt_pk_bf16(v6, v7);
                    *(u32x4*)(rowp + bj * HALF) = w; } }
        }
    }
};
struct EpiRes {
    static constexpr bool PERM = true, AFTER_DRAIN = false;
    const float* base; const bf16_t* bb; bf16_t* out; int ldc; float* ssq;
    __device__ __forceinline__ void operator()(const f32x4 (&acc)[2][2][4][2], const Unit& u, int wr, int wc, int, int) const {
        const int lane_ = fresh_lane(), fr = lane_ & 15, fq = lane_ >> 4;
        const int row0 = u.pm * BM + wr * 64 + fr, col0 = u.pn * BM + wc * 32 + 8 * fq;
        const __amdgpu_buffer_rsrc_t rsrc = __builtin_amdgcn_make_buffer_rsrc((void*)(bb ? bb : out), 0, 0x7fffffff, 0x00020000);
#pragma unroll
        for (int ai = 0; ai < 2; ++ai)
#pragma unroll
            for (int mh = 0; mh < 2; ++mh) {
                f32x4 b0[2][2], b1[2][2];
#pragma unroll
                for (int mm = 0; mm < 2; ++mm) { const size_t off = (size_t)(row0 + ai * HALF + (2 * mh + mm) * 16) * ldc + col0;
#pragma unroll
                    for (int bj = 0; bj < 2; ++bj) {
                        if (bb) { const u32x4 p = __builtin_bit_cast(u32x4, __builtin_amdgcn_raw_buffer_load_b128(rsrc, (int)((off + bj * HALF) * 2), 0, 16  )); b0[mm][bj] = (f32x4){bflo(p.x), bfhi(p.x), bflo(p.y), bfhi(p.y)}; b1[mm][bj] = (f32x4){bflo(p.z), bfhi(p.z), bflo(p.w), bfhi(p.w)}; }
                        else { b0[mm][bj] = *(const f32x4*)(base + off + bj * HALF); b1[mm][bj] = *(const f32x4*)(base + off + bj * HALF + 4); } } }
#pragma unroll
                for (int mm = 0; mm < 2; ++mm) { const int m = 2 * mh + mm; const size_t off = (size_t)(row0 + ai * HALF + m * 16) * ldc + col0; float sq = 0.f;
#pragma unroll
                    for (int bj = 0; bj < 2; ++bj) { const f32x4 v0 = acc[ai][bj][m][0] + b0[mm][bj], v1 = acc[ai][bj][m][1] + b1[mm][bj];
                        sq += (v0[0] * v0[0] + v0[1] * v0[1]) + (v0[2] * v0[2] + v0[3] * v0[3]) + (v1[0] * v1[0] + v1[1] * v1[1]) + (v1[2] * v1[2] + v1[3] * v1[3]);
                        u32x4 w; w.x = cvt_pk_bf16(v0[0], v0[1]); w.y = cvt_pk_bf16(v0[2], v0[3]); w.z = cvt_pk_bf16(v1[0], v1[1]); w.w = cvt_pk_bf16(v1[2], v1[3]);
                        *(u32x4*)(out + off + bj * HALF) = w; }
                    if (ssq) ssq_put(ssq, row0 + ai * HALF + m * 16, u.pn * 4 + wc, sq, lane_); }
            }
    }
};
__device__ __forceinline__ unsigned cvt4_fp8(float a, float b, float c, float d) { int w = 0; w = __builtin_amdgcn_cvt_pk_fp8_f32(a, b, w, false); w = __builtin_amdgcn_cvt_pk_fp8_f32(c, d, w, true); return (unsigned)w; }
struct EpiSwiGLU {
    static constexpr bool PERM = true, AFTER_DRAIN = false;
    bf16_t* T; int ldt; const float* ssq; int f8;
    __device__ __forceinline__ void operator()(const f32x4 (&acc)[2][2][4][2], const Unit& u, int wr, int wc, int, int) const {
        const int lane_ = fresh_lane(), fr = lane_ & 15, fq = lane_ >> 4;
        const int row0 = u.pm * BM + wr * 64 + fr, col0 = u.pn * HALF + wc * 32 + 8 * fq;
#pragma unroll
        for (int ai = 0; ai < 2; ++ai)
#pragma unroll
            for (int m = 0; m < 4; ++m) { const int r = row0 + ai * HALF + m * 16; bf16_t* rowp = T + (size_t)r * ldt + col0; float v[8];
                const float q = ssq ? ssq_ms(ssq, r) : 1.0f; const float nk = -1.44269504f * __builtin_amdgcn_rsqf(q);
                const float qd = f8 ? 0.25f * q : q; const f32x2p nk2 = {nk, nk}, q2 = {qd, qd};
#pragma unroll
                for (int n = 0; n < 2; ++n)
#pragma unroll
                    for (int h = 0; h < 2; ++h) { const f32x2p a2 = {acc[ai][0][m][n][2 * h], acc[ai][0][m][n][2 * h + 1]}, b2 = {acc[ai][1][m][n][2 * h], acc[ai][1][m][n][2 * h + 1]};
                        const f32x2p x2 = a2 * nk2; const f32x2p e2 = {__builtin_amdgcn_exp2f(x2[0]), __builtin_amdgcn_exp2f(x2[1])};
                        const f32x2p d2 = e2 * q2 + q2; const f32x2p r2 = {__builtin_amdgcn_rcpf(d2[0]), __builtin_amdgcn_rcpf(d2[1])};
                        const f32x2p v2 = (a2 * b2) * r2; v[n * 4 + 2 * h] = v2[0]; v[n * 4 + 2 * h + 1] = v2[1]; }
                if (f8) { u32x2 w8; w8.x = cvt4_fp8(v[0], v[1], v[2], v[3]); w8.y = cvt4_fp8(v[4], v[5], v[6], v[7]); *(u32x2*)((unsigned char*)T + (size_t)r * ldt + col0) = w8; }
                else { u32x4 w; w.x = cvt_pk_bf16(v[0], v[1]); w.y = cvt_pk_bf16(v[2], v[3]); w.z = cvt_pk_bf16(v[4], v[5]); w.w = cvt_pk_bf16(v[6], v[7]);
                    *(u32x4*)rowp = w; } }
    }
};
struct EpiSwiGLU8 {
    static constexpr bool PERM = true, AFTER_DRAIN = false;
    unsigned char* T; int ldt; float cc, lc;
    __device__ __forceinline__ void operator()(const f32x4 (&acc)[2][2][4][2], const Unit& u, int wr, int wc, int, int) const {
        const int lane_ = fresh_lane(), fr = lane_ & 15, fq = lane_ >> 4;
        const int row0 = u.prow * BM + wr * 64 + fr, col0 = u.pn * HALF + wc * 32 + 8 * fq;
#pragma unroll
        for (int ai = 0; ai < 2; ++ai)
#pragma unroll
            for (int m = 0; m < 4; ++m) { unsigned char* rowp = T + (size_t)(row0 + ai * HALF + m * 16) * ldt + col0; float v[8];
                const f32x2p nk2 = {-1.44269504f * 0.03125f, -1.44269504f * 0.03125f}, l2 = {lc, lc}, c2 = {cc, cc};
#pragma unroll
                for (int n = 0; n < 2; ++n)
#pragma unroll
                    for (int h = 0; h < 2; ++h) { const f32x2p a2 = {acc[ai][0][m][n][2 * h], acc[ai][0][m][n][2 * h + 1]}, b2 = {acc[ai][1][m][n][2 * h], acc[ai][1][m][n][2 * h + 1]};
                        const f32x2p x2 = a2 * nk2 + l2; const f32x2p e2 = {__builtin_amdgcn_exp2f(x2[0]), __builtin_amdgcn_exp2f(x2[1])};
                        const f32x2p d2 = e2 + c2; const f32x2p r2 = {__builtin_amdgcn_rcpf(d2[0]), __builtin_amdgcn_rcpf(d2[1])};
                        const f32x2p v2 = (a2 * b2) * r2; v[n * 4 + 2 * h] = v2[0]; v[n * 4 + 2 * h + 1] = v2[1]; }
                u32x2 w; w.x = cvt4_fp8(v[0], v[1], v[2], v[3]); w.y = cvt4_fp8(v[4], v[5], v[6], v[7]);
                *(u32x2*)rowp = w; }
    }
};
struct EpiGate8 {
    static constexpr bool PERM = true, AFTER_DRAIN = false;
    unsigned char* O; int ldo, goff; const float* ssq;
    __device__ __forceinline__ void operator()(const f32x4 (&acc)[2][2][4][2], const Unit& u, int wr, int wc, int, int) const {
        const int lane_ = fresh_lane(), fr = lane_ & 15, fq = lane_ >> 4;
        const int row0 = u.pm * BM + wr * 64 + fr, col0 = u.pn * BM + wc * 32 + 8 * fq;
#pragma unroll
        for (int ai = 0; ai < 2; ++ai)
#pragma unroll
            for (int m = 0; m < 4; ++m) { const int r = row0 + ai * HALF + m * 16; unsigned char* rowp = O + (size_t)r * ldo + goff + col0;
                const float rs = (ssq ? ssq_rs(ssq, r) : 1.0f) * 0.03125f;
#pragma unroll
                for (int bj = 0; bj < 2; ++bj) { const f32x4 v0 = acc[ai][bj][m][0] * rs, v1 = acc[ai][bj][m][1] * rs;
                    u32x2 w; w.x = cvt4_fp8(v0[0], v0[1], v0[2], v0[3]); w.y = cvt4_fp8(v1[0], v1[1], v1[2], v1[3]);
                    *(u32x2*)(rowp + bj * HALF) = w; } }
    }
};
struct EpiScatter {
    static constexpr bool PERM = true, AFTER_DRAIN = false;
    bf16_t* R; int ldc; const int* tok; const float* gate; float scale; float* ssq; unsigned char* r8; bf16_t* Z; int ldz;
    __device__ __forceinline__ void operator()(const f32x4 (&acc)[2][2][4][2], const Unit& u, int wr, int wc, int, int) const {
        const int lane_ = fresh_lane(), fr = lane_ & 15, fq = lane_ >> 4;
        const int row0 = u.prow * BM + wr * 64 + fr, col0 = u.pn * BM + wc * 32 + 8 * fq;
        if (Z) {
#pragma unroll
            for (int ai = 0; ai < 2; ++ai)
#pragma unroll
                for (int m = 0; m < 4; ++m) { const int r = row0 + ai * HALF + m * 16; const int t = tok[r]; const float g = gate[r] * scale;
                    if (t >= 0) { bf16_t* zp = Z + (size_t)t * ldz + u.second * 1024 + col0;
#pragma unroll
                        for (int bj = 0; bj < 2; ++bj) { const f32x4 a0 = acc[ai][bj][m][0] * g, a1 = acc[ai][bj][m][1] * g;
                            u32x4 w; w.x = cvt_pk_bf16(a0[0], a0[1]); w.y = cvt_pk_bf16(a0[2], a0[3]); w.z = cvt_pk_bf16(a1[0], a1[1]); w.w = cvt_pk_bf16(a1[2], a1[3]);
                            *(u32x4*)(zp + bj * HALF) = w; } } }
            return; }
        const __amdgpu_buffer_rsrc_t rsrc = __builtin_amdgcn_make_buffer_rsrc((void*)R, 0, 0x7fffffff, 0x00020000);
        int tk[2][4]; float gg[2][4];
#pragma unroll
        for (int ai = 0; ai < 2; ++ai)
#pragma unroll
            for (int m = 0; m < 4; ++m) { const int r = row0 + ai * HALF + m * 16; tk[ai][m] = tok ? tok[r] : r; gg[ai][m] = tok ? gate[r] * scale : scale; }
#pragma unroll
        for (int ai = 0; ai < 2; ++ai) {
            u32x4 pq[4][2];
#pragma unroll
            for (int m = 0; m < 4; ++m) { const int t = tk[ai][m] < 0 ? 0 : tk[ai][m]; const bf16_t* rp = R + (size_t)t * ldc + col0;
#pragma unroll
                for (int bj = 0; bj < 2; ++bj) pq[m][bj] = __builtin_bit_cast(u32x4, __builtin_amdgcn_raw_buffer_load_b128(rsrc, (int)(((size_t)t * ldc + col0 + bj * HALF) * 2), 0, 16  )); (void)rp; }
#pragma unroll
            for (int m = 0; m < 4; ++m) { const int t = tk[ai][m]; const float g = gg[ai][m];
                if (t >= 0) { bf16_t* rp = R + (size_t)t * ldc + col0; float sq = 0.f;
#pragma unroll
                    for (int bj = 0; bj < 2; ++bj) { const u32x4 p = pq[m][bj]; const f32x4 a0 = acc[ai][bj][m][0] * g, a1 = acc[ai][bj][m][1] * g;
                        const float e0 = bflo(p.x) + a0[0], e1 = bfhi(p.x) + a0[1], e2 = bflo(p.y) + a0[2], e3 = bfhi(p.y) + a0[3], e4 = bflo(p.z) + a1[0], e5 = bfhi(p.z) + a1[1], e6 = bflo(p.w) + a1[2], e7 = bfhi(p.w) + a1[3];
                        sq += (e0 * e0 + e1 * e1) + (e2 * e2 + e3 * e3) + (e4 * e4 + e5 * e5) + (e6 * e6 + e7 * e7);
                        u32x4 w; w.x = cvt_pk_bf16(e0, e1); w.y = cvt_pk_bf16(e2, e3); w.z = cvt_pk_bf16(e4, e5); w.w = cvt_pk_bf16(e6, e7);
                        *(u32x4*)(rp + bj * HALF) = w;
                        if (r8) { u32x2 w8; w8.x = cvt4_fp8(e0, e1, e2, e3); w8.y = cvt4_fp8(e4, e5, e6, e7); *(u32x2*)(r8 + (size_t)t * 1024 + col0 + bj * HALF) = w8; } }
                    if (ssq) ssq_put(ssq, row0 + ai * HALF + m * 16, u.pn * 4 + wc, sq, lane_); } }
        }
    }
};

template <class Epi, class Sched, bool ALIGN_EPI = false, bool FP8 = false>
__device__ __forceinline__ void gemm_phase(PG8_LAS unsigned char* lds, const int tid, const Gemm g, const Sched& S, const Epi& E) {
    const int wid = __builtin_amdgcn_readfirstlane(tid >> 6), lane = tid & 63, wr = wid >> 2, wc = wid & 3, fr = lane & 15, fq = lane >> 4;
    const int K = g.K, nt = K / BK;
    unsigned voffA, voffB;
    { int R, C; stage_rc(tid * 16, R, C); const int Rb = Epi::PERM ? ((R & ~31) + perm32(R & 31)) : R;
      voffA = (unsigned)(R * g.lda + C) * 2u; voffB = (unsigned)(Rb * g.ldb + C) * 2u; }
    const size_t rstepA = (size_t)64 * g.lda * 2, rstepB = (size_t)64 * g.ldb * 2;
    const size_t kstep = (size_t)(BK * 2);
    const size_t hstepA = (size_t)HALF * g.lda * 2, hstepB = (size_t)HALF * g.ldb * 2;
    const unsigned ldsw = (unsigned)wid * 1024u;
    const int aoff = lds_byte(wr * 64 + fr, fq * 8), boff = lds_byte(wc * 32 + fr, fq * 8);
#define PG8_SA(b, h) (((b) * 2 + (h)) * HTB)
#define PG8_SB(b, h) ((4 + (b) * 2 + (h)) * HTB)
#define PG8_STAGE(bufoff, gbase, voff) do { _Pragma("unroll") for (int _i = 0; _i < 2; ++_i) { const char* gb_ = (const char*)(gbase) + (size_t)_i * rstep##voff; asm volatile("" : "+s"(gb_));     \
        __builtin_amdgcn_global_load_lds((const unsigned*)(gb_ + (voff)), (PG8_LAS unsigned*)(lds + (bufoff) + ldsw + _i * 8192), 16, 0, 0); } } while (0)
#define rstepvoffA rstepA
#define rstepvoffB rstepB
#define PG8_LDA(dst, b, h) do { if constexpr (FP8) { _Pragma("unroll") for (int m = 0; m < 4; ++m) dst##8[m] = __builtin_shufflevector(*(const PG8_LAS i32x4*)(lds + PG8_SA(b, h) + aoff + m * 2048), *(const PG8_LAS i32x4*)(lds + PG8_SA(b, h) + aoff + m * 2048 + 1024), 0, 1, 2, 3, 4, 5, 6, 7); } \
        else { _Pragma("unroll") for (int m = 0; m < 4; ++m) _Pragma("unroll") for (int k = 0; k < 2; ++k) dst[m][k] = *(const PG8_LAS bf16x8*)(lds + PG8_SA(b, h) + aoff + m * 2048 + k * 1024); } } while (0)
#define PG8_LDB(dst, b, h) do { if constexpr (FP8) { _Pragma("unroll") for (int n = 0; n < 2; ++n) dst##8[n] = __builtin_shufflevector(*(const PG8_LAS i32x4*)(lds + PG8_SB(b, h) + boff + n * 2048), *(const PG8_LAS i32x4*)(lds + PG8_SB(b, h) + boff + n * 2048 + 1024), 0, 1, 2, 3, 4, 5, 6, 7); } \
        else { _Pragma("unroll") for (int n = 0; n < 2; ++n) _Pragma("unroll") for (int k = 0; k < 2; ++k) dst[n][k] = *(const PG8_LAS bf16x8*)(lds + PG8_SB(b, h) + boff + n * 2048 + k * 1024); } } while (0)
#define PG8_MMA(ai, bj, At, Bt) do { __builtin_amdgcn_s_setprio(1); \
        if constexpr (FP8) { _Pragma("unroll") for (int m = 0; m < 4; ++m) _Pragma("unroll") for (int n = 0; n < 2; ++n) \
            acc[ai][bj][m][n] = __builtin_amdgcn_mfma_scale_f32_16x16x128_f8f6f4(Bt##8[n], At##8[m], acc[ai][bj][m][n], 0, 0, 0, 0x7f7f7f7f, 0, 0x7f7f7f7f); } \
        else { _Pragma("unroll") for (int m = 0; m < 4; ++m) _Pragma("unroll") for (int n = 0; n < 2; ++n) _Pragma("unroll") for (int k = 0; k < 2; ++k) \
            acc[ai][bj][m][n] = __builtin_amdgcn_mfma_f32_16x16x32_bf16(Bt[n][k], At[m][k], acc[ai][bj][m][n], 0, 0, 0); } \
        __builtin_amdgcn_s_setprio(0); } while (0)
#define PG8_WAIT_V(n) asm volatile("s_waitcnt vmcnt(" #n ")" ::: "memory")
#define PG8_WAIT_L(n) asm volatile("s_waitcnt lgkmcnt(" #n ")" ::: "memory")
#define PG8_BAR __builtin_amdgcn_s_barrier()
#define PG8_SCHED __builtin_amdgcn_sched_barrier(0)
    Unit cur, nxt; int ui = 0;
    if (!S.next(0, cur)) return;
    f32x4 acc[2][2][4][2];
#pragma unroll
    for (int a = 0; a < 2; ++a)
#pragma unroll
        for (int b = 0; b < 2; ++b)
#pragma unroll
            for (int m = 0; m < 4; ++m)
#pragma unroll
                for (int n = 0; n < 2; ++n) acc[a][b][m][n] = (f32x4){0.f, 0.f, 0.f, 0.f};
    bf16x8 At[4][2], B0[2][2], B1[2][2]; i32x8 At8[4], B08[2], B18[2];
    const char* cA = (const char*)g.A + cur.aoff; const char* cB = (const char*)g.Bt + cur.boff;
    S.a_ready(cur);
    PG8_STAGE(PG8_SB(0, 0), cB, voffB); PG8_STAGE(PG8_SB(0, 1), cB + hstepB, voffB); PG8_STAGE(PG8_SA(0, 0), cA, voffA); PG8_STAGE(PG8_SA(0, 1), cA + hstepA, voffA);
    if (wr == 1) PG8_BAR;
    PG8_WAIT_V(2); PG8_BAR;
    PG8_STAGE(PG8_SB(1, 0), cB + kstep, voffB); PG8_STAGE(PG8_SA(1, 0), cA + kstep, voffA); PG8_STAGE(PG8_SB(1, 1), cB + hstepB + kstep, voffB);
    PG8_WAIT_V(6); PG8_BAR;
    for (;;) {
        const bool has_next = S.next(ui + 1, nxt);
        const char* nA = has_next ? (const char*)g.A + nxt.aoff : cA; const char* nB = has_next ? (const char*)g.Bt + nxt.boff : cB;
#pragma unroll 1
        for (int t = 0; t < nt; t += 2) {
            const bool last = (t == nt - 2);
            const char* a1 = cA + (size_t)(t + 1) * kstep;
            const char* a2 = last ? nA : cA + (size_t)(t + 2) * kstep; const char* b2 = last ? nB : cB + (size_t)(t + 2) * kstep;
            const char* a3 = a2 + kstep; const char* b3 = b2 + kstep;
            if (last && has_next) S.a_ready(nxt);
            PG8_LDB(B0, 0, 0); PG8_LDB(B1, 0, 1); PG8_SCHED; PG8_LDA(At, 0, 0); PG8_STAGE(PG8_SA(1, 1), a1 + hstepA, voffA);
            PG8_WAIT_V(8); PG8_WAIT_L(0); PG8_BAR; PG8_MMA(0, 0, At, B0); PG8_MMA(0, 1, At, B1); PG8_BAR; PG8_SCHED;
            PG8_LDA(At, 0, 1); PG8_STAGE(PG8_SB(0, 0), b2, voffB); PG8_STAGE(PG8_SB(0, 1), b2 + hstepB, voffB); PG8_STAGE(PG8_SA(0, 0), a2, voffA);
            PG8_WAIT_V(8); PG8_WAIT_L(0); PG8_BAR; PG8_MMA(1, 0, At, B0); PG8_MMA(1, 1, At, B1); PG8_BAR; PG8_SCHED;
            PG8_LDB(B0, 1, 0); PG8_LDB(B1, 1, 1); PG8_SCHED; PG8_LDA(At, 1, 0); PG8_STAGE(PG8_SA(0, 1), a2 + hstepA, voffA);
            PG8_WAIT_V(8); PG8_WAIT_L(0); PG8_BAR; PG8_MMA(0, 0, At, B0); PG8_MMA(0, 1, At, B1); PG8_BAR; PG8_SCHED;
            PG8_LDA(At, 1, 1); PG8_STAGE(PG8_SB(1, 0), b3, voffB); PG8_STAGE(PG8_SB(1, 1), b3 + hstepB, voffB); PG8_STAGE(PG8_SA(1, 0), a3, voffA);
            PG8_WAIT_V(8); PG8_WAIT_L(0); PG8_BAR; PG8_MMA(1, 0, At, B0); PG8_MMA(1, 1, At, B1); PG8_BAR; PG8_SCHED;
        }
        if constexpr (ALIGN_EPI) { if (wr == 0) PG8_BAR; }
        E(acc, cur, wr, wc, fr, fq); S.done(cur);
        if (!has_next) break;
#pragma unroll
        for (int a = 0; a < 2; ++a)
#pragma unroll
            for (int b = 0; b < 2; ++b)
#pragma unroll
                for (int m = 0; m < 4; ++m)
#pragma unroll
                    for (int n = 0; n < 2; ++n) acc[a][b][m][n] = (f32x4){0.f, 0.f, 0.f, 0.f};
        cur = nxt; cA = nA; cB = nB; ++ui;
        if constexpr (ALIGN_EPI) { if (wr == 1) PG8_BAR; }
    }
    PG8_WAIT_V(0);
    if constexpr (!ALIGN_EPI) { if (wr == 0) PG8_BAR; }
    PG8_BAR;
#undef PG8_SA
#undef PG8_SB
#undef PG8_STAGE
#undef rstepvoffA
#undef rstepvoffB
#undef PG8_LDA
#undef PG8_LDB
#undef PG8_MMA
#undef PG8_WAIT_V
#undef PG8_WAIT_L
#undef PG8_BAR
#undef PG8_SCHED
}
}

constexpr int NB = 32, SEQ = 2048, D = 1024, M = NB * SEQ;
constexpr int WIN = 6656, GCOL0 = 2560;
constexpr int UST = 4608;
constexpr int FF0 = 2816, FFE = 3584, NEXP = 8;
constexpr int HROWS = M / 2, HB = NB / 2;
constexpr int CAPROWS = M + NEXP * 256, CAPT = CAPROWS / 256;
constexpr float RMS_EPS = 1e-6f, SUBLN_EPS = 1e-5f;
constexpr int NWAVES = 8;
constexpr int C_QA = 0, C_KA = 256, C_VA = 512, C_XB = 768, C_BB = 1024, C_CB = 1280, C_PC = 1536, C_QD = 1792, C_KD = 2048, C_VD = 2304;

constexpr size_t MiB = 1u << 20;
constexpr size_t WS_CTL = 0, CTL_ZERO_BYTES = 1 * MiB;
constexpr size_t WS_ROUTE = 2 * MiB;
constexpr size_t WS_TOK = 4 * MiB;
constexpr size_t WS_GATE = 5 * MiB;
constexpr size_t WS_TILEE = 6 * MiB;
constexpr size_t WS_KMEAN = 7 * MiB;
constexpr size_t WS_WIN = 8 * MiB;
constexpr size_t WS_WG8 = 24 * MiB;
constexpr size_t WS_BP = 34 * MiB;
constexpr size_t WS_WOUT = 38 * MiB;
constexpr size_t WS_W13D = 42 * MiB;
constexpr size_t WS_W2D = 53 * MiB;
constexpr size_t WS_W13E = 60 * MiB;
constexpr size_t WS_W2E = 116 * MiB;
constexpr size_t WS_R = 144 * MiB;
constexpr size_t WS_H = 272 * MiB;
constexpr size_t WS_U = 400 * MiB;
constexpr size_t WS_A8 = 752 * MiB;
constexpr size_t WS_Y = 816 * MiB;
constexpr size_t WS_MG = 880 * MiB;
constexpr size_t WS_HPERM = 272 * MiB;
constexpr size_t WS_TE = 404 * MiB;
constexpr size_t WS_END = 952 * MiB;
static_assert(WS_W13E + (size_t)8 * 2 * FFE * D <= WS_W2E && WS_W2E + (size_t)8 * D * FFE <= WS_R && WS_U + (size_t)HROWS * UST * 2 <= WS_A8 && WS_A8 + (size_t)M * D <= WS_Y && WS_HPERM + 2 * (size_t)CAPROWS * D <= WS_TE && WS_TE + 2 * (size_t)CAPROWS * FFE <= WS_END - 8 * MiB && WS_U + (size_t)M * FF0 * 2 <= WS_A8 && WS_MG + (size_t)HROWS * D * 2 <= WS_END, "d_ws map");
constexpr int CW_BAR = 4096;
constexpr int CW_QUEUE = 16384;
constexpr int CW_CNT = 20480;
constexpr size_t SSQ0_OFF = 944 * MiB, SSQ1_OFF = 948 * MiB;

constexpr int RING_BYTES = 131072;
constexpr int LUT_OFF = RING_BYTES;
constexpr int LUT_N = 320, LUT_NEG = 96;
constexpr int SLUT_OFF = LUT_OFF + 8 * LUT_N * 4;
constexpr int LDSCTL_OFF = RING_BYTES + 12288, MISC_OFF = LDSCTL_OFF + 320;
constexpr int LDS_BYTES = 147456;

#define GAS __attribute__((address_space(1)))
#define LAS __attribute__((address_space(3)))
typedef unsigned short bf16;
typedef unsigned v4u __attribute__((ext_vector_type(4)));
typedef unsigned v2u __attribute__((ext_vector_type(2)));
typedef float f32x4 __attribute__((ext_vector_type(4)));
typedef GAS unsigned gu32;
#define RLX_AGENT __ATOMIC_RELAXED, __HIP_MEMORY_SCOPE_AGENT
#define LDS_WAIT() asm volatile("s_waitcnt lgkmcnt(0)" ::: "memory")
#define VM_WAIT() asm volatile("s_waitcnt vmcnt(0)" ::: "memory")
__device__ __forceinline__ unsigned f2bf(float f) { unsigned u = __builtin_bit_cast(unsigned, f); return (u + 0x7fffu + ((u >> 16) & 1u)) >> 16; }
__device__ __forceinline__ unsigned pk2(float lo, float hi) { return f2bf(lo) | (f2bf(hi) << 16); }
__device__ __forceinline__ float bflo(unsigned w) { return __uint_as_float(w << 16); }
__device__ __forceinline__ float bfhi(unsigned w) { return __uint_as_float(w & 0xffff0000u); }

#define XB_TMO      128
#define XB_XCNT(j)  (256  + 64 * (j))
#define XB_XSUB(j)  (1280 + 64 * (j))
#define XB_XGEN(j)  (2304 + 64 * (j))
#define XB_TOP      3328
#define XB_TOPGEN   3392
#define XCD_BAR_WORDS 3456
#define XB_SPIN_CAP (1u << 22)

__device__ __forceinline__ unsigned xb_ld(unsigned* p)              { return __hip_atomic_load(p, __ATOMIC_RELAXED, __HIP_MEMORY_SCOPE_AGENT); }
__device__ __forceinline__ unsigned xb_add(unsigned* p, unsigned v) { return __hip_atomic_fetch_add(p, v, __ATOMIC_RELAXED, __HIP_MEMORY_SCOPE_AGENT); }
__device__ __forceinline__ unsigned xb_xcc_id() { return (unsigned)__builtin_amdgcn_s_getreg((3 << 11) | 20) & 0xFu; }
#define XB_SPIN(cond, bar) do { unsigned _sp = 0; while (cond) { __builtin_amdgcn_s_sleep(1); \
    if ((++_sp & 255u) == 0u) { if (xb_ld(&(bar)[XB_TMO])) break; if (_sp > XB_SPIN_CAP) { atomicAdd(&(bar)[XB_TMO], 1u); break; } } } } while (0)

struct XcdBarrier { unsigned* bar; unsigned x; volatile LAS unsigned* st; };

__device__ __forceinline__ XcdBarrier xcd_barrier_post(unsigned* bar, volatile LAS unsigned* st) {
    XcdBarrier b; b.bar = bar; b.x = xb_xcc_id(); b.st = st;
    if (threadIdx.x == 0) (void)xb_add(&bar[XB_XCNT(b.x)], 1u);
    return b;
}
__device__ __forceinline__ void xcd_barrier_complete(unsigned* bar, unsigned x, unsigned& nloc, unsigned& nx) {
    const unsigned G = gridDim.x * gridDim.y * gridDim.z;
    unsigned sum, cnt, mine, sp = 0u;
    for (;;) {
        sum = 0u; cnt = 0u; mine = 0u;
#pragma unroll
        for (unsigned j = 0; j < 16; ++j) { const unsigned c = xb_ld(&bar[XB_XCNT(j)]); sum += c; cnt += (c > 0u) ? 1u : 0u; mine = (j == x) ? c : mine; }
        if (sum == G) break;
        __builtin_amdgcn_s_sleep(1);
        if ((++sp & 255u) == 0u) { if (xb_ld(&bar[XB_TMO])) break; if (sp > XB_SPIN_CAP) { atomicAdd(&bar[XB_TMO], 1u); break; } }
    }
    nloc = mine > 0u ? mine : 1u; nx = cnt > 0u ? cnt : 1u;
}
__device__ __forceinline__ void xcd_barrier(const XcdBarrier& b) {
    asm volatile("s_waitcnt vmcnt(0)" ::: "memory");
    __syncthreads();
    if (threadIdx.x == 0) {
        unsigned* bar = b.bar;
        __builtin_amdgcn_s_waitcnt(0);
        unsigned nloc = b.st[0], nx = b.st[1];
        if (nloc == 0u) { xcd_barrier_complete(bar, b.x, nloc, nx); b.st[0] = nloc; b.st[1] = nx; }
        const unsigned old = xb_add(&bar[XB_XSUB(b.x)], 1u);
        const unsigned gen = old / nloc;
        if (old + 1u == (gen + 1u) * nloc) {
            __builtin_amdgcn_fence(__ATOMIC_RELEASE, "agent");
            asm volatile("s_waitcnt vmcnt(0)" ::: "memory");
            const unsigned og = xb_add(&bar[XB_TOP], 1u);
            const unsigned tg = og / nx;
            if (og + 1u == (tg + 1u) * nx) xb_add(&bar[XB_TOPGEN], 1u);
            else XB_SPIN(xb_ld(&bar[XB_TOPGEN]) == tg, bar);
            __builtin_amdgcn_fence(__ATOMIC_ACQUIRE, "agent");
            xb_add(&bar[XB_XGEN(b.x)], 1u);
            asm volatile("s_waitcnt vmcnt(0)" ::: "memory");
        } else {
            XB_SPIN(xb_ld(&bar[XB_XGEN(b.x)]) == gen, bar);
            __builtin_amdgcn_fence(__ATOMIC_ACQUIRE, "agent");
            asm volatile("s_waitcnt vmcnt(0)" ::: "memory");
        }
    }
    __syncthreads();
}

__device__ __forceinline__ float wave_sum(float v, int lane) {
#pragma unroll
    for (int o = 1; o < 64; o <<= 1) v += __int_as_float(__builtin_amdgcn_ds_bpermute((lane ^ o) << 2, __float_as_int(v)));
    return v;
}
__device__ __forceinline__ void wave_sync() { asm volatile("s_waitcnt lgkmcnt(0)" ::: "memory"); __builtin_amdgcn_wave_barrier(); }

__device__ const unsigned char BKT[129] = {
    0, 1, 2, 3, 4, 5, 6, 7, 8, 9, 10, 11, 12, 13, 14, 15, 16, 16, 16, 17, 17, 18, 18, 18, 19, 19, 19, 20, 20, 20, 20, 21, 21, 21, 21, 22, 22, 22, 22, 22, 23, 23, 23, 23, 23, 23,
    24, 24, 24, 24, 24, 24, 25, 25, 25, 25, 25, 25, 25, 26, 26, 26, 26, 26, 26, 26, 26, 27, 27, 27, 27, 27, 27, 27, 27, 27, 27, 28, 28, 28, 28, 28, 28, 28, 28, 28, 28,
    29, 29, 29, 29, 29, 29, 29, 29, 29, 29, 29, 29, 30, 30, 30, 30, 30, 30, 30, 30, 30, 30, 30, 30, 30, 30, 31, 31, 31, 31, 31, 31, 31, 31, 31, 31, 31, 31, 31, 31, 31, 31 };

__device__ __forceinline__ void transpose_item(const float* W, int K, int N, bf16* WT, int row_off, int il, LAS float* scr, int item, int lane, const float* gk = nullptr, int ldw = 0) {
    if (ldw == 0) ldw = N;
    const int nblk = N / 32, kb = item / nblk, nb = item % nblk, k0 = 64 * kb, n0 = 32 * nb;
#pragma unroll 8
    for (int i = 0; i < 32; ++i) { const int kk = 2 * i + (lane >> 5); scr[kk * 33 + (lane & 31)] = __builtin_nontemporal_load(W + (size_t)(k0 + kk) * ldw + n0 + (lane & 31)) * (gk ? gk[k0 + kk] : 1.0f); }
    LDS_WAIT(); asm volatile("" ::: "memory"); __builtin_amdgcn_wave_barrier();
    const int c = lane & 7;
    const int r0 = il ? ((n0 >> 7) * 256 + row_off + (n0 & 127)) : (row_off + n0);
#pragma unroll
    for (int j = 0; j < 4; ++j) { const int n = (lane >> 3) + 8 * j; const LAS float* s = scr + (8 * c) * 33 + n;
        v4u o; o.x = pk2(s[0 * 33], s[1 * 33]); o.y = pk2(s[2 * 33], s[3 * 33]); o.z = pk2(s[4 * 33], s[5 * 33]); o.w = pk2(s[6 * 33], s[7 * 33]);
        *(GAS v4u*)(WT + (size_t)(r0 + n) * K + k0 + 8 * c) = o; }
    LDS_WAIT(); asm volatile("" ::: "memory"); __builtin_amdgcn_wave_barrier();
}


__device__ __forceinline__ int fresh_tid_w(int wave) { int lane; asm volatile("v_mbcnt_lo_u32_b32 %0, -1, 0\n\tv_mbcnt_hi_u32_b32 %0, -1, %0" : "=v"(lane)); return wave * 64 + lane; }
#define fresh_tid() fresh_tid_w(wave0)

__device__ __forceinline__ unsigned moba_mask(const bf16* u, const float* kmean, int bl, int h, int qc, int lane) {
    const int t = qc * 32 + (lane & 31), own = qc >> 3;
    if (own <= 3) return (1u << own) - 1u;
    const bf16* qp = u + ((size_t)bl * SEQ + t) * UST + C_QA + h * 64;
    float gs[7];
#pragma unroll
    for (int blk = 0; blk < 7; ++blk) gs[blk] = 0.f;
#pragma unroll 1
    for (int i = 0; i < 8; ++i) { const v4u x = *(const GAS v4u*)(qp + 8 * i);
        const float qv[8] = {bflo(x.x), bfhi(x.x), bflo(x.y), bfhi(x.y), bflo(x.z), bfhi(x.z), bflo(x.w), bfhi(x.w)};
#pragma unroll
        for (int blk = 0; blk < 7; ++blk) { const float* km = kmean + ((size_t)(bl * 8 + blk)) * 512 + h * 64 + 8 * i;
#pragma unroll
            for (int k = 0; k < 8; ++k) gs[blk] += qv[k] * (km[k] + km[256 + k]); } }
    unsigned mask = 0u;
#pragma unroll
    for (int k = 0; k < 3; ++k) { float bv = -3.3e38f; int best = 0;
#pragma unroll
        for (int blk = 0; blk < 7; ++blk) { const bool ok = (blk < own) && (((mask >> blk) & 1u) == 0u); if (ok && gs[blk] > bv) { bv = gs[blk]; best = blk; } }
        mask |= 1u << best; }
    return mask;
}

typedef short bf16x8v __attribute__((ext_vector_type(8)));
typedef float f32x16 __attribute__((ext_vector_type(16)));
constexpr int AT_KP = 144, AT_VP = 136, AT_KB = 64 * AT_KP, AT_BUF = AT_KB + 64 * AT_VP;

typedef float f32x2c __attribute__((ext_vector_type(2)));
typedef __bf16 bf16x2c __attribute__((ext_vector_type(2)));
__device__ __forceinline__ unsigned pk2c(float lo, float hi) { const f32x2c f = {lo, hi}; const bf16x2c b = __builtin_convertvector(f, bf16x2c); return __builtin_bit_cast(unsigned, b); }

__device__ __forceinline__ void softmax_step(f32x16 (&e)[2], float& m, float& l, f32x16 (&o)[2], bf16x8v (&pb)[2][2], bool first, int xaddr) {
    float pm = -1.0e30f;
#pragma unroll
    for (int st = 0; st < 2; ++st)
#pragma unroll
        for (int i = 0; i < 16; ++i) pm = fmaxf(pm, e[st][i]);
    pm = fmaxf(pm, __int_as_float(__builtin_amdgcn_ds_bpermute(xaddr, __float_as_int(pm))));
    if (first || __ballot(pm > 8.0f) != 0ull) {
        const float delta = first ? pm : fmaxf(pm, 0.f);
        const float f = __builtin_amdgcn_exp2f(-delta);
        m += delta; l *= f;
#pragma unroll
        for (int mb = 0; mb < 2; ++mb)
#pragma unroll
            for (int i = 0; i < 16; ++i) o[mb][i] *= f;
#pragma unroll
        for (int st = 0; st < 2; ++st)
#pragma unroll
            for (int i = 0; i < 16; ++i) e[st][i] -= delta;
    }
#pragma unroll
    for (int st = 0; st < 2; ++st)
#pragma unroll
        for (int sp = 0; sp < 2; ++sp) { float pv[8];
#pragma unroll
            for (int j = 0; j < 8; ++j) { pv[j] = __builtin_amdgcn_exp2f(e[st][8 * sp + j]); l += pv[j]; }
            union { v4u u; bf16x8v b; } cv; cv.u.x = pk2c(pv[0], pv[1]); cv.u.y = pk2c(pv[2], pv[3]); cv.u.z = pk2c(pv[4], pv[5]); cv.u.w = pk2c(pv[6], pv[7]); pb[st][sp] = cv.b; }
}

template <bool DIFF>
__device__ __forceinline__ void attn_unit(const bf16* U, const float* kmean, bf16* Y, const LAS float* lut, LAS unsigned char* lds, int bl, int h, int qb, const int wave0, float lam, float outscale, const float* subg) {
    const int tid = fresh_tid(), lane = tid & 63, w = wave0, c = lane & 31, hh = lane >> 5;
    const int qcol = (DIFF ? C_QD : C_QA) + h * 64, kcol = (DIFF ? C_KD : C_KA) + h * 64, vcol = (DIFF ? C_VD : C_VA) + h * 64;
    const int q0w = qb * 256 + 32 * w, tq = q0w + c;
    const size_t qrow = (size_t)bl * SEQ + tq;
    bf16x8v qf[4];
#pragma unroll
    for (int s = 0; s < 4; ++s) qf[s] = *(const GAS bf16x8v*)(U + qrow * UST + qcol + 16 * s + 8 * hh);
    unsigned mask = 0xffu;
    if (!DIFF) mask = moba_mask(U, kmean, bl, h, qb * 8 + w, lane);
    const LAS float* lh = lut + (DIFF ? 4 + h : h) * LUT_N;
    const float cfar = lh[LUT_NEG + 128];
    const float qs2 = (DIFF ? 0.17677669529663687f : 0.125f) * 1.4426950408889634f;
    f32x16 o1[2], o2[2];
#pragma unroll
    for (int mb = 0; mb < 2; ++mb)
#pragma unroll
        for (int i = 0; i < 16; ++i) { o1[mb][i] = 0.f; o2[mb][i] = 0.f; }
    float m1 = 0.f, l1 = 0.f, m2 = 0.f, l2 = 0.f;
    const int ntiles = 4 * (qb + 1), my_last = qb * 4 + (w >> 1);
    const int xaddr = (lane ^ 32) << 2;
#define AT_KT(it) ((it) < 4 ? 4 * qb + (it) : (it) - 4)
    const bf16* kg = U + ((size_t)bl * SEQ + (tid >> 3)) * UST + kcol + 8 * (tid & 7);
    const bf16* vg = U + ((size_t)bl * SEQ + (tid & 63)) * UST + vcol + 8 * (tid >> 6);
    const int kst = (tid >> 3) * AT_KP + (tid & 7) * 16;
    const int vst = AT_KB + (8 * (tid >> 6)) * AT_VP + (tid & 63) * 2;
    v4u kreg = *(const GAS v4u*)(kg + (size_t)AT_KT(0) * 64 * UST), vreg = *(const GAS v4u*)(vg + (size_t)AT_KT(0) * 64 * UST);
#define AT_WRITE(bufb) do { LAS unsigned char* b_ = lds + (bufb) * AT_BUF; *(LAS v4u*)(b_ + kst) = kreg; \
        LAS unsigned short* v_ = (LAS unsigned short*)(b_ + vst); \
        v_[0 * (AT_VP / 2)] = (unsigned short)(vreg.x & 0xffffu); v_[1 * (AT_VP / 2)] = (unsigned short)(vreg.x >> 16); v_[2 * (AT_VP / 2)] = (unsigned short)(vreg.y & 0xffffu); v_[3 * (AT_VP / 2)] = (unsigned short)(vreg.y >> 16); \
        v_[4 * (AT_VP / 2)] = (unsigned short)(vreg.z & 0xffffu); v_[5 * (AT_VP / 2)] = (unsigned short)(vreg.z >> 16); v_[6 * (AT_VP / 2)] = (unsigned short)(vreg.w & 0xffffu); v_[7 * (AT_VP / 2)] = (unsigned short)(vreg.w >> 16); } while (0)
    AT_WRITE(0);
    __syncthreads();
    for (int it = 0; it < ntiles; ++it) {
        const bool more = (it + 1 < ntiles);
        if (more) { const int ktn = AT_KT(it + 1); kreg = *(const GAS v4u*)(kg + (size_t)ktn * 64 * UST); vreg = *(const GAS v4u*)(vg + (size_t)ktn * 64 * UST); }
        const int kt = AT_KT(it);
        const int blk = kt >> 2; const bool past = blk < qb;
        const bool lane_on = past ? (((mask >> blk) & 1u) != 0u) : true;
        if (kt <= my_last && (DIFF || !past || __ballot(lane_on) != 0ull)) {
            const LAS unsigned char* kb = lds + (it & 1) * AT_BUF; const LAS unsigned char* vb = kb + AT_KB;
            const int key0 = kt * 64;
            f32x16 s1[2], s2[2];
#pragma unroll
            for (int st = 0; st < 2; ++st) {
#pragma unroll
                for (int i = 0; i < 16; ++i) { s1[st][i] = 0.f; s2[st][i] = 0.f; }
#pragma unroll
                for (int s = 0; s < 4; ++s) { const bf16x8v a = *(const LAS bf16x8v*)(kb + (32 * st + c) * AT_KP + (16 * s + 8 * hh) * 2);
                    if (DIFF && s >= 2) s2[st] = __builtin_amdgcn_mfma_f32_32x32x16_bf16(a, qf[s], s2[st], 0, 0, 0);
                    else s1[st] = __builtin_amdgcn_mfma_f32_32x32x16_bf16(a, qf[s], s1[st], 0, 0, 0); }
            }
            const float off1 = lane_on ? -m1 : -1.0e30f, off2 = -m2;
            if (key0 + 63 + 128 <= q0w) {
                const float x1 = cfar + off1, x2 = cfar + off2;
#pragma unroll
                for (int st = 0; st < 2; ++st)
#pragma unroll
                    for (int i = 0; i < 16; ++i) { s1[st][i] = s1[st][i] * qs2 + x1; if (DIFF) s2[st][i] = s2[st][i] * qs2 + x2; }
            } else {
                const LAS float* lp = lh + (LUT_NEG + tq - key0 - 4 * hh);
#pragma unroll
                for (int st = 0; st < 2; ++st)
#pragma unroll
                    for (int i = 0; i < 16; ++i) { const float b = lp[-(32 * st + (i & 3) + 8 * (i >> 2))]; s1[st][i] = s1[st][i] * qs2 + (b + off1); if (DIFF) s2[st][i] = s2[st][i] * qs2 + (b + off2); }
            }
            bf16x8v p1[2][2], p2[2][2];
            softmax_step(s1, m1, l1, o1, p1, it == 0, xaddr);
            if (DIFF) softmax_step(s2, m2, l2, o2, p2, it == 0, xaddr);
#pragma unroll
            for (int mb = 0; mb < 2; ++mb)
#pragma unroll
                for (int s = 0; s < 4; ++s) { const LAS unsigned char* vr = vb + (32 * mb + c) * AT_VP + (16 * s + 4 * hh) * 2;
                    const v2u lo = *(const LAS v2u*)vr, hi = *(const LAS v2u*)(vr + 16);
                    union { v4u u; bf16x8v b; } cv; cv.u.x = lo.x; cv.u.y = lo.y; cv.u.z = hi.x; cv.u.w = hi.y;
                    o1[mb] = __builtin_amdgcn_mfma_f32_32x32x16_bf16(cv.b, p1[s >> 1][s & 1], o1[mb], 0, 0, 0);
                    if (DIFF) o2[mb] = __builtin_amdgcn_mfma_f32_32x32x16_bf16(cv.b, p2[s >> 1][s & 1], o2[mb], 0, 0, 0); }
        }
        if (more) AT_WRITE((it + 1) & 1);
        __syncthreads();
    }
#undef AT_WRITE
#undef AT_KT
    l1 += __int_as_float(__builtin_amdgcn_ds_bpermute(xaddr, __float_as_int(l1)));
    const float i1 = 1.0f / l1;
    bf16* yp = Y + qrow * 1024 + (DIFF ? 768 : 0) + h * 64;
    if (!DIFF) {
#pragma unroll
        for (int mb = 0; mb < 2; ++mb)
#pragma unroll
            for (int g = 0; g < 4; ++g) { v2u wv; wv.x = pk2c(o1[mb][4 * g] * i1, o1[mb][4 * g + 1] * i1); wv.y = pk2c(o1[mb][4 * g + 2] * i1, o1[mb][4 * g + 3] * i1);
                *(GAS v2u*)(yp + 32 * mb + 8 * g + 4 * hh) = wv; }
    } else {
        l2 += __int_as_float(__builtin_amdgcn_ds_bpermute(xaddr, __float_as_int(l2)));
        const float i2 = lam / l2; float ss = 0.f;
#pragma unroll
        for (int mb = 0; mb < 2; ++mb)
#pragma unroll
            for (int i = 0; i < 16; ++i) { const float v = o1[mb][i] * i1 - o2[mb][i] * i2; o1[mb][i] = v; ss += v * v; }
        ss += __int_as_float(__builtin_amdgcn_ds_bpermute(xaddr, __float_as_int(ss)));
        const float r = outscale / sqrtf(ss * (1.0f / 64.0f) + SUBLN_EPS);
#pragma unroll
        for (int mb = 0; mb < 2; ++mb)
#pragma unroll
            for (int g = 0; g < 4; ++g) { const int d = 32 * mb + 8 * g + 4 * hh; const f32x4 sg = *(const f32x4*)(subg + d);
                v2u wv; wv.x = pk2c(o1[mb][4 * g] * r * sg.x, o1[mb][4 * g + 1] * r * sg.y); wv.y = pk2c(o1[mb][4 * g + 2] * r * sg.z, o1[mb][4 * g + 3] * r * sg.w);
                *(GAS v2u*)(yp + d) = wv; }
    }
}

__device__ __forceinline__ unsigned cvt4_fp8g(float a, float b, float c, float d) { int w = 0; w = __builtin_amdgcn_cvt_pk_fp8_f32(a, b, w, false); w = __builtin_amdgcn_cvt_pk_fp8_f32(c, d, w, true); return (unsigned)w; }
__device__ __forceinline__ void transpose_item8(const float* W, int K, int N, unsigned char* WT, int row_off, int il, LAS float* scr, int item, int lane, const float* gk = nullptr, int ldw = 0) {
    if (ldw == 0) ldw = N;
    const int nblk = N / 32, kb = item / nblk, nb = item % nblk, k0 = 64 * kb, n0 = 32 * nb;
#pragma unroll 8
    for (int i = 0; i < 32; ++i) { const int kk = 2 * i + (lane >> 5); scr[kk * 33 + (lane & 31)] = __builtin_nontemporal_load(W + (size_t)(k0 + kk) * ldw + n0 + (lane & 31)) * (gk ? gk[k0 + kk] : 1.0f); }
    LDS_WAIT(); asm volatile("" ::: "memory"); __builtin_amdgcn_wave_barrier();
    const int c = lane & 7;
    const int r0 = il ? ((n0 >> 7) * 256 + row_off + (n0 & 127)) : (row_off + n0);
#pragma unroll
    for (int j = 0; j < 4; ++j) { const int n = (lane >> 3) + 8 * j; const LAS float* sp = scr + (8 * c) * 33 + n;
        v2u o; o.x = cvt4_fp8g(32.f * sp[0 * 33], 32.f * sp[1 * 33], 32.f * sp[2 * 33], 32.f * sp[3 * 33]); o.y = cvt4_fp8g(32.f * sp[4 * 33], 32.f * sp[5 * 33], 32.f * sp[6 * 33], 32.f * sp[7 * 33]);
        *(GAS v2u*)(WT + (size_t)(r0 + n) * K + k0 + 8 * c) = o; }
    LDS_WAIT(); asm volatile("" ::: "memory"); __builtin_amdgcn_wave_barrier();
}

struct Args {
    const float* in[20]; float* out; unsigned char* ws; int ph_lo, ph_hi, li, pad;
};
typedef const __attribute__((address_space(4))) Args CArgs;

__device__ __forceinline__ float row_rms_load(const float* xrow, const float* g, int lane, f32x4 (&v)[4]) {
    const GAS f32x4* xr = (const GAS f32x4*)xrow + lane; float s = 0.f;
#pragma unroll
    for (int j = 0; j < 4; ++j) { v[j] = __builtin_nontemporal_load(xr + 64 * j); s += (v[j].x * v[j].x + v[j].y * v[j].y) + (v[j].z * v[j].z + v[j].w * v[j].w); }
    const float r = 1.0f / sqrtf(wave_sum(s, lane) * (1.f / D) + RMS_EPS);
    const GAS f32x4* gr = (const GAS f32x4*)g + lane;
#pragma unroll
    for (int j = 0; j < 4; ++j) { const f32x4 gg = gr[64 * j]; v[j] = v[j] * r * gg; }
    return r;
}
__device__ __forceinline__ void row_store_bf16(bf16* orow, int lane, const f32x4 (&v)[4]) {
    GAS unsigned long long* o8 = (GAS unsigned long long*)orow + lane;
#pragma unroll
    for (int j = 0; j < 4; ++j) o8[64 * j] = (unsigned long long)pk2(v[j].x, v[j].y) | ((unsigned long long)pk2(v[j].z, v[j].w) << 32);
}

__device__ __forceinline__ float rowb_rms_load(const bf16* xrow, const float* g, int lane, float (&v)[16]) {
    float s = 0.f;
#pragma unroll
    for (int j = 0; j < 2; ++j) { const v4u x = *(const GAS v4u*)(xrow + 8 * lane + 512 * j);
        v[8 * j + 0] = bflo(x.x); v[8 * j + 1] = bfhi(x.x); v[8 * j + 2] = bflo(x.y); v[8 * j + 3] = bfhi(x.y); v[8 * j + 4] = bflo(x.z); v[8 * j + 5] = bfhi(x.z); v[8 * j + 6] = bflo(x.w); v[8 * j + 7] = bfhi(x.w); }
#pragma unroll
    for (int k = 0; k < 16; ++k) s += v[k] * v[k];
    const float r = 1.0f / sqrtf(wave_sum(s, lane) * (1.f / D) + RMS_EPS);
#pragma unroll
    for (int j = 0; j < 2; ++j) { const f32x4 g0 = *(const GAS f32x4*)(g + 8 * lane + 512 * j), g1 = *(const GAS f32x4*)(g + 8 * lane + 512 * j + 4);
        v[8 * j + 0] *= r * g0.x; v[8 * j + 1] *= r * g0.y; v[8 * j + 2] *= r * g0.z; v[8 * j + 3] *= r * g0.w; v[8 * j + 4] *= r * g1.x; v[8 * j + 5] *= r * g1.y; v[8 * j + 6] *= r * g1.z; v[8 * j + 7] *= r * g1.w; }
    return r;
}
__device__ __forceinline__ float rowb_rms_from(const v4u (&x)[2], const float* g, int lane, float (&v)[16]) {
    float s = 0.f;
#pragma unroll
    for (int j = 0; j < 2; ++j) { v[8 * j + 0] = bflo(x[j].x); v[8 * j + 1] = bfhi(x[j].x); v[8 * j + 2] = bflo(x[j].y); v[8 * j + 3] = bfhi(x[j].y); v[8 * j + 4] = bflo(x[j].z); v[8 * j + 5] = bfhi(x[j].z); v[8 * j + 6] = bflo(x[j].w); v[8 * j + 7] = bfhi(x[j].w); }
#pragma unroll
    for (int k = 0; k < 16; ++k) s += v[k] * v[k];
    const float r = 1.0f / sqrtf(wave_sum(s, lane) * (1.f / D) + RMS_EPS);
#pragma unroll
    for (int j = 0; j < 2; ++j) { const f32x4 g0 = *(const GAS f32x4*)(g + 8 * lane + 512 * j), g1 = *(const GAS f32x4*)(g + 8 * lane + 512 * j + 4);
        v[8 * j + 0] *= r * g0.x; v[8 * j + 1] *= r * g0.y; v[8 * j + 2] *= r * g0.z; v[8 * j + 3] *= r * g0.w; v[8 * j + 4] *= r * g1.x; v[8 * j + 5] *= r * g1.y; v[8 * j + 6] *= r * g1.z; v[8 * j + 7] *= r * g1.w; }
    return r;
}
__device__ __forceinline__ void rowb_store_bf16(bf16* orow, int lane, const float (&v)[16]) {
#pragma unroll
    for (int j = 0; j < 2; ++j) { v4u w; w.x = pk2(v[8 * j], v[8 * j + 1]); w.y = pk2(v[8 * j + 2], v[8 * j + 3]); w.z = pk2(v[8 * j + 4], v[8 * j + 5]); w.w = pk2(v[8 * j + 6], v[8 * j + 7]);
        *(GAS v4u*)(orow + 8 * lane + 512 * j) = w; }
}
__device__ __forceinline__ void rowb_store_fp8(unsigned char* orow, int lane, const float (&v)[16]) {
#pragma unroll
    for (int j = 0; j < 2; ++j) { v2u w; w.x = cvt4_fp8g(v[8 * j], v[8 * j + 1], v[8 * j + 2], v[8 * j + 3]); w.y = cvt4_fp8g(v[8 * j + 4], v[8 * j + 5], v[8 * j + 6], v[8 * j + 7]);
        *(GAS v2u*)(orow + 8 * lane + 512 * j) = w; }
}
__device__ __forceinline__ void row_store_fp8(unsigned char* orow, int lane, const f32x4 (&v)[4]) {
    GAS unsigned* o4 = (GAS unsigned*)orow + lane;
#pragma unroll
    for (int j = 0; j < 4; ++j) o4[64 * j] = cvt4_fp8g(v[j].x, v[j].y, v[j].z, v[j].w);
}
__device__ __forceinline__ void ph_prologue(CArgs& args, LAS unsigned char* lds, const int wave0) {
    const int tid = fresh_tid(), lane = tid & 63, wave = __builtin_amdgcn_readfirstlane(tid >> 6), gw = blockIdx.x * NWAVES + wave, NGW = gridDim.x * NWAVES;
    unsigned char* ws = args.ws;
    LAS float* scr = (LAS float*)(lds + wave * 16384);
    constexpr int I_WIN = 16 * (GCOL0 / 32), I_WG = 16 * ((WIN - GCOL0) / 32), I_BP = 4 * 32, I_WO = 16 * 32, I_D1 = 16 * (FF0 / 32), I_D2 = (FF0 / 64) * 32, I_E1 = 16 * (FFE / 32), I_E2 = (FFE / 64) * 32;
    constexpr int NIT = 2 * I_WIN + 2 * I_WG + 8 * I_BP + 2 * I_WO + 2 * I_D1 + I_D2 + 16 * I_E1 + 8 * I_E2;
    for (int it = gw; it < NIT; it += NGW) {
        int r = it;
        if (r < 2 * I_WIN) { const int l = r / I_WIN; transpose_item(args.in[3] + (size_t)l * D * WIN, D, GCOL0, (bf16*)(ws + WS_WIN) + (size_t)l * GCOL0 * D, 0, 0, scr, r % I_WIN, lane, l ? args.in[2] + D : nullptr, WIN); continue; } r -= 2 * I_WIN;
        if (r < 2 * I_WG) { const int l = r / I_WG; transpose_item8(args.in[3] + (size_t)l * D * WIN + GCOL0, D, WIN - GCOL0, ws + WS_WG8 + (size_t)l * (WIN - GCOL0) * D, 0, 0, scr, r % I_WG, lane, l ? args.in[2] + D : nullptr, WIN); continue; } r -= 2 * I_WG;
        if (r < 8 * I_BP) { const int q = r / I_BP;
            if ((q & 3) != 2) { transpose_item(args.in[9] + (size_t)q * 256 * D, 256, D, (bf16*)(ws + WS_BP) + (size_t)q * D * 256, 0, 0, scr, r % I_BP, lane); continue; }
            const int it2 = r % I_BP; if (it2 < 64) { const int l = q >> 2, g = it2 >> 4, n = (it2 & 15) * 64 + lane;
                const float* pw = args.in[5] + ((size_t)l * 4 + g) * 64 * 64; const float* psc = args.in[6] + (size_t)l * 256 + g * 64; const float* b2 = args.in[9] + ((size_t)q * 256 + g * 64) * D + n;
                bf16* dst = (bf16*)(ws + WS_BP) + (size_t)q * D * 256 + (size_t)n * 256 + g * 64;
#pragma unroll 1
                for (int ch = 0; ch < 4; ++ch) {
                    float accw[16];
#pragma unroll
                    for (int c = 0; c < 16; ++c) accw[c] = 0.f;
#pragma unroll 4
                    for (int d = 0; d < 64; ++d) { const float bv = b2[(size_t)d * D] * psc[d];
#pragma unroll
                        for (int c = 0; c < 16; ++c) accw[c] += pw[(ch * 16 + c) * 64 + d] * bv; }
#pragma unroll
                    for (int c8 = 0; c8 < 2; ++c8) { v4u w; w.x = pk2(accw[8 * c8], accw[8 * c8 + 1]); w.y = pk2(accw[8 * c8 + 2], accw[8 * c8 + 3]); w.z = pk2(accw[8 * c8 + 4], accw[8 * c8 + 5]); w.w = pk2(accw[8 * c8 + 6], accw[8 * c8 + 7]);
                        *(GAS v4u*)(dst + ch * 16 + 8 * c8) = w; } } }
            continue; } r -= 8 * I_BP;
        if (r < 2 * I_WO) { const int l = r / I_WO; transpose_item(args.in[10] + (size_t)l * D * D, D, D, (bf16*)(ws + WS_WOUT) + (size_t)l * D * D, 0, 0, scr, r % I_WO, lane); continue; } r -= 2 * I_WO;
        if (r < I_D1) { transpose_item(args.in[12], D, FF0, (bf16*)(ws + WS_W13D), 0, 1, scr, r, lane, args.in[11]); continue; } r -= I_D1;
        if (r < I_D1) { transpose_item(args.in[13], D, FF0, (bf16*)(ws + WS_W13D), 128, 1, scr, r, lane, args.in[11]); continue; } r -= I_D1;
        if (r < I_D2) { transpose_item8(args.in[14], FF0, D, ws + WS_W2D, 0, 0, scr, r, lane); continue; } r -= I_D2;
        if (r < 8 * I_E1) { const int e = r / I_E1; transpose_item8(args.in[16] + (size_t)e * D * FFE, D, FFE, ws + WS_W13E + (size_t)e * 2 * FFE * D, 0, 1, scr, r % I_E1, lane); continue; } r -= 8 * I_E1;
        if (r < 8 * I_E1) { const int e = r / I_E1; transpose_item8(args.in[17] + (size_t)e * D * FFE, D, FFE, ws + WS_W13E + (size_t)e * 2 * FFE * D, 128, 1, scr, r % I_E1, lane); continue; } r -= 8 * I_E1;
        { const int e = r / I_E2; transpose_item8(args.in[18] + (size_t)e * FFE * D, FFE, D, ws + WS_W2E + (size_t)e * D * FFE, 0, 0, scr, r % I_E2, lane); }
    }
}

__device__ __forceinline__ void ph_norm_rb(const bf16* src, const float* g, bf16* dst, const int wave0) {
    const int tid = fresh_tid(), lane = tid & 63, wave = __builtin_amdgcn_readfirstlane(tid >> 6), gw = blockIdx.x * NWAVES + wave, NGW = gridDim.x * NWAVES;
    for (int m = gw; m < M; m += NGW) { float v[16]; (void)rowb_rms_load(src + (size_t)m * D, g, lane, v); rowb_store_bf16(dst + (size_t)m * D, lane, v); }
}
__device__ __forceinline__ void ph_norm_bf16(const float* src, const float* g, bf16* dst, unsigned char* dst8, const int wave0) {
    const int tid = fresh_tid(), lane = tid & 63, wave = __builtin_amdgcn_readfirstlane(tid >> 6), gw = blockIdx.x * NWAVES + wave, NGW = gridDim.x * NWAVES;
    for (int m = gw; m < M; m += NGW) { f32x4 v[4]; (void)row_rms_load(src + (size_t)m * D, g, lane, v); row_store_bf16(dst + (size_t)m * D, lane, v); row_store_fp8(dst8 + (size_t)m * D, lane, v); }
}
__device__ __forceinline__ void ph_final_norm(const bf16* R, const float* g, float* out, const int wave0) {
    const int tid = fresh_tid(), lane = tid & 63, wave = __builtin_amdgcn_readfirstlane(tid >> 6), gw = blockIdx.x * NWAVES + wave, NGW = gridDim.x * NWAVES;
    f32x4 gg[4];
#pragma unroll
    for (int j = 0; j < 2; ++j) { gg[2 * j] = *(const GAS f32x4*)(g + 8 * lane + 512 * j); gg[2 * j + 1] = *(const GAS f32x4*)(g + 8 * lane + 512 * j + 4); }
    for (int m0 = gw; m0 < M; m0 += 2 * NGW) {
        v4u x[2][2], z[2][2], z0[2][2];
#pragma unroll
        for (int q = 0; q < 2; ++q)
#pragma unroll
            for (int j = 0; j < 2; ++j) { x[q][j] = *(const GAS v4u*)(R + (size_t)(m0 + q * NGW) * D + 8 * lane + 512 * j);
                z[q][j] = *(const GAS v4u*)((const bf16*)(out + (size_t)(m0 + q * NGW) * D + 512) + 8 * lane + 512 * j);
                z0[q][j] = *(const GAS v4u*)((const bf16*)(out + (size_t)(m0 + q * NGW) * D) + 8 * lane + 512 * j); }
#pragma unroll
        for (int q = 0; q < 2; ++q) { float v[16];
#pragma unroll
            for (int j = 0; j < 2; ++j) { const v4u w = x[q][j], y = z[q][j], y0 = z0[q][j];
                v[8 * j + 0] = bflo(w.x) + (bflo(y0.x) + bflo(y.x)); v[8 * j + 1] = bfhi(w.x) + (bfhi(y0.x) + bfhi(y.x)); v[8 * j + 2] = bflo(w.y) + (bflo(y0.y) + bflo(y.y)); v[8 * j + 3] = bfhi(w.y) + (bfhi(y0.y) + bfhi(y.y));
                v[8 * j + 4] = bflo(w.z) + (bflo(y0.z) + bflo(y.z)); v[8 * j + 5] = bfhi(w.z) + (bfhi(y0.z) + bfhi(y.z)); v[8 * j + 6] = bflo(w.w) + (bflo(y0.w) + bflo(y.w)); v[8 * j + 7] = bfhi(w.w) + (bfhi(y0.w) + bfhi(y.w)); }
            float s = 0.f;
#pragma unroll
            for (int k = 0; k < 16; ++k) s += v[k] * v[k];
            const float r = 1.0f / sqrtf(wave_sum(s, lane) * (1.f / D) + RMS_EPS);
            float* o = out + (size_t)(m0 + q * NGW) * D + 8 * lane;
#pragma unroll
            for (int j = 0; j < 2; ++j) { const f32x4 a = gg[2 * j], b = gg[2 * j + 1];
                *(GAS f32x4*)(o + 512 * j) = (f32x4){v[8 * j] * r * a.x, v[8 * j + 1] * r * a.y, v[8 * j + 2] * r * a.z, v[8 * j + 3] * r * a.w};
                *(GAS f32x4*)(o + 512 * j + 4) = (f32x4){v[8 * j + 4] * r * b.x, v[8 * j + 5] * r * b.y, v[8 * j + 6] * r * b.z, v[8 * j + 7] * r * b.w}; } }
    }
}

__device__ __forceinline__ void ph_kmean(const bf16* U, float* kmean, LAS unsigned char* lds, const int wave0) {
    const int tid = fresh_tid();
    LAS float* red = (LAS float*)lds;
    for (int task = blockIdx.x; task < HB * 8; task += gridDim.x) {
        const int bl = task >> 3, blk = task & 7, cg = tid & 31, rq = tid >> 5;
        const bf16* kp = U + ((size_t)bl * SEQ + blk * 256 + rq * 16) * UST + C_KA + 8 * cg;
        v4u x[16];
#pragma unroll
        for (int i = 0; i < 16; ++i) x[i] = *(const GAS v4u*)(kp + (size_t)i * UST);
        float sm[8];
#pragma unroll
        for (int k = 0; k < 8; ++k) sm[k] = 0.f;
#pragma unroll
        for (int i = 0; i < 16; ++i) { sm[0] += bflo(x[i].x); sm[1] += bfhi(x[i].x); sm[2] += bflo(x[i].y); sm[3] += bfhi(x[i].y); sm[4] += bflo(x[i].z); sm[5] += bfhi(x[i].z); sm[6] += bflo(x[i].w); sm[7] += bfhi(x[i].w); }
#pragma unroll
        for (int k = 0; k < 8; ++k) red[rq * 256 + 8 * cg + k] = sm[k];
        __syncthreads();
        if (tid < 256) { float t = 0.f;
#pragma unroll
            for (int q = 0; q < 16; ++q) t += red[q * 256 + tid];
            kmean[(size_t)task * 256 + tid] = t * (1.0f / 256.0f); }
        __syncthreads();
    }
}

__device__ __forceinline__ void ph_conv_pool(CArgs& args, int l, const bf16* U, bf16* Y, LAS unsigned char* lds, const int wave0) {
    const int tid = fresh_tid(), lane = tid & 63, wave = __builtin_amdgcn_readfirstlane(tid >> 6), gw = blockIdx.x * NWAVES + wave, NGW = gridDim.x * NWAVES;
    {
        const float* cw = args.in[4] + (size_t)l * 3 * 256; const int c0 = (lane & 31) * 8;
        float w0[8], w1[8], w2[8];
#pragma unroll
        for (int k = 0; k < 8; ++k) { w0[k] = cw[c0 + k]; w1[k] = cw[256 + c0 + k]; w2[k] = cw[512 + c0 + k]; }
        for (int ch = gw; ch < HROWS / 8; ch += NGW) {
            const int rl0 = ch * 8 + (lane >> 5) * 4, t = rl0 & (SEQ - 1);
            const bf16* up = U + (size_t)rl0 * UST; const int back = t > 0 ? 1 : 0; const float mb = t > 0 ? 1.f : 0.f;
            v4u xv[6], gv[6], bv[4];
#pragma unroll
            for (int k = 0; k < 6; ++k) { const long ro = (k < 2) ? (long)(k - 2) * back : (long)(k - 2); xv[k] = *(const GAS v4u*)(up + ro * UST + C_XB + c0); gv[k] = *(const GAS v4u*)(up + ro * UST + C_CB + c0); }
#pragma unroll
            for (int i = 0; i < 4; ++i) bv[i] = *(const GAS v4u*)(up + (size_t)i * UST + C_BB + c0);
            float uu[6][8];
#pragma unroll
            for (int k = 0; k < 6; ++k) { const float mk = (k < 2) ? mb : 1.f;
                uu[k][0] = mk * bflo(xv[k].x) * bflo(gv[k].x); uu[k][1] = mk * bfhi(xv[k].x) * bfhi(gv[k].x); uu[k][2] = mk * bflo(xv[k].y) * bflo(gv[k].y); uu[k][3] = mk * bfhi(xv[k].y) * bfhi(gv[k].y);
                uu[k][4] = mk * bflo(xv[k].z) * bflo(gv[k].z); uu[k][5] = mk * bfhi(xv[k].z) * bfhi(gv[k].z); uu[k][6] = mk * bflo(xv[k].w) * bflo(gv[k].w); uu[k][7] = mk * bfhi(xv[k].w) * bfhi(gv[k].w); }
#pragma unroll
            for (int i = 0; i < 4; ++i) { float cv[8];
#pragma unroll
                for (int k = 0; k < 8; ++k) cv[k] = w2[k] * uu[i + 2][k] + w1[k] * uu[i + 1][k] + w0[k] * uu[i][k];
                v4u w; w.x = pk2(cv[0] * bflo(bv[i].x), cv[1] * bfhi(bv[i].x)); w.y = pk2(cv[2] * bflo(bv[i].y), cv[3] * bfhi(bv[i].y)); w.z = pk2(cv[4] * bflo(bv[i].z), cv[5] * bfhi(bv[i].z)); w.w = pk2(cv[6] * bflo(bv[i].w), cv[7] * bfhi(bv[i].w));
                *(GAS v4u*)(Y + (size_t)(rl0 + i) * 1024 + 256 + c0) = w; }
        }
    }
    {
        const int gq = lane >> 4, c4 = (lane & 15) * 4, wlen = 2 << gq;
        for (int ch = gw; ch < HROWS / 8; ch += NGW) {
            const int rl0 = ch * 8, t0 = rl0 & (SEQ - 1); const bf16* pp = U + (size_t)rl0 * UST + C_PC + gq * 64 + c4;
            v2u xr[23];
#pragma unroll
            for (int i = 0; i < 23; ++i) { const int d = i - 15; const long ro = (t0 + d >= 0) ? (long)d : 0; xr[i] = *(const GAS v2u*)(pp + ro * UST); }
            float xf[23][4];
#pragma unroll
            for (int i = 0; i < 23; ++i) { const float mk = (t0 + i - 15 >= 0) ? 1.f : 0.f; xf[i][0] = mk * bflo(xr[i].x); xf[i][1] = mk * bfhi(xr[i].x); xf[i][2] = mk * bflo(xr[i].y); xf[i][3] = mk * bfhi(xr[i].y); }
#pragma unroll
            for (int tk = 0; tk < 8; ++tk) { float s0 = 0.f, s1 = 0.f, s2 = 0.f, s3 = 0.f;
#pragma unroll
                for (int j = 0; j < 16; ++j) { const float mk = j < wlen ? 1.f : 0.f; s0 += mk * xf[15 + tk - j][0]; s1 += mk * xf[15 + tk - j][1]; s2 += mk * xf[15 + tk - j][2]; s3 += mk * xf[15 + tk - j][3]; }
                const int t = t0 + tk; const int cnt = (t + 1) < wlen ? (t + 1) : wlen; const float ic = 1.0f / (float)cnt;
                v2u w; w.x = pk2(s0 * ic - xf[15 + tk][0], s1 * ic - xf[15 + tk][1]); w.y = pk2(s2 * ic - xf[15 + tk][2], s3 * ic - xf[15 + tk][3]);
                *(GAS v2u*)(Y + (size_t)(rl0 + tk) * 1024 + 512 + gq * 64 + c4) = w; }
        }
    }
    __syncthreads();
}

__device__ __forceinline__ void ph_attn(CArgs& args, int l, const bf16* U, const float* kmean, bf16* Y, LAS unsigned char* lds, const int wave0) {
    const float* dl = args.in[7] + (size_t)l * 128; const float* subg = args.in[8] + (size_t)l * 64;
    float a = 0.f, b = 0.f;
    for (int i = 0; i < 32; ++i) { a += dl[i] * dl[32 + i]; b += dl[64 + i] * dl[96 + i]; }
    int l_s = l; asm volatile("" : "+s"(l_s));
    const float lam_init = (l_s == 0) ? 0.2f : 0.35550906759096926f;
    const float lam = __expf(a) - __expf(b) + lam_init, outscale = 1.0f - lam_init;
    const LAS float* lut = (const LAS float*)(lds + LUT_OFF);
    for (int cu0 = blockIdx.x; cu0 < HB * 4 * 4; cu0 += gridDim.x) {
        const int cu = (gridDim.x == 256) ? ((cu0 & 7) * 32 + (cu0 >> 3)) : cu0;
        const int bh = cu >> 2, pr = cu & 3, bl = bh >> 2, h = bh & 3;
#pragma unroll 1
        for (int k = 0; k < 2; ++k) attn_unit<false>(U, kmean, Y, lut, lds, bl, h, k ? 7 - pr : pr, wave0, 0.f, 0.f, subg);
#pragma unroll 1
        for (int k = 0; k < 2; ++k) attn_unit<true>(U, kmean, Y, lut, lds, bl, h, k ? 7 - pr : pr, wave0, lam, outscale, subg);
    }
}

__device__ __forceinline__ void ph_route(CArgs& args, int l, const bf16* R, unsigned* route, int* tokp, gu32* ctl, LAS unsigned char* lds, const int wave0) {
    const int tid = fresh_tid(), lane = tid & 63, wave = __builtin_amdgcn_readfirstlane(tid >> 6), gw = blockIdx.x * NWAVES + wave, NGW = gridDim.x * NWAVES;
    const float* g = args.in[11] + (size_t)l * D;
    LAS float* rl = (LAS float*)lds;
    { const float* rw = args.in[15]; for (int i = tid; i < D * 8; i += NWAVES * 64) rl[i] = rw[i] * g[i >> 3]; }
    for (int i = blockIdx.x * NWAVES * 64 + tid; i < 2 * CAPROWS; i += gridDim.x * NWAVES * 64) tokp[i] = -1;
    __syncthreads();
    for (int m0 = gw; m0 < M; m0 += 4 * NGW) {
        v4u xr[4][2];
#pragma unroll
        for (int q = 0; q < 4; ++q)
#pragma unroll
            for (int j = 0; j < 2; ++j) xr[q][j] = *(const GAS v4u*)(R + (size_t)(m0 + q * NGW) * D + 8 * lane + 512 * j);
        int i0q[4], i1q[4]; float w0q[4], w1q[4], rq[4];
#pragma unroll
        for (int q = 0; q < 4; ++q) {
            float v[16], ss = 0.f;
#pragma unroll
            for (int j = 0; j < 2; ++j) { v[8 * j + 0] = bflo(xr[q][j].x); v[8 * j + 1] = bfhi(xr[q][j].x); v[8 * j + 2] = bflo(xr[q][j].y); v[8 * j + 3] = bfhi(xr[q][j].y); v[8 * j + 4] = bflo(xr[q][j].z); v[8 * j + 5] = bfhi(xr[q][j].z); v[8 * j + 6] = bflo(xr[q][j].w); v[8 * j + 7] = bfhi(xr[q][j].w); }
#pragma unroll
            for (int k = 0; k < 16; ++k) ss += v[k] * v[k];
            float lg[8];
#pragma unroll
            for (int e = 0; e < 8; ++e) lg[e] = 0.f;
#pragma unroll
            for (int j = 0; j < 2; ++j)
#pragma unroll
                for (int k = 0; k < 8; ++k) { const int c = 8 * lane + 512 * j + k; const f32x4 ra = *(const LAS f32x4*)(rl + c * 8), rb = *(const LAS f32x4*)(rl + c * 8 + 4); const float xv = v[8 * j + k];
                    lg[0] += xv * ra.x; lg[1] += xv * ra.y; lg[2] += xv * ra.z; lg[3] += xv * ra.w; lg[4] += xv * rb.x; lg[5] += xv * rb.y; lg[6] += xv * rb.z; lg[7] += xv * rb.w; }
#define RT_X(k_, val_) __int_as_float(__builtin_amdgcn_ds_bpermute((lane ^ (k_)) << 2, __float_as_int(val_)))
            { const bool b1 = (lane & 1) != 0, b2 = (lane & 2) != 0, b3 = (lane & 4) != 0;
              float a4[4], c2[2], d1;
#pragma unroll
              for (int i = 0; i < 4; ++i) { const float snd = b1 ? lg[i] : lg[4 + i], kp = b1 ? lg[4 + i] : lg[i]; a4[i] = kp + RT_X(1, snd); }
#pragma unroll
              for (int i = 0; i < 2; ++i) { const float snd = b2 ? a4[i] : a4[2 + i], kp = b2 ? a4[2 + i] : a4[i]; c2[i] = kp + RT_X(2, snd); }
              { const float snd = b3 ? c2[0] : c2[1], kp = b3 ? c2[1] : c2[0]; d1 = kp + RT_X(4, snd); }
              d1 += RT_X(8, d1); d1 += RT_X(16, d1); d1 += RT_X(32, d1);
              const float r = 1.0f / sqrtf(wave_sum(ss, lane) * (1.f / D) + RMS_EPS); rq[q] = r;
#pragma unroll
              for (int e = 0; e < 8; ++e) lg[e] = r * __int_as_float(__builtin_amdgcn_readlane(__float_as_int(d1), ((e >> 2) & 1) | (((e >> 1) & 1) << 1) | ((e & 1) << 2))); }
#undef RT_X
            int i0 = 0; float v0 = lg[0];
#pragma unroll
            for (int e = 1; e < 8; ++e) if (lg[e] > v0) { v0 = lg[e]; i0 = e; }
            int i1 = 0; float v1 = -3.0e38f;
#pragma unroll
            for (int e = 0; e < 8; ++e) if (e != i0 && lg[e] > v1) { v1 = lg[e]; i1 = e; }
            const float e1 = __expf(v1 - v0); w0q[q] = 1.0f / (1.0f + e1); w1q[q] = e1 * w0q[q]; i0q[q] = i0; i1q[q] = i1;
        }
        if (lane == 0) {
            unsigned s0[4], s1[4];
#pragma unroll
            for (int q = 0; q < 4; ++q) { s0[q] = atomicAdd((unsigned*)(ctl + CW_CNT + (0 * 8 + i0q[q]) * 64), 1u); s1[q] = atomicAdd((unsigned*)(ctl + CW_CNT + (1 * 8 + i1q[q]) * 64), 1u); }
#pragma unroll
            for (int q = 0; q < 4; ++q) { unsigned* rec = route + (size_t)(m0 + q * NGW) * 8; rec[0] = (unsigned)i0q[q] | ((unsigned)i1q[q] << 8); rec[1] = s0[q]; rec[2] = s1[q]; rec[3] = __float_as_uint(w0q[q]); rec[4] = __float_as_uint(w1q[q]); rec[5] = __float_as_uint(rq[q]); }
        }
    }
}

__device__ __forceinline__ void ph_gather(CArgs& args, int l, const bf16* R, const unsigned* route, int* tokp, float* gatep, int* tile_e, int* n_rt, unsigned char* hperm, gu32* ctl, LAS unsigned char* lds, const int wave0) {
    const int tid = fresh_tid(), lane = tid & 63, wave = __builtin_amdgcn_readfirstlane(tid >> 6), gw = blockIdx.x * NWAVES + wave, NGW = gridDim.x * NWAVES;
    const float* g = args.in[11] + (size_t)l * D;
    LAS int* base = (LAS int*)lds;
    if (tid < 2) { int acc = 0;
        for (int e = 0; e < 8; ++e) { base[tid * 8 + e] = acc; const int c = (int)__hip_atomic_load((unsigned*)(ctl + CW_CNT + (tid * 8 + e) * 64), RLX_AGENT); acc += (c + 255) & ~255; }
        base[16 + tid] = acc; }
    __syncthreads();
    if (blockIdx.x == 0 && tid < 2) { const int p = tid, nt = base[16 + p] >> 8; n_rt[p] = nt;
        for (int rt = 0; rt < nt; ++rt) { int e = 0; for (int k = 1; k < 8; ++k) if (rt * 256 >= base[p * 8 + k]) e = k; tile_e[p * 512 + rt] = e; } }
    for (int m0 = gw; m0 < M; m0 += 4 * NGW) {
        v4u xr[4][2]; unsigned ee[4], sl0[4], sl1[4], gw0[4], gw1[4], rs5[4];
#pragma unroll
        for (int q = 0; q < 4; ++q) { const size_t m = (size_t)(m0 + q * NGW);
#pragma unroll
            for (int j = 0; j < 2; ++j) xr[q][j] = *(const GAS v4u*)(R + m * D + 8 * lane + 512 * j);
            const unsigned* rec = route + m * 8; ee[q] = rec[0]; sl0[q] = rec[1]; sl1[q] = rec[2]; gw0[q] = rec[3]; gw1[q] = rec[4]; rs5[q] = rec[5]; }
#pragma unroll
        for (int q = 0; q < 4; ++q) { const int m = m0 + q * NGW;
            float v[16]; const float r = __uint_as_float(rs5[q]);
#pragma unroll
            for (int j = 0; j < 2; ++j) { const f32x4 g0 = *(const GAS f32x4*)(g + 8 * lane + 512 * j), g1 = *(const GAS f32x4*)(g + 8 * lane + 512 * j + 4); const v4u x = xr[q][j];
                v[8 * j + 0] = bflo(x.x) * (r * g0.x); v[8 * j + 1] = bfhi(x.x) * (r * g0.y); v[8 * j + 2] = bflo(x.y) * (r * g0.z); v[8 * j + 3] = bfhi(x.y) * (r * g0.w);
                v[8 * j + 4] = bflo(x.z) * (r * g1.x); v[8 * j + 5] = bfhi(x.z) * (r * g1.y); v[8 * j + 6] = bflo(x.w) * (r * g1.z); v[8 * j + 7] = bfhi(x.w) * (r * g1.w); }
            const int e0 = ee[q] & 255, e1 = (ee[q] >> 8) & 255;
            const int pos0 = base[e0] + (int)sl0[q], pos1 = base[8 + e1] + (int)sl1[q];
            rowb_store_fp8(hperm + (size_t)pos0 * D, lane, v); rowb_store_fp8(hperm + ((size_t)CAPROWS + pos1) * D, lane, v);
            if (lane == 0) { tokp[pos0] = m; tokp[CAPROWS + pos1] = m; gatep[pos0] = __uint_as_float(gw0[q]); gatep[CAPROWS + pos1] = __uint_as_float(gw1[q]); } }
    }
    __syncthreads();
}

__global__ void __launch_bounds__(NWAVES * 64, 2) mega_fwd(Args args0) {
    extern __shared__ __attribute__((aligned(16))) unsigned char lds_raw[];
    LAS unsigned char* lds = (LAS unsigned char*)lds_raw;
    volatile LAS unsigned* MISC = (volatile LAS unsigned*)(lds + MISC_OFF);
    const int G = gridDim.x;
    const int wave0 = __builtin_amdgcn_readfirstlane((int)(threadIdx.x >> 6));
    gu32* ctl = (gu32*)(args0.ws + WS_CTL);
    { const int tid = threadIdx.x;
      for (int i = tid; i < (LDS_BYTES - LDSCTL_OFF) / 4; i += NWAVES * 64) ((LAS unsigned*)(lds + LDSCTL_OFF))[i] = 0u;
      LAS float* lut = (LAS float*)(lds + LUT_OFF); const float* bt = args0.in[1];
      for (int i = tid; i < 8 * LUT_N; i += NWAVES * 64) { const int hd = i / LUT_N, n = i % LUT_N - LUT_NEG; lut[i] = (n < 0) ? -1.0e30f : 1.4426950408889634f * bt[(int)BKT[n > 128 ? 128 : n] * 8 + hd]; }
      if (tid < 256) { const float gv = __builtin_amdgcn_cvt_f32_fp8(tid, 0); ((LAS float*)(lds + SLUT_OFF))[tid] = 1.0f / (1.0f + __expf(-gv)); } }
    __syncthreads();
    XcdBarrier bar; bar.bar = (unsigned*)(ctl + CW_BAR) + args0.li * XCD_BAR_WORDS; bar.x = 0; bar.st = nullptr;
#if MK_ONE_LAUNCH
    bar = xcd_barrier_post((unsigned*)(ctl + CW_BAR) + args0.li * XCD_BAR_WORDS, MISC + 8);
#define GRID_BAR() xcd_barrier(bar)
#else
    (void)MISC;
#define GRID_BAR() do { } while (0)
#endif
    const int lo = args0.ph_lo, hi = args0.ph_hi;
#define IN(k) (lo <= (k) && (k) < hi)
#define BOTH(k) (IN(k) && IN((k) + 1))

#define OPQ_PTRS CArgs* ka_ = (CArgs*)__builtin_amdgcn_kernarg_segment_ptr(); asm volatile("" : "+s"(ka_)); CArgs& args = *ka_; unsigned char* ws = args.ws; bf16* R = (bf16*)(ws + WS_R); \
        bf16* Hn = (bf16*)(ws + WS_H); bf16* U = (bf16*)(ws + WS_U); bf16* Y = (bf16*)(ws + WS_Y); bf16* MG = (bf16*)(ws + WS_MG); float* kmean = (float*)(ws + WS_KMEAN); \
        unsigned* route = (unsigned*)(ws + WS_ROUTE); int* tokp = (int*)(ws + WS_TOK); float* gatep = (float*)(ws + WS_GATE); int* tile_e = (int*)(ws + WS_TILEE); int* n_rt = (int*)(ws + WS_TILEE + 4096); \
        (void)Hn; (void)U; (void)Y; (void)MG; (void)kmean; (void)route; (void)tokp; (void)gatep; (void)tile_e; (void)n_rt; (void)R
#define OPQ_I(name, v) int name = (v); asm volatile("" : "+s"(name))

    if (IN(0)) { OPQ_PTRS; ph_prologue(args, lds, wave0); ph_norm_bf16(args.in[0], args.in[2], Hn, ws + WS_A8, wave0); if (BOTH(0)) GRID_BAR(); }

    for (int l_ = 0; l_ < 2; ++l_) {
        const int pb = 1 + 17 * l_;
        for (int hf_ = 0; hf_ < 2; ++hf_) {
            const int p2 = pb + 1 + 5 * hf_;
            if (IN(p2)) {
                OPQ_PTRS; OPQ_I(l, l_); OPQ_I(hf, hf_); const size_t r0 = (size_t)hf * HROWS;
                const float* ssq1 = l == 0 ? (const float*)nullptr : (const float*)(ws + SSQ1_OFF) + r0 * 16;
                {
                    pg8::Gemm g{(l == 0 ? Hn : R) + r0 * D, (const bf16*)(ws + WS_WIN) + (size_t)l * GCOL0 * D, D, D, D};
                    pg8::Order S; S.init(HROWS / 256, GCOL0 / 256, G, (int)blockIdx.x, 0, D, D, nullptr, 0);
                    pg8::EpiWin E{U, UST, ssq1, 1 << 20, kmean, C_KA / 256};
                    pg8::gemm_phase<pg8::EpiWin, pg8::Order, true>(lds, fresh_tid(), g, S, E);
                }
                {
                    pg8::Gemm g{(const bf16*)(ws + WS_A8 + r0 * D), (const bf16*)(ws + WS_WG8 + (size_t)l * (WIN - GCOL0) * D), D / 2, D / 2, D / 2};
                    pg8::Order S; S.init(HROWS / 256, (WIN - GCOL0) / 256, G, (int)blockIdx.x, 0, D / 2, D / 2, nullptr, 0);
                    pg8::EpiGate8 E{(unsigned char*)U, 2 * UST, 2 * GCOL0, ssq1};
                    pg8::gemm_phase<pg8::EpiGate8, pg8::Order, true, true>(lds, fresh_tid(), g, S, E);
                }
                if (BOTH(p2)) GRID_BAR();
            }
            if (IN(p2 + 2)) {
                OPQ_PTRS; OPQ_I(l, l_);
                ph_conv_pool(args, l, U, Y, lds, wave0);
                ph_attn(args, l, U, kmean, Y, lds, wave0);
                if (BOTH(p2 + 2)) GRID_BAR();
            }
            if (IN(p2 + 3)) {
                OPQ_PTRS; OPQ_I(l, l_);
                pg8::Gemm g{Y, (const bf16*)(ws + WS_BP) + (size_t)l * 4 * D * 256, 1024, 256, 256};
                pg8::Order S; S.init(HROWS / 256, 4, G, (int)blockIdx.x, 1, 1024, 256, nullptr, (size_t)D * 256 * 2);
                pg8::EpiMerge E{U, UST, GCOL0, MG, 1024, (const LAS float*)(lds + SLUT_OFF)};
                pg8::gemm_phase<pg8::EpiMerge, pg8::Order, true>(lds, fresh_tid(), g, S, E);
                if (BOTH(p2 + 3)) GRID_BAR();
            }
            if (IN(p2 + 4)) {
                OPQ_PTRS; OPQ_I(l, l_); OPQ_I(hf, hf_); const size_t r0 = (size_t)hf * HROWS;
                pg8::Gemm g{MG, (const bf16*)(ws + WS_WOUT) + (size_t)l * D * D, D, D, D};
                pg8::Order S; S.init(HROWS / 256, 4, G, (int)blockIdx.x, 0, D, D, nullptr, 0);
                pg8::EpiRes E{args.in[0] + r0 * D, (l == 0) ? (const bf16*)nullptr : (const bf16*)(R + r0 * D), R + r0 * D, D, (l == 0) ? (float*)(ws + SSQ0_OFF) + r0 * 16 : (float*)nullptr};
                pg8::gemm_phase<pg8::EpiRes, pg8::Order, true>(lds, fresh_tid(), g, S, E);
                if (hf == 1 && BOTH(p2 + 4)) GRID_BAR();
            }
        }
        if (IN(pb + 11)) {
            OPQ_PTRS; OPQ_I(l, l_);
            if (l == 1) { ph_route(args, l, R, route, tokp, ctl, lds, wave0); if (BOTH(pb + 11)) GRID_BAR(); }
        }
        if (IN(pb + 12)) {
            OPQ_PTRS; OPQ_I(l, l_);
            if (l == 1) { ph_gather(args, l, R, route, tokp, gatep, tile_e, n_rt, ws + WS_HPERM, ctl, lds, wave0); if (BOTH(pb + 12)) GRID_BAR(); }
        }
        for (int ps_ = 0; ps_ < 2; ++ps_) {
            const int p3 = pb + 13 + 2 * ps_;
            if (IN(p3)) {
                OPQ_PTRS; OPQ_I(l, l_); OPQ_I(ps, ps_);
                if (l == 1) {
                    if (ps == 0) {
                        const int n0 = __builtin_amdgcn_readfirstlane(n_rt[0]), n1 = __builtin_amdgcn_readfirstlane(n_rt[1]);
                        pg8::Gemm g{(const bf16*)(ws + WS_HPERM), (const bf16*)(ws + WS_W13E), D / 2, D / 2, D / 2};
                        pg8::Order S; S.init(n0 + n1, 2 * FFE / 256, G, (int)blockIdx.x, 0, D / 2, D / 2, tile_e, (size_t)2 * FFE * D, n0, CAPT);
                        pg8::EpiSwiGLU8 E{ws + WS_TE, FFE, 256.0f, 8.0f};
                        pg8::gemm_phase<pg8::EpiSwiGLU8, pg8::Order, true, true>(lds, fresh_tid(), g, S, E);
                        if (BOTH(p3)) GRID_BAR();
                    }
                } else if (ps == 0) {
                    pg8::Gemm g{R, (const bf16*)(ws + WS_W13D), D, D, D};
                    pg8::Order S; S.init(M / 256, 2 * FF0 / 256, G, (int)blockIdx.x, 0, D, D, nullptr, 0);
                    pg8::EpiSwiGLU E{U, FF0, (const float*)(ws + SSQ0_OFF), 1};
                    pg8::gemm_phase<pg8::EpiSwiGLU, pg8::Order, true>(lds, fresh_tid(), g, S, E);
                    if (BOTH(p3)) GRID_BAR();
                }
            }
            if (IN(p3 + 1)) {
                OPQ_PTRS; OPQ_I(l, l_); OPQ_I(ps, ps_);
                if (l == 1) {
                    if (ps == 0) {
                        const int n0 = __builtin_amdgcn_readfirstlane(n_rt[0]), n1 = __builtin_amdgcn_readfirstlane(n_rt[1]);
                        pg8::Gemm g{(const bf16*)(ws + WS_TE), (const bf16*)(ws + WS_W2E), FFE / 2, FFE / 2, FFE / 2};
                        pg8::Order S; S.init(n0 + n1, 4, G, (int)blockIdx.x, 0, FFE / 2, FFE / 2, tile_e, (size_t)D * FFE, n0, CAPT);
                        pg8::EpiScatter E{R, D, tokp, gatep, 1.0f / 128.0f, nullptr, nullptr, (bf16*)args.out, 2048};
                        pg8::gemm_phase<pg8::EpiScatter, pg8::Order, true, true>(lds, fresh_tid(), g, S, E);
                        if (BOTH(p3 + 1)) GRID_BAR();
                    }
                } else if (ps == 0) {
                    pg8::Gemm g{U, (const bf16*)(ws + WS_W2D), FF0 / 2, FF0 / 2, FF0 / 2};
                    pg8::Order S; S.init(M / 256, 4, G, (int)blockIdx.x, 0, FF0 / 2, FF0 / 2, nullptr, 0);
                    pg8::EpiScatter E{R, D, nullptr, nullptr, 1.0f / 128.0f, (float*)(ws + SSQ1_OFF), ws + WS_A8, nullptr, 0};
                    pg8::gemm_phase<pg8::EpiScatter, pg8::Order, true, true>(lds, fresh_tid(), g, S, E);
                    if (BOTH(p3 + 1)) GRID_BAR();
                }
            }
        }
    }
    if (IN(35)) { OPQ_PTRS; ph_final_norm(R, args.in[19], args.out, wave0); }
#undef IN
#undef BOTH
}

extern "C" void kernel_launch(void* const* d_in, const int* in_sizes, int n_in, void* d_out, int out_size, void* d_ws, size_t ws_size, hipStream_t stream) {
    static int grid = 0;
    if (grid == 0) {
        if (n_in != 20 || in_sizes[0] != M * D || out_size != M * D || ws_size < WS_END) { fprintf(stderr, "kernel_launch: unexpected shapes / workspace (n_in %d, ws %zu); nothing launched\n", n_in, ws_size); grid = -1; return; }
        int dev = 0, cus = 0, per_cu = 0;
        if (hipGetDevice(&dev) != hipSuccess || hipDeviceGetAttribute(&cus, hipDeviceAttributeMultiprocessorCount, dev) != hipSuccess) { grid = -1; return; }
        if (hipFuncSetAttribute((const void*)mega_fwd, hipFuncAttributeMaxDynamicSharedMemorySize, LDS_BYTES) != hipSuccess) { fprintf(stderr, "kernel_launch: hipFuncSetAttribute failed\n"); grid = -1; return; }
        if (hipOccupancyMaxActiveBlocksPerMultiprocessor(&per_cu, (const void*)mega_fwd, NWAVES * 64, LDS_BYTES) != hipSuccess || per_cu < 1) { fprintf(stderr, "kernel_launch: occupancy query reports %d\n", per_cu); }
        (void)hipGetLastError();
        grid = cus;
    }
    if (grid < 0) return;
    if (hipMemsetAsync((char*)d_ws + WS_CTL, 0, CTL_ZERO_BYTES, stream) != hipSuccess) return;
    Args a{};
    for (int i = 0; i < 20; ++i) a.in[i] = (const float*)d_in[i];
    a.out = (float*)d_out; a.ws = (unsigned char*)d_ws;
#if MK_ONE_LAUNCH
#ifdef PROBE_DUP
    { const int dup[] = {PROBE_DUP}; const int nd = (int)(sizeof(dup) / sizeof(int)); int lo = 0;
      for (int i = 0; i <= nd; ++i) { a.ph_lo = lo; a.ph_hi = (i < nd) ? dup[i] + 1 : 36; a.li = i; hipLaunchKernelGGL(mega_fwd, dim3(grid), dim3(NWAVES * 64), LDS_BYTES, stream, a); if (i < nd) lo = dup[i]; } }
#else
    a.ph_lo = 0; a.ph_hi = 36;
    hipLaunchKernelGGL(mega_fwd, dim3(grid), dim3(NWAVES * 64), LDS_BYTES, stream, a);
#endif
#else
    for (int p = 0; p < 36; ++p) {
        if (p == 1 + 12 || p == 1 + 15 || p == 1 + 16) continue;
        a.ph_lo = p; a.ph_hi = p + 1;
        hipLaunchKernelGGL(mega_fwd, dim3(grid), dim3(NWAVES * 64), LDS_BYTES, stream, a);
    }
#endif
}
```

```cpp
#include <hip/hip_runtime.h>
#include <cstdio>
#include <cstdint>

#ifndef MK_ONE_LAUNCH
#define MK_ONE_LAUNCH 1
#endif

namespace pg8 {
#define PG8_LAS __attribute__((address_space(3)))
typedef unsigned short bf16_t;
typedef short bf16x8 __attribute__((ext_vector_type(8)));
typedef float f32x4 __attribute__((ext_vector_type(4)));
typedef unsigned u32x4 __attribute__((ext_vector_type(4)));
typedef unsigned u32x2 __attribute__((ext_vector_type(2)));
typedef int i32x4 __attribute__((ext_vector_type(4)));
typedef int i32x8 __attribute__((ext_vector_type(8)));
constexpr int BM = 256, BK = 64, HALF = 128, HTB = HALF * BK * 2  , STAGE_BYTES = 8 * HTB, NXCD = 8, WGM = 8;

__host__ __device__ __forceinline__ int lds_byte(int r, int c) { const int st = (r >> 4) * 2 + (c >> 5), rr = r & 15, cc = c & 31, ob = rr * 64 + cc * 2; return st * 1024 + (ob ^ (((ob >> 9) & 1) << 5)); }
__host__ __device__ __forceinline__ void stage_rc(int b, int& R, int& C) { const int st = b / 1024, sb = b % 1024, swz = sb ^ (((sb >> 9) & 1) << 5); R = (st >> 1) * 16 + swz / 64; C = (st & 1) * 32 + (swz % 64) / 2; }
__host__ __device__ __forceinline__ int perm32(int rho) { const int n = rho >> 4, i = rho & 15; return 8 * (i >> 2) + 4 * n + (i & 3); }

struct Unit { int pm, pn, e, prow, second; size_t aoff, boff; };
struct Gemm { const bf16_t* A; const bf16_t* Bt; int lda, ldb, K; };

struct Order {
    int nM, nN, nwg, G, c, mode, n0, skip; size_t arow  , brow  , estride; const int* tile_e;
    __device__ __forceinline__ void init(int nM_, int nN_, int G_, int c_, int mode_, int lda, int ldb, const int* te, size_t es, int n0_ = 1 << 30, int skip_ = 0) {
        nM = nM_; nN = nN_; nwg = nM * nN; G = G_; c = c_; mode = mode_; arow = (size_t)BM * lda * 2; brow = (size_t)BM * ldb * 2; tile_e = te; estride = es; n0 = n0_; skip = skip_; }
    __device__ __forceinline__ bool base(int i, Unit& u) const {
        const long L = (long)i * G + c; if (L >= nwg) return false;
        int wgid = (int)L; { const int q = nwg / NXCD, r = nwg % NXCD, xcd = wgid % NXCD, off = wgid / NXCD; wgid = (xcd < r ? xcd * (q + 1) : r * (q + 1) + (xcd - r) * q) + off; }
        const int nig = WGM * nN, gid = wgid / nig, fm = gid * WGM, gsz = (nM - fm) < WGM ? (nM - fm) : WGM;
        u.pm = fm + ((wgid % nig) % gsz); u.pn = (wgid % nig) / gsz; return true;
    }
    __device__ __forceinline__ bool next(int i, Unit& u) const {
        if (mode == 1) { if (!base(i >> 2, u)) return false; u.e = i & 3; u.prow = u.pm; u.second = 0; u.aoff = (size_t)u.pm * arow + (size_t)u.e * 512; u.boff = (size_t)u.e * estride + (size_t)u.pn * brow; return true; }
        if (!base(i, u)) return false;
        const bool second = u.pm >= n0; u.prow = second ? skip + (u.pm - n0) : u.pm; u.second = second ? 1 : 0;
        u.e = tile_e ? __builtin_amdgcn_readfirstlane(tile_e[second ? 512 + (u.pm - n0) : u.pm]) : 0; u.aoff = (size_t)u.prow * arow; u.boff = (size_t)u.e * estride + (size_t)u.pn * brow; return true;
    }
    __device__ __forceinline__ void a_ready(const Unit&) const {}
    __device__ __forceinline__ void done(const Unit&) const {}
};

__device__ __forceinline__ int fresh_lane() { int lane; asm volatile("v_mbcnt_lo_u32_b32 %0, -1, 0\n\tv_mbcnt_hi_u32_b32 %0, -1, %0" : "=v"(lane)); return lane; }
typedef float f32x2p __attribute__((ext_vector_type(2)));
typedef __bf16 bf16x2p __attribute__((ext_vector_type(2)));
__device__ __forceinline__ unsigned cvt_pk_bf16(float lo, float hi) { const f32x2p f = {lo, hi}; const bf16x2p b = __builtin_convertvector(f, bf16x2p); return __builtin_bit_cast(unsigned, b); }
__device__ __forceinline__ float bflo(unsigned w) { return __uint_as_float(w << 16); }
__device__ __forceinline__ float bfhi(unsigned w) { return __uint_as_float(w & 0xffff0000u); }
__device__ __forceinline__ float sigmoidf_(float x) { return __builtin_amdgcn_rcpf(1.0f + __expf(-x)); }

__device__ __forceinline__ void ssq_put(float* ssq, int row, int slot, float part, int lane_) {
    part += __int_as_float(__builtin_amdgcn_ds_bpermute((lane_ ^ 16) << 2, __float_as_int(part)));
    part += __int_as_float(__builtin_amdgcn_ds_bpermute((lane_ ^ 32) << 2, __float_as_int(part)));
    if (lane_ < 16) ssq[(size_t)row * 16 + slot] = part;
}
__device__ __forceinline__ float ssq_rs(const float* ssq, int row) {
    const f32x4* p = (const f32x4*)(ssq + (size_t)row * 16); const f32x4 a = p[0], b = p[1], c = p[2], d = p[3];
    const float t = (((a[0] + a[1]) + (a[2] + a[3])) + ((b[0] + b[1]) + (b[2] + b[3]))) + (((c[0] + c[1]) + (c[2] + c[3])) + ((d[0] + d[1]) + (d[2] + d[3])));
    return __builtin_amdgcn_rsqf(t * (1.0f / 1024.0f) + 1e-6f);
}
__device__ __forceinline__ float ssq_ms(const float* ssq, int row) {
    const f32x4* p = (const f32x4*)(ssq + (size_t)row * 16); const f32x4 a = p[0], b = p[1], c = p[2], d = p[3];
    const float t = (((a[0] + a[1]) + (a[2] + a[3])) + ((b[0] + b[1]) + (b[2] + b[3]))) + (((c[0] + c[1]) + (c[2] + c[3])) + ((d[0] + d[1]) + (d[2] + d[3])));
    return t * (1.0f / 1024.0f) + 1e-6f;
}
struct EpiWin {
    static constexpr bool PERM = true, AFTER_DRAIN = false;
    bf16_t* O; int ldc; const float* ssq; int gate_pn; float* kmp; int kpn;
    __device__ __forceinline__ void operator()(const f32x4 (&acc)[2][2][4][2], const Unit& u, int wr, int wc, int, int) const {
        const int lane_ = fresh_lane(), fr = lane_ & 15, fq = lane_ >> 4;
        const int row0 = u.pm * BM + wr * 64 + fr, col0 = u.pn * BM + wc * 32 + 8 * fq; const bool gt = u.pn >= gate_pn;
        const bool km = (u.pn == kpn); float cs[2][8];
#pragma unroll
        for (int b_ = 0; b_ < 2; ++b_)
#pragma unroll
            for (int k_ = 0; k_ < 8; ++k_) cs[b_][k_] = 0.f;
#pragma unroll
        for (int ai = 0; ai < 2; ++ai)
#pragma unroll
            for (int m = 0; m < 4; ++m) { const int r = row0 + ai * HALF + m * 16; bf16_t* rowp = O + (size_t)r * ldc;
                const float rs = ssq ? ssq_rs(ssq, r) : 1.0f;
#pragma unroll
                for (int bj = 0; bj < 2; ++bj) { const f32x4 v0 = acc[ai][bj][m][0] * rs, v1 = acc[ai][bj][m][1] * rs;
                    if (km) { cs[bj][0] += v0[0]; cs[bj][1] += v0[1]; cs[bj][2] += v0[2]; cs[bj][3] += v0[3]; cs[bj][4] += v1[0]; cs[bj][5] += v1[1]; cs[bj][6] += v1[2]; cs[bj][7] += v1[3]; }
                    if (gt) { u32x2 w; { int t_ = 0; t_ = __builtin_amdgcn_cvt_pk_fp8_f32(v0[0], v0[1], t_, false); t_ = __builtin_amdgcn_cvt_pk_fp8_f32(v0[2], v0[3], t_, true); w.x = (unsigned)t_; }
                        { int t_ = 0; t_ = __builtin_amdgcn_cvt_pk_fp8_f32(v1[0], v1[1], t_, false); t_ = __builtin_amdgcn_cvt_pk_fp8_f32(v1[2], v1[3], t_, true); w.y = (unsigned)t_; }
                        *(u32x2*)((unsigned char*)rowp + 512 * gate_pn + (col0 - BM * gate_pn) + bj * HALF) = w; }
                    else { u32x4 w; w.x = cvt_pk_bf16(v0[0], v0[1]); w.y = cvt_pk_bf16(v0[2], v0[3]); w.z = cvt_pk_bf16(v1[0], v1[1]); w.w = cvt_pk_bf16(v1[2], v1[3]);
                        *(u32x4*)(rowp + col0 + bj * HALF) = w; } } }
        if (km) {
#pragma unroll
            for (int b_ = 0; b_ < 2; ++b_)
#pragma unroll
                for (int k_ = 0; k_ < 8; ++k_) { float x = cs[b_][k_];
#pragma unroll
                    for (int o_ = 1; o_ < 16; o_ <<= 1) x += __int_as_float(__builtin_amdgcn_ds_bpermute((lane_ ^ o_) << 2, __float_as_int(x)));
                    cs[b_][k_] = x; }
            if (fr == 0) { float* kp = kmp + ((size_t)u.pm * 2 + wr) * 256 + wc * 32 + 8 * fq;
#pragma unroll
                for (int b_ = 0; b_ < 2; ++b_) { *(f32x4*)(kp + b_ * HALF) = (f32x4){cs[b_][0], cs[b_][1], cs[b_][2], cs[b_][3]}; *(f32x4*)(kp + b_ * HALF + 4) = (f32x4){cs[b_][4], cs[b_][5], cs[b_][6], cs[b_][7]}; } }
        }
    }
};
struct EpiMerge {
    static constexpr bool PERM = true, AFTER_DRAIN = false;
    const bf16_t* U; int ldu, gcol0; bf16_t* O; int ldc; const PG8_LAS float* slut;
    __device__ __forceinline__ void operator()(const f32x4 (&acc)[2][2][4][2], const Unit& u, int wr, int wc, int, int) const {
        const int lane_ = fresh_lane(), fr = lane_ & 15, fq = lane_ >> 4;
        const int row0 = u.pm * BM + wr * 64 + fr, col0 = u.pn * BM + wc * 32 + 8 * fq;
        typedef float f32x2g __attribute__((ext_vector_type(2)));
        const __amdgpu_buffer_rsrc_t rsrc = __builtin_amdgcn_make_buffer_rsrc((void*)O, 0, 0x7fffffff, 0x00020000);
#pragma unroll
        for (int ai = 0; ai < 2; ++ai) {
            u32x2 gq[4][2]; u32x4 pq[4][2];
#pragma unroll
            for (int m = 0; m < 4; ++m) { const size_t r = (size_t)(row0 + ai * HALF + m * 16); const unsigned char* gp = (const unsigned char*)(U + r * ldu) + 2 * gcol0 + u.e * 1024 + col0; const bf16_t* rowp = O + r * ldc + col0;
#pragma unroll
                for (int bj = 0; bj < 2; ++bj) { gq[m][bj] = *(const u32x2*)(gp + bj * HALF); if (u.e != 0) pq[m][bj] = __builtin_bit_cast(u32x4, __builtin_amdgcn_raw_buffer_load_b128(rsrc, (int)((r * ldc + col0 + bj * HALF) * 2), 0, 16  )); else pq[m][bj] = (u32x4){0u, 0u, 0u, 0u}; } }
#pragma unroll
            for (int m = 0; m < 4; ++m) { const size_t r = (size_t)(row0 + ai * HALF + m * 16); bf16_t* rowp = O + r * ldc + col0;
#pragma unroll
                for (int bj = 0; bj < 2; ++bj) { const f32x4 a0 = acc[ai][bj][m][0], a1 = acc[ai][bj][m][1]; const u32x2 g = gq[m][bj]; const u32x4 p = pq[m][bj];
                    const float s0 = slut[g.x & 0xffu], s1 = slut[(g.x >> 8) & 0xffu], s2 = slut[(g.x >> 16) & 0xffu], s3 = slut[g.x >> 24], s4 = slut[g.y & 0xffu], s5 = slut[(g.y >> 8) & 0xffu], s6 = slut[(g.y >> 16) & 0xffu], s7 = slut[g.y >> 24];
                    const float v0 = a0[0] * s0 + bflo(p.x), v1 = a0[1] * s1 + bfhi(p.x), v2 = a0[2] * s2 + bflo(p.y), v3 = a0[3] * s3 + bfhi(p.y);
                    const float v4 = a1[0] * s4 + bflo(p.z), v5 = a1[1] * s5 + bfhi(p.z), v6 = a1[2] * s6 + bflo(p.w), v7 = a1[3] * s7 + bfhi(p.w);
                    u32x4 w; w.x = cvt_pk_bf16(v0, v1); w.y = cvt_pk_bf16(v2, v3); w.z = cvt_pk_bf16(v4, v5); w.w = cvt_pk_bf16(v6, v7);
                    *(u32x4*)(rowp + bj * HALF) = w; } }
        }
    }
};
struct EpiRes {
    static constexpr bool PERM = true, AFTER_DRAIN = false;
    const float* base; const bf16_t* bb; bf16_t* out; int ldc; float* ssq;
    __device__ __forceinline__ void operator()(const f32x4 (&acc)[2][2][4][2], const Unit& u, int wr, int wc, int, int) const {
        const int lane_ = fresh_lane(), fr = lane_ & 15, fq = lane_ >> 4;
        const int row0 = u.pm * BM + wr * 64 + fr, col0 = u.pn * BM + wc * 32 + 8 * fq;
        const __amdgpu_buffer_rsrc_t rsrc = __builtin_amdgcn_make_buffer_rsrc((void*)(bb ? bb : out), 0, 0x7fffffff, 0x00020000);
#pragma unroll
        for (int ai = 0; ai < 2; ++ai)
#pragma unroll
            for (int mh = 0; mh < 2; ++mh) {
                f32x4 b0[2][2], b1[2][2];
#pragma unroll
                for (int mm = 0; mm < 2; ++mm) { const size_t off = (size_t)(row0 + ai * HALF + (2 * mh + mm) * 16) * ldc + col0;
#pragma unroll
                    for (int bj = 0; bj < 2; ++bj) {
                        if (bb) { const u32x4 p = __builtin_bit_cast(u32x4, __builtin_amdgcn_raw_buffer_load_b128(rsrc, (int)((off + bj * HALF) * 2), 0, 16  )); b0[mm][bj] = (f32x4){bflo(p.x), bfhi(p.x), bflo(p.y), bfhi(p.y)}; b1[mm][bj] = (f32x4){bflo(p.z), bfhi(p.z), bflo(p.w), bfhi(p.w)}; }
                        else { b0[mm][bj] = *(const f32x4*)(base + off + bj * HALF); b1[mm][bj] = *(const f32x4*)(base + off + bj * HALF + 4); } } }
#pragma unroll
                for (int mm = 0; mm < 2; ++mm) { const int m = 2 * mh + mm; const size_t off = (size_t)(row0 + ai * HALF + m * 16) * ldc + col0; float sq = 0.f;
#pragma unroll
                    for (int bj = 0; bj < 2; ++bj) { const f32x4 v0 = acc[ai][bj][m][0] + b0[mm][bj], v1 = acc[ai][bj][m][1] + b1[mm][bj];
                        sq += (v0[0] * v0[0] + v0[1] * v0[1]) + (v0[2] * v0[2] + v0[3] * v0[3]) + (v1[0] * v1[0] + v1[1] * v1[1]) + (v1[2] * v1[2] + v1[3] * v1[3]);
                        u32x4 w; w.x = cvt_pk_bf16(v0[0], v0[1]); w.y = cvt_pk_bf16(v0[2], v0[3]); w.z = cvt_pk_bf16(v1[0], v1[1]); w.w = cvt_pk_bf16(v1[2], v1[3]);
                        *(u32x4*)(out + off + bj * HALF) = w; }
                    if (ssq) ssq_put(ssq, row0 + ai * HALF + m * 16, u.pn * 4 + wc, sq, lane_); }
            }
    }
};
__device__ __forceinline__ unsigned cvt4_fp8(float a, float b, float c, float d) { int w = 0; w = __builtin_amdgcn_cvt_pk_fp8_f32(a, b, w, false); w = __builtin_amdgcn_cvt_pk_fp8_f32(c, d, w, true); return (unsigned)w; }
__device__ __forceinline__ u32x4 pair16(u32x2 wa, u32x2 wb) {
    typedef unsigned u2_ __attribute__((ext_vector_type(2)));
    const u2_ s0 = __builtin_amdgcn_permlane16_swap(wa.x, wb.x, false, false), s1 = __builtin_amdgcn_permlane16_swap(wa.y, wb.y, false, false);
    return (u32x4){s0.x, s1.x, s0.y, s1.y};
}
struct EpiSwiGLU {
    static constexpr bool PERM = true, AFTER_DRAIN = false;
    bf16_t* T; int ldt; const float* ssq; int f8;
    __device__ __forceinline__ void calc(const f32x4 (&acc)[2][2][4][2], int ai, int m, int r, float (&v)[8]) const {
        const float q = ssq ? ssq_ms(ssq, r) : 1.0f; const float nk = -1.44269504f * __builtin_amdgcn_rsqf(q);
        const float qd = f8 ? 0.25f * q : q; const f32x2p nk2 = {nk, nk}, q2 = {qd, qd};
#pragma unroll
        for (int n = 0; n < 2; ++n)
#pragma unroll
            for (int h = 0; h < 2; ++h) { const f32x2p a2 = {acc[ai][0][m][n][2 * h], acc[ai][0][m][n][2 * h + 1]}, b2 = {acc[ai][1][m][n][2 * h], acc[ai][1][m][n][2 * h + 1]};
                const f32x2p x2 = a2 * nk2; const f32x2p e2 = {__builtin_amdgcn_exp2f(x2[0]), __builtin_amdgcn_exp2f(x2[1])};
                const f32x2p d2 = e2 * q2 + q2; const f32x2p r2 = {__builtin_amdgcn_rcpf(d2[0]), __builtin_amdgcn_rcpf(d2[1])};
                const f32x2p v2 = (a2 * b2) * r2; v[n * 4 + 2 * h] = v2[0]; v[n * 4 + 2 * h + 1] = v2[1]; }
    }
    __device__ __forceinline__ void operator()(const f32x4 (&acc)[2][2][4][2], const Unit& u, int wr, int wc, int, int) const {
        const int lane_ = fresh_lane(), fr = lane_ & 15, fq = lane_ >> 4;
        const int row0 = u.pm * BM + wr * 64 + fr, col0 = u.pn * HALF + wc * 32 + 8 * fq;
#pragma unroll
        for (int ai = 0; ai < 2; ++ai)
#pragma unroll
            for (int mp = 0; mp < 2; ++mp) { const int ra = row0 + ai * HALF + (2 * mp) * 16, rb = ra + 16; float va[8], vb[8];
                calc(acc, ai, 2 * mp, ra, va); calc(acc, ai, 2 * mp + 1, rb, vb);
                if (f8) {
                    u32x2 wa, wb; wa.x = cvt4_fp8(va[0], va[1], va[2], va[3]); wa.y = cvt4_fp8(va[4], va[5], va[6], va[7]); wb.x = cvt4_fp8(vb[0], vb[1], vb[2], vb[3]); wb.y = cvt4_fp8(vb[4], vb[5], vb[6], vb[7]);
                    const u32x4 w16 = pair16(wa, wb);
                    *(u32x4*)((unsigned char*)T + (size_t)((fq & 1) ? rb : ra) * ldt + u.pn * HALF + wc * 32 + 8 * (fq & 2)) = w16; }
                else { u32x4 w; w.x = cvt_pk_bf16(va[0], va[1]); w.y = cvt_pk_bf16(va[2], va[3]); w.z = cvt_pk_bf16(va[4], va[5]); w.w = cvt_pk_bf16(va[6], va[7]); *(u32x4*)(T + (size_t)ra * ldt + col0) = w;
                    w.x = cvt_pk_bf16(vb[0], vb[1]); w.y = cvt_pk_bf16(vb[2], vb[3]); w.z = cvt_pk_bf16(vb[4], vb[5]); w.w = cvt_pk_bf16(vb[6], vb[7]); *(u32x4*)(T + (size_t)rb * ldt + col0) = w; } }
    }
};
struct EpiSwiGLU8 {
    static constexpr bool PERM = true, AFTER_DRAIN = false;
    unsigned char* T; int ldt; float cc, lc;
    __device__ __forceinline__ u32x2 calc(const f32x4 (&acc)[2][2][4][2], int ai, int m) const {
        float v[8];
        const f32x2p nk2 = {-1.44269504f * 0.03125f, -1.44269504f * 0.03125f}, l2 = {lc, lc}, c2 = {cc, cc};
#pragma unroll
        for (int n = 0; n < 2; ++n)
#pragma unroll
            for (int h = 0; h < 2; ++h) { const f32x2p a2 = {acc[ai][0][m][n][2 * h], acc[ai][0][m][n][2 * h + 1]}, b2 = {acc[ai][1][m][n][2 * h], acc[ai][1][m][n][2 * h + 1]};
                const f32x2p x2 = a2 * nk2 + l2; const f32x2p e2 = {__builtin_amdgcn_exp2f(x2[0]), __builtin_amdgcn_exp2f(x2[1])};
                const f32x2p d2 = e2 + c2; const f32x2p r2 = {__builtin_amdgcn_rcpf(d2[0]), __builtin_amdgcn_rcpf(d2[1])};
                const f32x2p v2 = (a2 * b2) * r2; v[n * 4 + 2 * h] = v2[0]; v[n * 4 + 2 * h + 1] = v2[1]; }
        u32x2 w; w.x = cvt4_fp8(v[0], v[1], v[2], v[3]); w.y = cvt4_fp8(v[4], v[5], v[6], v[7]); return w;
    }
    __device__ __forceinline__ void operator()(const f32x4 (&acc)[2][2][4][2], const Unit& u, int wr, int wc, int, int) const {
        const int lane_ = fresh_lane(), fr = lane_ & 15, fq = lane_ >> 4;
        const int row0 = u.prow * BM + wr * 64 + fr;
#pragma unroll
        for (int ai = 0; ai < 2; ++ai)
#pragma unroll
            for (int mp = 0; mp < 2; ++mp) {
                const u32x4 w16 = pair16(calc(acc, ai, 2 * mp), calc(acc, ai, 2 * mp + 1));
                *(u32x4*)(T + (size_t)(row0 + ai * HALF + (2 * mp + (fq & 1)) * 16) * ldt + u.pn * HALF + wc * 32 + 8 * (fq & 2)) = w16; }
    }
};
struct EpiGate8 {
    static constexpr bool PERM = true, AFTER_DRAIN = false;
    unsigned char* O; int ldo, goff; const float* ssq;
    __device__ __forceinline__ void operator()(const f32x4 (&acc)[2][2][4][2], const Unit& u, int wr, int wc, int, int) const {
        const int lane_ = fresh_lane(), fr = lane_ & 15, fq = lane_ >> 4;
        const int row0 = u.pm * BM + wr * 64 + fr;
#pragma unroll
        for (int ai = 0; ai < 2; ++ai)
#pragma unroll
            for (int m = 0; m < 4; ++m) { const int r = row0 + ai * HALF + m * 16;
                const float rs = (ssq ? ssq_rs(ssq, r) : 1.0f) * 0.03125f;
                u32x2 w[2];
#pragma unroll
                for (int bj = 0; bj < 2; ++bj) { const f32x4 v0 = acc[ai][bj][m][0] * rs, v1 = acc[ai][bj][m][1] * rs; w[bj].x = cvt4_fp8(v0[0], v0[1], v0[2], v0[3]); w[bj].y = cvt4_fp8(v1[0], v1[1], v1[2], v1[3]); }
                *(u32x4*)(O + (size_t)r * ldo + goff + u.pn * BM + (fq & 1) * HALF + wc * 32 + 8 * (fq & 2)) = pair16(w[0], w[1]); }
    }
};
struct EpiScatter {
    static constexpr bool PERM = true, AFTER_DRAIN = false;
    bf16_t* R; int ldc; const int* tok; const float* gate; float scale; float* ssq; unsigned char* r8; bf16_t* Z; int ldz;
    __device__ __forceinline__ void operator()(const f32x4 (&acc)[2][2][4][2], const Unit& u, int wr, int wc, int, int) const {
        const int lane_ = fresh_lane(), fr = lane_ & 15, fq = lane_ >> 4;
        const int row0 = u.prow * BM + wr * 64 + fr, col0 = u.pn * BM + wc * 32 + 8 * fq;
        if (Z) {
#pragma unroll
            for (int ai = 0; ai < 2; ++ai)
#pragma unroll
                for (int m = 0; m < 4; ++m) { const int r = row0 + ai * HALF + m * 16; const int t = tok[r]; const float g = gate[r] * scale;
                    if (t >= 0) { bf16_t* zp = Z + (size_t)t * ldz + u.second * 1024 + col0;
#pragma unroll
                        for (int bj = 0; bj < 2; ++bj) { const f32x4 a0 = acc[ai][bj][m][0] * g, a1 = acc[ai][bj][m][1] * g;
                            u32x4 w; w.x = cvt_pk_bf16(a0[0], a0[1]); w.y = cvt_pk_bf16(a0[2], a0[3]); w.z = cvt_pk_bf16(a1[0], a1[1]); w.w = cvt_pk_bf16(a1[2], a1[3]);
                            *(u32x4*)(zp + bj * HALF) = w; } } }
            return; }
        const __amdgpu_buffer_rsrc_t rsrc = __builtin_amdgcn_make_buffer_rsrc((void*)R, 0, 0x7fffffff, 0x00020000);
        int tk[2][4]; float gg[2][4];
#pragma unroll
        for (int ai = 0; ai < 2; ++ai)
#pragma unroll
            for (int m = 0; m < 4; ++m) { const int r = row0 + ai * HALF + m * 16; tk[ai][m] = tok ? tok[r] : r; gg[ai][m] = tok ? gate[r] * scale : scale; }
#pragma unroll
        for (int ai = 0; ai < 2; ++ai) {
            u32x4 pq[4][2];
#pragma unroll
            for (int m = 0; m < 4; ++m) { const int t = tk[ai][m] < 0 ? 0 : tk[ai][m]; const bf16_t* rp = R + (size_t)t * ldc + col0;
#pragma unroll
                for (int bj = 0; bj < 2; ++bj) pq[m][bj] = __builtin_bit_cast(u32x4, __builtin_amdgcn_raw_buffer_load_b128(rsrc, (int)(((size_t)t * ldc + col0 + bj * HALF) * 2), 0, 16  )); (void)rp; }
#pragma unroll
            for (int m = 0; m < 4; ++m) { const int t = tk[ai][m]; const float g = gg[ai][m];
                if (t >= 0) { bf16_t* rp = R + (size_t)t * ldc + col0; float sq = 0.f;
#pragma unroll
                    for (int bj = 0; bj < 2; ++bj) { const u32x4 p = pq[m][bj]; const f32x4 a0 = acc[ai][bj][m][0] * g, a1 = acc[ai][bj][m][1] * g;
                        const float e0 = bflo(p.x) + a0[0], e1 = bfhi(p.x) + a0[1], e2 = bflo(p.y) + a0[2], e3 = bfhi(p.y) + a0[3], e4 = bflo(p.z) + a1[0], e5 = bfhi(p.z) + a1[1], e6 = bflo(p.w) + a1[2], e7 = bfhi(p.w) + a1[3];
                        sq += (e0 * e0 + e1 * e1) + (e2 * e2 + e3 * e3) + (e4 * e4 + e5 * e5) + (e6 * e6 + e7 * e7);
                        u32x4 w; w.x = cvt_pk_bf16(e0, e1); w.y = cvt_pk_bf16(e2, e3); w.z = cvt_pk_bf16(e4, e5); w.w = cvt_pk_bf16(e6, e7);
                        *(u32x4*)(rp + bj * HALF) = w;
                        if (r8) { u32x2 w8; w8.x = cvt4_fp8(e0, e1, e2, e3); w8.y = cvt4_fp8(e4, e5, e6, e7); *(u32x2*)(r8 + (size_t)t * 1024 + col0 + bj * HALF) = w8; } }
                    if (ssq) ssq_put(ssq, row0 + ai * HALF + m * 16, u.pn * 4 + wc, sq, lane_); } }
        }
    }
};

template <class Epi, class Sched, bool ALIGN_EPI = false, bool FP8 = false>
__device__ __forceinline__ void gemm_phase(PG8_LAS unsigned char* lds, const int tid, const Gemm g, const Sched& S, const Epi& E) {
    const int wid = __builtin_amdgcn_readfirstlane(tid >> 6), lane = tid & 63, wr = wid >> 2, wc = wid & 3, fr = lane & 15, fq = lane >> 4;
    const int K = g.K, nt = K / BK;
    unsigned voffA, voffB;
    { int R, C; stage_rc(tid * 16, R, C); const int Rb = Epi::PERM ? ((R & ~31) + perm32(R & 31)) : R;
      voffA = (unsigned)(R * g.lda + C) * 2u; voffB = (unsigned)(Rb * g.ldb + C) * 2u; }
    const size_t rstepA = (size_t)64 * g.lda * 2, rstepB = (size_t)64 * g.ldb * 2;
    const size_t kstep = (size_t)(BK * 2);
    const size_t hstepA = (size_t)HALF * g.lda * 2, hstepB = (size_t)HALF * g.ldb * 2;
    const unsigned ldsw = (unsigned)wid * 1024u;
    const int aoff = lds_byte(wr * 64 + fr, fq * 8), boff = lds_byte(wc * 32 + fr, fq * 8);
#define PG8_SA(b, h) (((b) * 2 + (h)) * HTB)
#define PG8_SB(b, h) ((4 + (b) * 2 + (h)) * HTB)
#define PG8_STAGE(bufoff, gbase, voff) do { _Pragma("unroll") for (int _i = 0; _i < 2; ++_i) { const char* gb_ = (const char*)(gbase) + (size_t)_i * rstep##voff; asm volatile("" : "+s"(gb_));     \
        __builtin_amdgcn_global_load_lds((const unsigned*)(gb_ + (voff)), (PG8_LAS unsigned*)(lds + (bufoff) + ldsw + _i * 8192), 16, 0, 0); } } while (0)
#define rstepvoffA rstepA
#define rstepvoffB rstepB
#define PG8_LDA(dst, b, h) do { if constexpr (FP8) { _Pragma("unroll") for (int m = 0; m < 4; ++m) dst##8[m] = __builtin_shufflevector(*(const PG8_LAS i32x4*)(lds + PG8_SA(b, h) + aoff + m * 2048), *(const PG8_LAS i32x4*)(lds + PG8_SA(b, h) + aoff + m * 2048 + 1024), 0, 1, 2, 3, 4, 5, 6, 7); } \
        else { _Pragma("unroll") for (int m = 0; m < 4; ++m) _Pragma("unroll") for (int k = 0; k < 2; ++k) dst[m][k] = *(const PG8_LAS bf16x8*)(lds + PG8_SA(b, h) + aoff + m * 2048 + k * 1024); } } while (0)
#define PG8_LDB(dst, b, h) do { if constexpr (FP8) { _Pragma("unroll") for (int n = 0; n < 2; ++n) dst##8[n] = __builtin_shufflevector(*(const PG8_LAS i32x4*)(lds + PG8_SB(b, h) + boff + n * 2048), *(const PG8_LAS i32x4*)(lds + PG8_SB(b, h) + boff + n * 2048 + 1024), 0, 1, 2, 3, 4, 5, 6, 7); } \
        else { _Pragma("unroll") for (int n = 0; n < 2; ++n) _Pragma("unroll") for (int k = 0; k < 2; ++k) dst[n][k] = *(const PG8_LAS bf16x8*)(lds + PG8_SB(b, h) + boff + n * 2048 + k * 1024); } } while (0)
#define PG8_MMA(ai, bj, At, Bt) do { __builtin_amdgcn_s_setprio(1); \
        if constexpr (FP8) { _Pragma("unroll") for (int m = 0; m < 4; ++m) _Pragma("unroll") for (int n = 0; n < 2; ++n) \
            acc[ai][bj][m][n] = __builtin_amdgcn_mfma_scale_f32_16x16x128_f8f6f4(Bt##8[n], At##8[m], acc[ai][bj][m][n], 0, 0, 0, 0x7f7f7f7f, 0, 0x7f7f7f7f); } \
        else { _Pragma("unroll") for (int m = 0; m < 4; ++m) _Pragma("unroll") for (int n = 0; n < 2; ++n) _Pragma("unroll") for (int k = 0; k < 2; ++k) \
            acc[ai][bj][m][n] = __builtin_amdgcn_mfma_f32_16x16x32_bf16(Bt[n][k], At[m][k], acc[ai][bj][m][n], 0, 0, 0); } \
        __builtin_amdgcn_s_setprio(0); } while (0)
#define PG8_WAIT_V(n) asm volatile("s_waitcnt vmcnt(" #n ")" ::: "memory")
#define PG8_WAIT_L(n) asm volatile("s_waitcnt lgkmcnt(" #n ")" ::: "memory")
#define PG8_BAR __builtin_amdgcn_s_barrier()
#define PG8_SCHED __builtin_amdgcn_sched_barrier(0)
    Unit cur, nxt; int ui = 0;
    if (!S.next(0, cur)) return;
    f32x4 acc[2][2][4][2];
#pragma unroll
    for (int a = 0; a < 2; ++a)
#pragma unroll
        for (int b = 0; b < 2; ++b)
#pragma unroll
            for (int m = 0; m < 4; ++m)
#pragma unroll
                for (int n = 0; n < 2; ++n) acc[a][b][m][n] = (f32x4){0.f, 0.f, 0.f, 0.f};
    bf16x8 At[4][2], B0[2][2], B1[2][2]; i32x8 At8[4], B08[2], B18[2];
    const char* cA = (const char*)g.A + cur.aoff; const char* cB = (const char*)g.Bt + cur.boff;
    S.a_ready(cur);
    PG8_STAGE(PG8_SB(0, 0), cB, voffB); PG8_STAGE(PG8_SB(0, 1), cB + hstepB, voffB); PG8_STAGE(PG8_SA(0, 0), cA, voffA); PG8_STAGE(PG8_SA(0, 1), cA + hstepA, voffA);
    if (wr == 1) PG8_BAR;
    PG8_WAIT_V(2); PG8_BAR;
    PG8_STAGE(PG8_SB(1, 0), cB + kstep, voffB); PG8_STAGE(PG8_SA(1, 0), cA + kstep, voffA); PG8_STAGE(PG8_SB(1, 1), cB + hstepB + kstep, voffB);
    PG8_WAIT_V(6); PG8_BAR;
    for (;;) {
        const bool has_next = S.next(ui + 1, nxt);
        const char* nA = has_next ? (const char*)g.A + nxt.aoff : cA; const char* nB = has_next ? (const char*)g.Bt + nxt.boff : cB;
#pragma unroll 1
        for (int t = 0; t < nt; t += 2) {
            const bool last = (t == nt - 2);
            const char* a1 = cA + (size_t)(t + 1) * kstep;
            const char* a2 = last ? nA : cA + (size_t)(t + 2) * kstep; const char* b2 = last ? nB : cB + (size_t)(t + 2) * kstep;
            const char* a3 = a2 + kstep; const char* b3 = b2 + kstep;
            if (last && has_next) S.a_ready(nxt);
            PG8_LDB(B0, 0, 0); PG8_LDB(B1, 0, 1); PG8_SCHED; PG8_LDA(At, 0, 0); PG8_STAGE(PG8_SA(1, 1), a1 + hstepA, voffA);
            PG8_WAIT_V(8); PG8_WAIT_L(0); PG8_BAR; PG8_MMA(0, 0, At, B0); PG8_MMA(0, 1, At, B1); PG8_BAR; PG8_SCHED;
            PG8_LDA(At, 0, 1); PG8_STAGE(PG8_SB(0, 0), b2, voffB); PG8_STAGE(PG8_SB(0, 1), b2 + hstepB, voffB); PG8_STAGE(PG8_SA(0, 0), a2, voffA);
            PG8_WAIT_V(8); PG8_WAIT_L(0); PG8_BAR; PG8_MMA(1, 0, At, B0); PG8_MMA(1, 1, At, B1); PG8_BAR; PG8_SCHED;
            PG8_LDB(B0, 1, 0); PG8_LDB(B1, 1, 1); PG8_SCHED; PG8_LDA(At, 1, 0); PG8_STAGE(PG8_SA(0, 1), a2 + hstepA, voffA);
            PG8_WAIT_V(8); PG8_WAIT_L(0); PG8_BAR; PG8_MMA(0, 0, At, B0); PG8_MMA(0, 1, At, B1); PG8_BAR; PG8_SCHED;
            PG8_LDA(At, 1, 1); PG8_STAGE(PG8_SB(1, 0), b3, voffB); PG8_STAGE(PG8_SB(1, 1), b3 + hstepB, voffB); PG8_STAGE(PG8_SA(1, 0), a3, voffA);
            PG8_WAIT_V(8); PG8_WAIT_L(0); PG8_BAR; PG8_MMA(1, 0, At, B0); PG8_MMA(1, 1, At, B1); PG8_BAR; PG8_SCHED;
        }
        if constexpr (ALIGN_EPI) { if (wr == 0) PG8_BAR; }
        E(acc, cur, wr, wc, fr, fq); S.done(cur);
        if (!has_next) break;
#pragma unroll
        for (int a = 0; a < 2; ++a)
#pragma unroll
            for (int b = 0; b < 2; ++b)
#pragma unroll
                for (int m = 0; m < 4; ++m)
#pragma unroll
                    for (int n = 0; n < 2; ++n) acc[a][b][m][n] = (f32x4){0.f, 0.f, 0.f, 0.f};
        cur = nxt; cA = nA; cB = nB; ++ui;
        if constexpr (ALIGN_EPI) { if (wr == 1) PG8_BAR; }
    }
    PG8_WAIT_V(0);
    if constexpr (!ALIGN_EPI) { if (wr == 0) PG8_BAR; }
    PG8_BAR;
#undef PG8_SA
#undef PG8_SB
#undef PG8_STAGE
#undef rstepvoffA
#undef rstepvoffB
#undef PG8_LDA
#undef PG8_LDB
#undef PG8_MMA
#undef PG8_WAIT_V
#undef PG8_WAIT_L
#undef PG8_BAR
#undef PG8_SCHED
}
}

constexpr int NB = 32, SEQ = 2048, D = 1024, M = NB * SEQ;
constexpr int WIN = 6656, GCOL0 = 2560;
constexpr int UST = 4608;
constexpr int FF0 = 2816, FFE = 3584, NEXP = 8;
constexpr int HROWS = M / 2, HB = NB / 2;
constexpr int CAPROWS = M + NEXP * 256, CAPT = CAPROWS / 256;
constexpr float RMS_EPS = 1e-6f, SUBLN_EPS = 1e-5f;
constexpr int NWAVES = 8;
constexpr int C_QA = 0, C_KA = 256, C_VA = 512, C_XB = 768, C_BB = 1024, C_CB = 1280, C_PC = 1536, C_QD = 1792, C_KD = 2048, C_VD = 2304;

constexpr size_t MiB = 1u << 20;
constexpr size_t WS_CTL = 0, CTL_ZERO_BYTES = 1 * MiB;
constexpr size_t WS_ROUTE = 2 * MiB;
constexpr size_t WS_TOK = 4 * MiB;
constexpr size_t WS_GATE = 5 * MiB;
constexpr size_t WS_TILEE = 6 * MiB;
constexpr size_t WS_KMEAN = 7 * MiB;
constexpr size_t WS_WIN = 8 * MiB;
constexpr size_t WS_WG8 = 24 * MiB;
constexpr size_t WS_BP = 34 * MiB;
constexpr size_t WS_WOUT = 38 * MiB;
constexpr size_t WS_W13D = 42 * MiB;
constexpr size_t WS_W2D = 53 * MiB;
constexpr size_t WS_W13E = 60 * MiB;
constexpr size_t WS_W2E = 116 * MiB;
constexpr size_t WS_R = 144 * MiB;
constexpr size_t WS_H = 272 * MiB;
constexpr size_t WS_U = 400 * MiB;
constexpr size_t WS_A8 = 752 * MiB;
constexpr size_t WS_Y = 816 * MiB;
constexpr size_t WS_MG = 880 * MiB;
constexpr size_t WS_HPERM = 272 * MiB;
constexpr size_t WS_TE = 404 * MiB;
constexpr size_t WS_END = 952 * MiB;
static_assert(WS_W13E + (size_t)8 * 2 * FFE * D <= WS_W2E && WS_W2E + (size_t)8 * D * FFE <= WS_R && WS_U + (size_t)HROWS * UST * 2 <= WS_A8 && WS_A8 + (size_t)M * D <= WS_Y && WS_HPERM + 2 * (size_t)CAPROWS * D <= WS_TE && WS_TE + 2 * (size_t)CAPROWS * FFE <= WS_END - 8 * MiB && WS_U + (size_t)M * FF0 * 2 <= WS_A8 && WS_MG + (size_t)HROWS * D * 2 <= WS_END, "d_ws map");
constexpr int CW_BAR = 4096;
constexpr int CW_QUEUE = 16384;
constexpr int CW_CNT = 20480;
constexpr size_t SSQ0_OFF = 944 * MiB, SSQ1_OFF = 948 * MiB;

constexpr int RING_BYTES = 131072;
constexpr int LUT_OFF = RING_BYTES;
constexpr int LUT_N = 320, LUT_NEG = 96;
constexpr int SLUT_OFF = LUT_OFF + 8 * LUT_N * 4;
constexpr int LDSCTL_OFF = RING_BYTES + 12288, MISC_OFF = LDSCTL_OFF + 320;
constexpr int LDS_BYTES = 147456;

#define GAS __attribute__((address_space(1)))
#define LAS __attribute__((address_space(3)))
typedef unsigned short bf16;
typedef unsigned v4u __attribute__((ext_vector_type(4)));
typedef unsigned v2u __attribute__((ext_vector_type(2)));
typedef float f32x4 __attribute__((ext_vector_type(4)));
typedef GAS unsigned gu32;
#define RLX_AGENT __ATOMIC_RELAXED, __HIP_MEMORY_SCOPE_AGENT
#define LDS_WAIT() asm volatile("s_waitcnt lgkmcnt(0)" ::: "memory")
#define VM_WAIT() asm volatile("s_waitcnt vmcnt(0)" ::: "memory")
__device__ __forceinline__ unsigned f2bf(float f) { unsigned u = __builtin_bit_cast(unsigned, f); return (u + 0x7fffu + ((u >> 16) & 1u)) >> 16; }
__device__ __forceinline__ unsigned pk2(float lo, float hi) { return f2bf(lo) | (f2bf(hi) << 16); }
__device__ __forceinline__ float bflo(unsigned w) { return __uint_as_float(w << 16); }
__device__ __forceinline__ float bfhi(unsigned w) { return __uint_as_float(w & 0xffff0000u); }

#define XB_TMO      128
#define XB_XCNT(j)  (256  + 64 * (j))
#define XB_XSUB(j)  (1280 + 64 * (j))
#define XB_XGEN(j)  (2304 + 64 * (j))
#define XB_TOP      3328
#define XB_TOPGEN   3392
#define XCD_BAR_WORDS 3456
#define XB_SPIN_CAP (1u << 22)

__device__ __forceinline__ unsigned xb_ld(unsigned* p)              { return __hip_atomic_load(p, __ATOMIC_RELAXED, __HIP_MEMORY_SCOPE_AGENT); }
__device__ __forceinline__ unsigned xb_add(unsigned* p, unsigned v) { return __hip_atomic_fetch_add(p, v, __ATOMIC_RELAXED, __HIP_MEMORY_SCOPE_AGENT); }
__device__ __forceinline__ unsigned xb_xcc_id() { return (unsigned)__builtin_amdgcn_s_getreg((3 << 11) | 20) & 0xFu; }
#define XB_SPIN(cond, bar) do { unsigned _sp = 0; while (cond) { __builtin_amdgcn_s_sleep(1); \
    if ((++_sp & 255u) == 0u) { if (xb_ld(&(bar)[XB_TMO])) break; if (_sp > XB_SPIN_CAP) { atomicAdd(&(bar)[XB_TMO], 1u); break; } } } } while (0)

struct XcdBarrier { unsigned* bar; unsigned x; volatile LAS unsigned* st; };

__device__ __forceinline__ XcdBarrier xcd_barrier_post(unsigned* bar, volatile LAS unsigned* st) {
    XcdBarrier b; b.bar = bar; b.x = xb_xcc_id(); b.st = st;
    if (threadIdx.x == 0) (void)xb_add(&bar[XB_XCNT(b.x)], 1u);
    return b;
}
__device__ __forceinline__ void xcd_barrier_complete(unsigned* bar, unsigned x, unsigned& nloc, unsigned& nx) {
    const unsigned G = gridDim.x * gridDim.y * gridDim.z;
    unsigned sum, cnt, mine, sp = 0u;
    for (;;) {
        sum = 0u; cnt = 0u; mine = 0u;
#pragma unroll
        for (unsigned j = 0; j < 16; ++j) { const unsigned c = xb_ld(&bar[XB_XCNT(j)]); sum += c; cnt += (c > 0u) ? 1u : 0u; mine = (j == x) ? c : mine; }
        if (sum == G) break;
        __builtin_amdgcn_s_sleep(1);
        if ((++sp & 255u) == 0u) { if (xb_ld(&bar[XB_TMO])) break; if (sp > XB_SPIN_CAP) { atomicAdd(&bar[XB_TMO], 1u); break; } }
    }
    nloc = mine > 0u ? mine : 1u; nx = cnt > 0u ? cnt : 1u;
}
__device__ __forceinline__ void xcd_barrier(const XcdBarrier& b) {
    asm volatile("s_waitcnt vmcnt(0)" ::: "memory");
    __syncthreads();
    if (threadIdx.x == 0) {
        unsigned* bar = b.bar;
        __builtin_amdgcn_s_waitcnt(0);
        unsigned nloc = b.st[0], nx = b.st[1];
        if (nloc == 0u) { xcd_barrier_complete(bar, b.x, nloc, nx); b.st[0] = nloc; b.st[1] = nx; }
        const unsigned old = xb_add(&bar[XB_XSUB(b.x)], 1u);
        const unsigned gen = old / nloc;
        if (old + 1u == (gen + 1u) * nloc) {
            __builtin_amdgcn_fence(__ATOMIC_RELEASE, "agent");
            asm volatile("s_waitcnt vmcnt(0)" ::: "memory");
            const unsigned og = xb_add(&bar[XB_TOP], 1u);
            const unsigned tg = og / nx;
            if (og + 1u == (tg + 1u) * nx) xb_add(&bar[XB_TOPGEN], 1u);
            else XB_SPIN(xb_ld(&bar[XB_TOPGEN]) == tg, bar);
            __builtin_amdgcn_fence(__ATOMIC_ACQUIRE, "agent");
            xb_add(&bar[XB_XGEN(b.x)], 1u);
            asm volatile("s_waitcnt vmcnt(0)" ::: "memory");
        } else {
            XB_SPIN(xb_ld(&bar[XB_XGEN(b.x)]) == gen, bar);
            __builtin_amdgcn_fence(__ATOMIC_ACQUIRE, "agent");
            asm volatile("s_waitcnt vmcnt(0)" ::: "memory");
        }
    }
    __syncthreads();
}

__device__ __forceinline__ float wave_sum(float v, int lane) {
#pragma unroll
    for (int o = 1; o < 64; o <<= 1) v += __int_as_float(__builtin_amdgcn_ds_bpermute((lane ^ o) << 2, __float_as_int(v)));
    return v;
}
__device__ __forceinline__ void wave_sync() { asm volatile("s_waitcnt lgkmcnt(0)" ::: "memory"); __builtin_amdgcn_wave_barrier(); }

__device__ const unsigned char BKT[129] = {
    0, 1, 2, 3, 4, 5, 6, 7, 8, 9, 10, 11, 12, 13, 14, 15, 16, 16, 16, 17, 17, 18, 18, 18, 19, 19, 19, 20, 20, 20, 20, 21, 21, 21, 21, 22, 22, 22, 22, 22, 23, 23, 23, 23, 23, 23,
    24, 24, 24, 24, 24, 24, 25, 25, 25, 25, 25, 25, 25, 26, 26, 26, 26, 26, 26, 26, 26, 27, 27, 27, 27, 27, 27, 27, 27, 27, 27, 28, 28, 28, 28, 28, 28, 28, 28, 28, 28,
    29, 29, 29, 29, 29, 29, 29, 29, 29, 29, 29, 29, 30, 30, 30, 30, 30, 30, 30, 30, 30, 30, 30, 30, 30, 30, 31, 31, 31, 31, 31, 31, 31, 31, 31, 31, 31, 31, 31, 31, 31, 31 };

__device__ __forceinline__ void transpose_item(const float* W, int K, int N, bf16* WT, int row_off, int il, LAS float* scr, int item, int lane, const float* gk = nullptr, int ldw = 0) {
    if (ldw == 0) ldw = N;
    const int nblk = N / 32, kb = item / nblk, nb = item % nblk, k0 = 64 * kb, n0 = 32 * nb;
#pragma unroll 8
    for (int i = 0; i < 32; ++i) { const int kk = 2 * i + (lane >> 5); scr[kk * 33 + (lane & 31)] = __builtin_nontemporal_load(W + (size_t)(k0 + kk) * ldw + n0 + (lane & 31)) * (gk ? gk[k0 + kk] : 1.0f); }
    LDS_WAIT(); asm volatile("" ::: "memory"); __builtin_amdgcn_wave_barrier();
    const int c = lane & 7;
    const int r0 = il ? ((n0 >> 7) * 256 + row_off + (n0 & 127)) : (row_off + n0);
#pragma unroll
    for (int j = 0; j < 4; ++j) { const int n = (lane >> 3) + 8 * j; const LAS float* s = scr + (8 * c) * 33 + n;
        v4u o; o.x = pk2(s[0 * 33], s[1 * 33]); o.y = pk2(s[2 * 33], s[3 * 33]); o.z = pk2(s[4 * 33], s[5 * 33]); o.w = pk2(s[6 * 33], s[7 * 33]);
        *(GAS v4u*)(WT + (size_t)(r0 + n) * K + k0 + 8 * c) = o; }
    LDS_WAIT(); asm volatile("" ::: "memory"); __builtin_amdgcn_wave_barrier();
}


__device__ __forceinline__ int fresh_tid_w(int wave) { int lane; asm volatile("v_mbcnt_lo_u32_b32 %0, -1, 0\n\tv_mbcnt_hi_u32_b32 %0, -1, %0" : "=v"(lane)); return wave * 64 + lane; }
#define fresh_tid() fresh_tid_w(wave0)

__device__ __forceinline__ unsigned moba_mask(const bf16* u, const float* kmean, int bl, int h, int qc, int lane) {
    const int t = qc * 32 + (lane & 31), own = qc >> 3;
    if (own <= 3) return (1u << own) - 1u;
    const bf16* qp = u + ((size_t)bl * SEQ + t) * UST + C_QA + h * 64;
    float gs[7];
#pragma unroll
    for (int blk = 0; blk < 7; ++blk) gs[blk] = 0.f;
#pragma unroll 1
    for (int i = 0; i < 8; ++i) { const v4u x = *(const GAS v4u*)(qp + 8 * i);
        const float qv[8] = {bflo(x.x), bfhi(x.x), bflo(x.y), bfhi(x.y), bflo(x.z), bfhi(x.z), bflo(x.w), bfhi(x.w)};
#pragma unroll
        for (int blk = 0; blk < 7; ++blk) { const float* km = kmean + ((size_t)(bl * 8 + blk)) * 512 + h * 64 + 8 * i;
#pragma unroll
            for (int k = 0; k < 8; ++k) gs[blk] += qv[k] * (km[k] + km[256 + k]); } }
    unsigned mask = 0u;
#pragma unroll
    for (int k = 0; k < 3; ++k) { float bv = -3.3e38f; int best = 0;
#pragma unroll
        for (int blk = 0; blk < 7; ++blk) { const bool ok = (blk < own) && (((mask >> blk) & 1u) == 0u); if (ok && gs[blk] > bv) { bv = gs[blk]; best = blk; } }
        mask |= 1u << best; }
    return mask;
}

typedef short bf16x8v __attribute__((ext_vector_type(8)));
typedef float f32x16 __attribute__((ext_vector_type(16)));
constexpr int AT_KP = 144, AT_VP = 136, AT_KB = 64 * AT_KP, AT_BUF = AT_KB + 64 * AT_VP;

typedef float f32x2c __attribute__((ext_vector_type(2)));
typedef __bf16 bf16x2c __attribute__((ext_vector_type(2)));
__device__ __forceinline__ unsigned pk2c(float lo, float hi) { const f32x2c f = {lo, hi}; const bf16x2c b = __builtin_convertvector(f, bf16x2c); return __builtin_bit_cast(unsigned, b); }

__device__ __forceinline__ void softmax_step(f32x16 (&e)[2], float& m, float& l, f32x16 (&o)[2], bf16x8v (&pb)[2][2], bool first, int xaddr) {
    float pm = -1.0e30f;
#pragma unroll
    for (int st = 0; st < 2; ++st)
#pragma unroll
        for (int i = 0; i < 16; ++i) pm = fmaxf(pm, e[st][i]);
    pm = fmaxf(pm, __int_as_float(__builtin_amdgcn_ds_bpermute(xaddr, __float_as_int(pm))));
    if (first || __ballot(pm > 8.0f) != 0ull) {
        const float delta = first ? pm : fmaxf(pm, 0.f);
        const float f = __builtin_amdgcn_exp2f(-delta);
        m += delta; l *= f;
#pragma unroll
        for (int mb = 0; mb < 2; ++mb)
#pragma unroll
            for (int i = 0; i < 16; ++i) o[mb][i] *= f;
#pragma unroll
        for (int st = 0; st < 2; ++st)
#pragma unroll
            for (int i = 0; i < 16; ++i) e[st][i] -= delta;
    }
#pragma unroll
    for (int st = 0; st < 2; ++st)
#pragma unroll
        for (int sp = 0; sp < 2; ++sp) { float pv[8];
#pragma unroll
            for (int j = 0; j < 8; ++j) { pv[j] = __builtin_amdgcn_exp2f(e[st][8 * sp + j]); l += pv[j]; }
            union { v4u u; bf16x8v b; } cv; cv.u.x = pk2c(pv[0], pv[1]); cv.u.y = pk2c(pv[2], pv[3]); cv.u.z = pk2c(pv[4], pv[5]); cv.u.w = pk2c(pv[6], pv[7]); pb[st][sp] = cv.b; }
}

template <bool DIFF>
__device__ __forceinline__ void attn_unit(const bf16* U, const float* kmean, bf16* Y, const LAS float* lut, LAS unsigned char* lds, int bl, int h, int qb, const int wave0, float lam, float outscale, const float* subg) {
    const int tid = fresh_tid(), lane = tid & 63, w = wave0, c = lane & 31, hh = lane >> 5;
    const int qcol = (DIFF ? C_QD : C_QA) + h * 64, kcol = (DIFF ? C_KD : C_KA) + h * 64, vcol = (DIFF ? C_VD : C_VA) + h * 64;
    const int q0w = qb * 256 + 32 * w, tq = q0w + c;
    const size_t qrow = (size_t)bl * SEQ + tq;
    bf16x8v qf[4];
#pragma unroll
    for (int s = 0; s < 4; ++s) qf[s] = *(const GAS bf16x8v*)(U + qrow * UST + qcol + 16 * s + 8 * hh);
    unsigned mask = 0xffu;
    if (!DIFF) mask = moba_mask(U, kmean, bl, h, qb * 8 + w, lane);
    const LAS float* lh = lut + (DIFF ? 4 + h : h) * LUT_N;
    const float cfar = lh[LUT_NEG + 128];
    const float qs2 = (DIFF ? 0.17677669529663687f : 0.125f) * 1.4426950408889634f;
    f32x16 o1[2], o2[2];
#pragma unroll
    for (int mb = 0; mb < 2; ++mb)
#pragma unroll
        for (int i = 0; i < 16; ++i) { o1[mb][i] = 0.f; o2[mb][i] = 0.f; }
    float m1 = 0.f, l1 = 0.f, m2 = 0.f, l2 = 0.f;
    const int ntiles = 4 * (qb + 1), my_last = qb * 4 + (w >> 1);
    const int xaddr = (lane ^ 32) << 2;
#define AT_KT(it) ((it) < 4 ? 4 * qb + (it) : (it) - 4)
    const bf16* kg = U + ((size_t)bl * SEQ + (tid >> 3)) * UST + kcol + 8 * (tid & 7);
    const bf16* vg = U + ((size_t)bl * SEQ + (tid & 63)) * UST + vcol + 8 * (tid >> 6);
    const int kst = (tid >> 3) * AT_KP + (tid & 7) * 16;
    const int vst = AT_KB + (8 * (tid >> 6)) * AT_VP + (tid & 63) * 2;
    v4u kreg = *(const GAS v4u*)(kg + (size_t)AT_KT(0) * 64 * UST), vreg = *(const GAS v4u*)(vg + (size_t)AT_KT(0) * 64 * UST);
#define AT_WRITE(bufb) do { LAS unsigned char* b_ = lds + (bufb) * AT_BUF; *(LAS v4u*)(b_ + kst) = kreg; \
        LAS unsigned short* v_ = (LAS unsigned short*)(b_ + vst); \
        v_[0 * (AT_VP / 2)] = (unsigned short)(vreg.x & 0xffffu); v_[1 * (AT_VP / 2)] = (unsigned short)(vreg.x >> 16); v_[2 * (AT_VP / 2)] = (unsigned short)(vreg.y & 0xffffu); v_[3 * (AT_VP / 2)] = (unsigned short)(vreg.y >> 16); \
        v_[4 * (AT_VP / 2)] = (unsigned short)(vreg.z & 0xffffu); v_[5 * (AT_VP / 2)] = (unsigned short)(vreg.z >> 16); v_[6 * (AT_VP / 2)] = (unsigned short)(vreg.w & 0xffffu); v_[7 * (AT_VP / 2)] = (unsigned short)(vreg.w >> 16); } while (0)
    AT_WRITE(0);
    __syncthreads();
    for (int it = 0; it < ntiles; ++it) {
        const bool more = (it + 1 < ntiles);
        if (more) { const int ktn = AT_KT(it + 1); kreg = *(const GAS v4u*)(kg + (size_t)ktn * 64 * UST); vreg = *(const GAS v4u*)(vg + (size_t)ktn * 64 * UST); }
        const int kt = AT_KT(it);
        const int blk = kt >> 2; const bool past = blk < qb;
        const bool lane_on = past ? (((mask >> blk) & 1u) != 0u) : true;
        if (kt <= my_last && (DIFF || !past || __ballot(lane_on) != 0ull)) {
            const LAS unsigned char* kb = lds + (it & 1) * AT_BUF; const LAS unsigned char* vb = kb + AT_KB;
            const int key0 = kt * 64;
            f32x16 s1[2], s2[2];
#pragma unroll
            for (int st = 0; st < 2; ++st) {
#pragma unroll
                for (int i = 0; i < 16; ++i) { s1[st][i] = 0.f; s2[st][i] = 0.f; }
#pragma unroll
                for (int s = 0; s < 4; ++s) { const bf16x8v a = *(const LAS bf16x8v*)(kb + (32 * st + c) * AT_KP + (16 * s + 8 * hh) * 2);
                    if (DIFF && s >= 2) s2[st] = __builtin_amdgcn_mfma_f32_32x32x16_bf16(a, qf[s], s2[st], 0, 0, 0);
                    else s1[st] = __builtin_amdgcn_mfma_f32_32x32x16_bf16(a, qf[s], s1[st], 0, 0, 0); }
            }
            const float off1 = lane_on ? -m1 : -1.0e30f, off2 = -m2;
            if (key0 + 63 + 128 <= q0w) {
                const float x1 = cfar + off1, x2 = cfar + off2;
#pragma unroll
                for (int st = 0; st < 2; ++st)
#pragma unroll
                    for (int i = 0; i < 16; ++i) { s1[st][i] = s1[st][i] * qs2 + x1; if (DIFF) s2[st][i] = s2[st][i] * qs2 + x2; }
            } else {
                const LAS float* lp = lh + (LUT_NEG + tq - key0 - 4 * hh);
#pragma unroll
                for (int st = 0; st < 2; ++st)
#pragma unroll
                    for (int i = 0; i < 16; ++i) { const float b = lp[-(32 * st + (i & 3) + 8 * (i >> 2))]; s1[st][i] = s1[st][i] * qs2 + (b + off1); if (DIFF) s2[st][i] = s2[st][i] * qs2 + (b + off2); }
            }
            bf16x8v p1[2][2], p2[2][2];
            softmax_step(s1, m1, l1, o1, p1, it == 0, xaddr);
            if (DIFF) softmax_step(s2, m2, l2, o2, p2, it == 0, xaddr);
#pragma unroll
            for (int mb = 0; mb < 2; ++mb)
#pragma unroll
                for (int s = 0; s < 4; ++s) { const LAS unsigned char* vr = vb + (32 * mb + c) * AT_VP + (16 * s + 4 * hh) * 2;
                    const v2u lo = *(const LAS v2u*)vr, hi = *(const LAS v2u*)(vr + 16);
                    union { v4u u; bf16x8v b; } cv; cv.u.x = lo.x; cv.u.y = lo.y; cv.u.z = hi.x; cv.u.w = hi.y;
                    o1[mb] = __builtin_amdgcn_mfma_f32_32x32x16_bf16(cv.b, p1[s >> 1][s & 1], o1[mb], 0, 0, 0);
                    if (DIFF) o2[mb] = __builtin_amdgcn_mfma_f32_32x32x16_bf16(cv.b, p2[s >> 1][s & 1], o2[mb], 0, 0, 0); }
        }
        if (more) AT_WRITE((it + 1) & 1);
        __syncthreads();
    }
#undef AT_WRITE
#undef AT_KT
    l1 += __int_as_float(__builtin_amdgcn_ds_bpermute(xaddr, __float_as_int(l1)));
    const float i1 = 1.0f / l1;
    bf16* yp = Y + qrow * 1024 + (DIFF ? 768 : 0) + h * 64;
    if (!DIFF) {
#pragma unroll
        for (int mb = 0; mb < 2; ++mb)
#pragma unroll
            for (int g = 0; g < 4; ++g) { v2u wv; wv.x = pk2c(o1[mb][4 * g] * i1, o1[mb][4 * g + 1] * i1); wv.y = pk2c(o1[mb][4 * g + 2] * i1, o1[mb][4 * g + 3] * i1);
                *(GAS v2u*)(yp + 32 * mb + 8 * g + 4 * hh) = wv; }
    } else {
        l2 += __int_as_float(__builtin_amdgcn_ds_bpermute(xaddr, __float_as_int(l2)));
        const float i2 = lam / l2; float ss = 0.f;
#pragma unroll
        for (int mb = 0; mb < 2; ++mb)
#pragma unroll
            for (int i = 0; i < 16; ++i) { const float v = o1[mb][i] * i1 - o2[mb][i] * i2; o1[mb][i] = v; ss += v * v; }
        ss += __int_as_float(__builtin_amdgcn_ds_bpermute(xaddr, __float_as_int(ss)));
        const float r = outscale / sqrtf(ss * (1.0f / 64.0f) + SUBLN_EPS);
#pragma unroll
        for (int mb = 0; mb < 2; ++mb)
#pragma unroll
            for (int g = 0; g < 4; ++g) { const int d = 32 * mb + 8 * g + 4 * hh; const f32x4 sg = *(const f32x4*)(subg + d);
                v2u wv; wv.x = pk2c(o1[mb][4 * g] * r * sg.x, o1[mb][4 * g + 1] * r * sg.y); wv.y = pk2c(o1[mb][4 * g + 2] * r * sg.z, o1[mb][4 * g + 3] * r * sg.w);
                *(GAS v2u*)(yp + d) = wv; }
    }
}

__device__ __forceinline__ unsigned cvt4_fp8g(float a, float b, float c, float d) { int w = 0; w = __builtin_amdgcn_cvt_pk_fp8_f32(a, b, w, false); w = __builtin_amdgcn_cvt_pk_fp8_f32(c, d, w, true); return (unsigned)w; }
__device__ __forceinline__ void transpose_item8(const float* W, int K, int N, unsigned char* WT, int row_off, int il, LAS float* scr, int item, int lane, const float* gk = nullptr, int ldw = 0) {
    if (ldw == 0) ldw = N;
    const int nblk = N / 32, kb = item / nblk, nb = item % nblk, k0 = 64 * kb, n0 = 32 * nb;
#pragma unroll 8
    for (int i = 0; i < 32; ++i) { const int kk = 2 * i + (lane >> 5); scr[kk * 33 + (lane & 31)] = __builtin_nontemporal_load(W + (size_t)(k0 + kk) * ldw + n0 + (lane & 31)) * (gk ? gk[k0 + kk] : 1.0f); }
    LDS_WAIT(); asm volatile("" ::: "memory"); __builtin_amdgcn_wave_barrier();
    const int c = lane & 7;
    const int r0 = il ? ((n0 >> 7) * 256 + row_off + (n0 & 127)) : (row_off + n0);
#pragma unroll
    for (int j = 0; j < 4; ++j) { const int n = (lane >> 3) + 8 * j; const LAS float* sp = scr + (8 * c) * 33 + n;
        v2u o; o.x = cvt4_fp8g(32.f * sp[0 * 33], 32.f * sp[1 * 33], 32.f * sp[2 * 33], 32.f * sp[3 * 33]); o.y = cvt4_fp8g(32.f * sp[4 * 33], 32.f * sp[5 * 33], 32.f * sp[6 * 33], 32.f * sp[7 * 33]);
        *(GAS v2u*)(WT + (size_t)(r0 + n) * K + k0 + 8 * c) = o; }
    LDS_WAIT(); asm volatile("" ::: "memory"); __builtin_amdgcn_wave_barrier();
}

struct Args {
    const float* in[20]; float* out; unsigned char* ws; int ph_lo, ph_hi, li, pad;
};
typedef const __attribute__((address_space(4))) Args CArgs;

__device__ __forceinline__ float row_rms_load(const float* xrow, const float* g, int lane, f32x4 (&v)[4]) {
    const GAS f32x4* xr = (const GAS f32x4*)xrow + lane; float s = 0.f;
#pragma unroll
    for (int j = 0; j < 4; ++j) { v[j] = __builtin_nontemporal_load(xr + 64 * j); s += (v[j].x * v[j].x + v[j].y * v[j].y) + (v[j].z * v[j].z + v[j].w * v[j].w); }
    const float r = 1.0f / sqrtf(wave_sum(s, lane) * (1.f / D) + RMS_EPS);
    const GAS f32x4* gr = (const GAS f32x4*)g + lane;
#pragma unroll
    for (int j = 0; j < 4; ++j) { const f32x4 gg = gr[64 * j]; v[j] = v[j] * r * gg; }
    return r;
}
__device__ __forceinline__ void row_store_bf16(bf16* orow, int lane, const f32x4 (&v)[4]) {
    GAS unsigned long long* o8 = (GAS unsigned long long*)orow + lane;
#pragma unroll
    for (int j = 0; j < 4; ++j) o8[64 * j] = (unsigned long long)pk2(v[j].x, v[j].y) | ((unsigned long long)pk2(v[j].z, v[j].w) << 32);
}

__device__ __forceinline__ float rowb_rms_load(const bf16* xrow, const float* g, int lane, float (&v)[16]) {
    float s = 0.f;
#pragma unroll
    for (int j = 0; j < 2; ++j) { const v4u x = *(const GAS v4u*)(xrow + 8 * lane + 512 * j);
        v[8 * j + 0] = bflo(x.x); v[8 * j + 1] = bfhi(x.x); v[8 * j + 2] = bflo(x.y); v[8 * j + 3] = bfhi(x.y); v[8 * j + 4] = bflo(x.z); v[8 * j + 5] = bfhi(x.z); v[8 * j + 6] = bflo(x.w); v[8 * j + 7] = bfhi(x.w); }
#pragma unroll
    for (int k = 0; k < 16; ++k) s += v[k] * v[k];
    const float r = 1.0f / sqrtf(wave_sum(s, lane) * (1.f / D) + RMS_EPS);
#pragma unroll
    for (int j = 0; j < 2; ++j) { const f32x4 g0 = *(const GAS f32x4*)(g + 8 * lane + 512 * j), g1 = *(const GAS f32x4*)(g + 8 * lane + 512 * j + 4);
        v[8 * j + 0] *= r * g0.x; v[8 * j + 1] *= r * g0.y; v[8 * j + 2] *= r * g0.z; v[8 * j + 3] *= r * g0.w; v[8 * j + 4] *= r * g1.x; v[8 * j + 5] *= r * g1.y; v[8 * j + 6] *= r * g1.z; v[8 * j + 7] *= r * g1.w; }
    return r;
}
__device__ __forceinline__ float rowb_rms_from(const v4u (&x)[2], const float* g, int lane, float (&v)[16]) {
    float s = 0.f;
#pragma unroll
    for (int j = 0; j < 2; ++j) { v[8 * j + 0] = bflo(x[j].x); v[8 * j + 1] = bfhi(x[j].x); v[8 * j + 2] = bflo(x[j].y); v[8 * j + 3] = bfhi(x[j].y); v[8 * j + 4] = bflo(x[j].z); v[8 * j + 5] = bfhi(x[j].z); v[8 * j + 6] = bflo(x[j].w); v[8 * j + 7] = bfhi(x[j].w); }
#pragma unroll
    for (int k = 0; k < 16; ++k) s += v[k] * v[k];
    const float r = 1.0f / sqrtf(wave_sum(s, lane) * (1.f / D) + RMS_EPS);
#pragma unroll
    for (int j = 0; j < 2; ++j) { const f32x4 g0 = *(const GAS f32x4*)(g + 8 * lane + 512 * j), g1 = *(const GAS f32x4*)(g + 8 * lane + 512 * j + 4);
        v[8 * j + 0] *= r * g0.x; v[8 * j + 1] *= r * g0.y; v[8 * j + 2] *= r * g0.z; v[8 * j + 3] *= r * g0.w; v[8 * j + 4] *= r * g1.x; v[8 * j + 5] *= r * g1.y; v[8 * j + 6] *= r * g1.z; v[8 * j + 7] *= r * g1.w; }
    return r;
}
__device__ __forceinline__ void rowb_store_bf16(bf16* orow, int lane, const float (&v)[16]) {
#pragma unroll
    for (int j = 0; j < 2; ++j) { v4u w; w.x = pk2(v[8 * j], v[8 * j + 1]); w.y = pk2(v[8 * j + 2], v[8 * j + 3]); w.z = pk2(v[8 * j + 4], v[8 * j + 5]); w.w = pk2(v[8 * j + 6], v[8 * j + 7]);
        *(GAS v4u*)(orow + 8 * lane + 512 * j) = w; }
}
__device__ __forceinline__ void rowb_store_fp8(unsigned char* orow, int lane, const float (&v)[16]) {
#pragma unroll
    for (int j = 0; j < 2; ++j) { v2u w; w.x = cvt4_fp8g(v[8 * j], v[8 * j + 1], v[8 * j + 2], v[8 * j + 3]); w.y = cvt4_fp8g(v[8 * j + 4], v[8 * j + 5], v[8 * j + 6], v[8 * j + 7]);
        *(GAS v2u*)(orow + 8 * lane + 512 * j) = w; }
}
__device__ __forceinline__ void row_store_fp8(unsigned char* orow, int lane, const f32x4 (&v)[4]) {
    GAS unsigned* o4 = (GAS unsigned*)orow + lane;
#pragma unroll
    for (int j = 0; j < 4; ++j) o4[64 * j] = cvt4_fp8g(v[j].x, v[j].y, v[j].z, v[j].w);
}
__device__ __forceinline__ void ph_prologue(CArgs& args, LAS unsigned char* lds, const int wave0) {
    const int tid = fresh_tid(), lane = tid & 63, wave = __builtin_amdgcn_readfirstlane(tid >> 6), gw = blockIdx.x * NWAVES + wave, NGW = gridDim.x * NWAVES;
    unsigned char* ws = args.ws;
    LAS float* scr = (LAS float*)(lds + wave * 16384);
    constexpr int I_WIN = 16 * (GCOL0 / 32), I_WG = 16 * ((WIN - GCOL0) / 32), I_BP = 4 * 32, I_WO = 16 * 32, I_D1 = 16 * (FF0 / 32), I_D2 = (FF0 / 64) * 32, I_E1 = 16 * (FFE / 32), I_E2 = (FFE / 64) * 32;
    constexpr int NIT = 2 * I_WIN + 2 * I_WG + 8 * I_BP + 2 * I_WO + 2 * I_D1 + I_D2 + 16 * I_E1 + 8 * I_E2;
    for (int it = gw; it < NIT; it += NGW) {
        int r = it;
        if (r < 2 * I_WIN) { const int l = r / I_WIN; transpose_item(args.in[3] + (size_t)l * D * WIN, D, GCOL0, (bf16*)(ws + WS_WIN) + (size_t)l * GCOL0 * D, 0, 0, scr, r % I_WIN, lane, l ? args.in[2] + D : nullptr, WIN); continue; } r -= 2 * I_WIN;
        if (r < 2 * I_WG) { const int l = r / I_WG; transpose_item8(args.in[3] + (size_t)l * D * WIN + GCOL0, D, WIN - GCOL0, ws + WS_WG8 + (size_t)l * (WIN - GCOL0) * D, 0, 0, scr, r % I_WG, lane, l ? args.in[2] + D : nullptr, WIN); continue; } r -= 2 * I_WG;
        if (r < 8 * I_BP) { const int q = r / I_BP;
            if ((q & 3) != 2) { transpose_item(args.in[9] + (size_t)q * 256 * D, 256, D, (bf16*)(ws + WS_BP) + (size_t)q * D * 256, 0, 0, scr, r % I_BP, lane); continue; }
            const int it2 = r % I_BP; if (it2 < 64) { const int l = q >> 2, g = it2 >> 4, n = (it2 & 15) * 64 + lane;
                const float* pw = args.in[5] + ((size_t)l * 4 + g) * 64 * 64; const float* psc = args.in[6] + (size_t)l * 256 + g * 64; const float* b2 = args.in[9] + ((size_t)q * 256 + g * 64) * D + n;
                bf16* dst = (bf16*)(ws + WS_BP) + (size_t)q * D * 256 + (size_t)n * 256 + g * 64;
#pragma unroll 1
                for (int ch = 0; ch < 4; ++ch) {
                    float accw[16];
#pragma unroll
                    for (int c = 0; c < 16; ++c) accw[c] = 0.f;
#pragma unroll 4
                    for (int d = 0; d < 64; ++d) { const float bv = b2[(size_t)d * D] * psc[d];
#pragma unroll
                        for (int c = 0; c < 16; ++c) accw[c] += pw[(ch * 16 + c) * 64 + d] * bv; }
#pragma unroll
                    for (int c8 = 0; c8 < 2; ++c8) { v4u w; w.x = pk2(accw[8 * c8], accw[8 * c8 + 1]); w.y = pk2(accw[8 * c8 + 2], accw[8 * c8 + 3]); w.z = pk2(accw[8 * c8 + 4], accw[8 * c8 + 5]); w.w = pk2(accw[8 * c8 + 6], accw[8 * c8 + 7]);
                        *(GAS v4u*)(dst + ch * 16 + 8 * c8) = w; } } }
            continue; } r -= 8 * I_BP;
        if (r < 2 * I_WO) { const int l = r / I_WO; transpose_item(args.in[10] + (size_t)l * D * D, D, D, (bf16*)(ws + WS_WOUT) + (size_t)l * D * D, 0, 0, scr, r % I_WO, lane); continue; } r -= 2 * I_WO;
        if (r < I_D1) { transpose_item(args.in[12], D, FF0, (bf16*)(ws + WS_W13D), 0, 1, scr, r, lane, args.in[11]); continue; } r -= I_D1;
        if (r < I_D1) { transpose_item(args.in[13], D, FF0, (bf16*)(ws + WS_W13D), 128, 1, scr, r, lane, args.in[11]); continue; } r -= I_D1;
        if (r < I_D2) { transpose_item8(args.in[14], FF0, D, ws + WS_W2D, 0, 0, scr, r, lane); continue; } r -= I_D2;
        if (r < 8 * I_E1) { const int e = r / I_E1; transpose_item8(args.in[16] + (size_t)e * D * FFE, D, FFE, ws + WS_W13E + (size_t)e * 2 * FFE * D, 0, 1, scr, r % I_E1, lane); continue; } r -= 8 * I_E1;
        if (r < 8 * I_E1) { const int e = r / I_E1; transpose_item8(args.in[17] + (size_t)e * D * FFE, D, FFE, ws + WS_W13E + (size_t)e * 2 * FFE * D, 128, 1, scr, r % I_E1, lane); continue; } r -= 8 * I_E1;
        { const int e = r / I_E2; transpose_item8(args.in[18] + (size_t)e * FFE * D, FFE, D, ws + WS_W2E + (size_t)e * D * FFE, 0, 0, scr, r % I_E2, lane); }
    }
}

__device__ __forceinline__ void ph_norm_rb(const bf16* src, const float* g, bf16* dst, const int wave0) {
    const int tid = fresh_tid(), lane = tid & 63, wave = __builtin_amdgcn_readfirstlane(tid >> 6), gw = blockIdx.x * NWAVES + wave, NGW = gridDim.x * NWAVES;
    for (int m = gw; m < M; m += NGW) { float v[16]; (void)rowb_rms_load(src + (size_t)m * D, g, lane, v); rowb_store_bf16(dst + (size_t)m * D, lane, v); }
}
__device__ __forceinline__ void ph_norm_bf16(const float* src, const float* g, bf16* dst, unsigned char* dst8, const int wave0) {
    const int tid = fresh_tid(), lane = tid & 63, wave = __builtin_amdgcn_readfirstlane(tid >> 6), gw = blockIdx.x * NWAVES + wave, NGW = gridDim.x * NWAVES;
    for (int m = gw; m < M; m += NGW) { f32x4 v[4]; (void)row_rms_load(src + (size_t)m * D, g, lane, v); row_store_bf16(dst + (size_t)m * D, lane, v); row_store_fp8(dst8 + (size_t)m * D, lane, v); }
}
__device__ __forceinline__ void ph_final_norm(const bf16* R, const float* g, float* out, const int wave0) {
    const int tid = fresh_tid(), lane = tid & 63, wave = __builtin_amdgcn_readfirstlane(tid >> 6), gw = blockIdx.x * NWAVES + wave, NGW = gridDim.x * NWAVES;
    f32x4 gg[4];
#pragma unroll
    for (int j = 0; j < 2; ++j) { gg[2 * j] = *(const GAS f32x4*)(g + 8 * lane + 512 * j); gg[2 * j + 1] = *(const GAS f32x4*)(g + 8 * lane + 512 * j + 4); }
    for (int m0 = gw; m0 < M; m0 += 2 * NGW) {
        v4u x[2][2], z[2][2], z0[2][2];
#pragma unroll
        for (int q = 0; q < 2; ++q)
#pragma unroll
            for (int j = 0; j < 2; ++j) { x[q][j] = *(const GAS v4u*)(R + (size_t)(m0 + q * NGW) * D + 8 * lane + 512 * j);
                z[q][j] = *(const GAS v4u*)((const bf16*)(out + (size_t)(m0 + q * NGW) * D + 512) + 8 * lane + 512 * j);
                z0[q][j] = *(const GAS v4u*)((const bf16*)(out + (size_t)(m0 + q * NGW) * D) + 8 * lane + 512 * j); }
#pragma unroll
        for (int q = 0; q < 2; ++q) { float v[16];
#pragma unroll
            for (int j = 0; j < 2; ++j) { const v4u w = x[q][j], y = z[q][j], y0 = z0[q][j];
                v[8 * j + 0] = bflo(w.x) + (bflo(y0.x) + bflo(y.x)); v[8 * j + 1] = bfhi(w.x) + (bfhi(y0.x) + bfhi(y.x)); v[8 * j + 2] = bflo(w.y) + (bflo(y0.y) + bflo(y.y)); v[8 * j + 3] = bfhi(w.y) + (bfhi(y0.y) + bfhi(y.y));
                v[8 * j + 4] = bflo(w.z) + (bflo(y0.z) + bflo(y.z)); v[8 * j + 5] = bfhi(w.z) + (bfhi(y0.z) + bfhi(y.z)); v[8 * j + 6] = bflo(w.w) + (bflo(y0.w) + bflo(y.w)); v[8 * j + 7] = bfhi(w.w) + (bfhi(y0.w) + bfhi(y.w)); }
            float s = 0.f;
#pragma unroll
            for (int k = 0; k < 16; ++k) s += v[k] * v[k];
            const float r = 1.0f / sqrtf(wave_sum(s, lane) * (1.f / D) + RMS_EPS);
            float* o = out + (size_t)(m0 + q * NGW) * D + 8 * lane;
#pragma unroll
            for (int j = 0; j < 2; ++j) { const f32x4 a = gg[2 * j], b = gg[2 * j + 1];
                *(GAS f32x4*)(o + 512 * j) = (f32x4){v[8 * j] * r * a.x, v[8 * j + 1] * r * a.y, v[8 * j + 2] * r * a.z, v[8 * j + 3] * r * a.w};
                *(GAS f32x4*)(o + 512 * j + 4) = (f32x4){v[8 * j + 4] * r * b.x, v[8 * j + 5] * r * b.y, v[8 * j + 6] * r * b.z, v[8 * j + 7] * r * b.w}; } }
    }
}

__device__ __forceinline__ void ph_kmean(const bf16* U, float* kmean, LAS unsigned char* lds, const int wave0) {
    const int tid = fresh_tid();
    LAS float* red = (LAS float*)lds;
    for (int task = blockIdx.x; task < HB * 8; task += gridDim.x) {
        const int bl = task >> 3, blk = task & 7, cg = tid & 31, rq = tid >> 5;
        const bf16* kp = U + ((size_t)bl * SEQ + blk * 256 + rq * 16) * UST + C_KA + 8 * cg;
        v4u x[16];
#pragma unroll
        for (int i = 0; i < 16; ++i) x[i] = *(const GAS v4u*)(kp + (size_t)i * UST);
        float sm[8];
#pragma unroll
        for (int k = 0; k < 8; ++k) sm[k] = 0.f;
#pragma unroll
        for (int i = 0; i < 16; ++i) { sm[0] += bflo(x[i].x); sm[1] += bfhi(x[i].x); sm[2] += bflo(x[i].y); sm[3] += bfhi(x[i].y); sm[4] += bflo(x[i].z); sm[5] += bfhi(x[i].z); sm[6] += bflo(x[i].w); sm[7] += bfhi(x[i].w); }
#pragma unroll
        for (int k = 0; k < 8; ++k) red[rq * 256 + 8 * cg + k] = sm[k];
        __syncthreads();
        if (tid < 256) { float t = 0.f;
#pragma unroll
            for (int q = 0; q < 16; ++q) t += red[q * 256 + tid];
            kmean[(size_t)task * 256 + tid] = t * (1.0f / 256.0f); }
        __syncthreads();
    }
}

__device__ __forceinline__ void ph_conv_pool(CArgs& args, int l, const bf16* U, bf16* Y, LAS unsigned char* lds, const int wave0) {
    const int tid = fresh_tid(), lane = tid & 63, wave = __builtin_amdgcn_readfirstlane(tid >> 6), gw = blockIdx.x * NWAVES + wave, NGW = gridDim.x * NWAVES;
    {
        const float* cw = args.in[4] + (size_t)l * 3 * 256; const int c0 = (lane & 31) * 8;
        float w0[8], w1[8], w2[8];
#pragma unroll
        for (int k = 0; k < 8; ++k) { w0[k] = cw[c0 + k]; w1[k] = cw[256 + c0 + k]; w2[k] = cw[512 + c0 + k]; }
        for (int ch = gw; ch < HROWS / 8; ch += NGW) {
            const int rl0 = ch * 8 + (lane >> 5) * 4, t = rl0 & (SEQ - 1);
            const bf16* up = U + (size_t)rl0 * UST; const int back = t > 0 ? 1 : 0; const float mb = t > 0 ? 1.f : 0.f;
            v4u xv[6], gv[6], bv[4];
#pragma unroll
            for (int k = 0; k < 6; ++k) { const long ro = (k < 2) ? (long)(k - 2) * back : (long)(k - 2); xv[k] = *(const GAS v4u*)(up + ro * UST + C_XB + c0); gv[k] = *(const GAS v4u*)(up + ro * UST + C_CB + c0); }
#pragma unroll
            for (int i = 0; i < 4; ++i) bv[i] = *(const GAS v4u*)(up + (size_t)i * UST + C_BB + c0);
            float uu[6][8];
#pragma unroll
            for (int k = 0; k < 6; ++k) { const float mk = (k < 2) ? mb : 1.f;
                uu[k][0] = mk * bflo(xv[k].x) * bflo(gv[k].x); uu[k][1] = mk * bfhi(xv[k].x) * bfhi(gv[k].x); uu[k][2] = mk * bflo(xv[k].y) * bflo(gv[k].y); uu[k][3] = mk * bfhi(xv[k].y) * bfhi(gv[k].y);
                uu[k][4] = mk * bflo(xv[k].z) * bflo(gv[k].z); uu[k][5] = mk * bfhi(xv[k].z) * bfhi(gv[k].z); uu[k][6] = mk * bflo(xv[k].w) * bflo(gv[k].w); uu[k][7] = mk * bfhi(xv[k].w) * bfhi(gv[k].w); }
#pragma unroll
            for (int i = 0; i < 4; ++i) { float cv[8];
#pragma unroll
                for (int k = 0; k < 8; ++k) cv[k] = w2[k] * uu[i + 2][k] + w1[k] * uu[i + 1][k] + w0[k] * uu[i][k];
                v4u w; w.x = pk2(cv[0] * bflo(bv[i].x), cv[1] * bfhi(bv[i].x)); w.y = pk2(cv[2] * bflo(bv[i].y), cv[3] * bfhi(bv[i].y)); w.z = pk2(cv[4] * bflo(bv[i].z), cv[5] * bfhi(bv[i].z)); w.w = pk2(cv[6] * bflo(bv[i].w), cv[7] * bfhi(bv[i].w));
                *(GAS v4u*)(Y + (size_t)(rl0 + i) * 1024 + 256 + c0) = w; }
        }
    }
    {
        const int gq = lane >> 4, c4 = (lane & 15) * 4, wlen = 2 << gq;
        for (int ch = gw; ch < HROWS / 8; ch += NGW) {
            const int rl0 = ch * 8, t0 = rl0 & (SEQ - 1); const bf16* pp = U + (size_t)rl0 * UST + C_PC + gq * 64 + c4;
            v2u xr[23];
#pragma unroll
            for (int i = 0; i < 23; ++i) { const int d = i - 15; const long ro = (t0 + d >= 0) ? (long)d : 0; xr[i] = *(const GAS v2u*)(pp + ro * UST); }
            float xf[23][4];
#pragma unroll
            for (int i = 0; i < 23; ++i) { const float mk = (t0 + i - 15 >= 0) ? 1.f : 0.f; xf[i][0] = mk * bflo(xr[i].x); xf[i][1] = mk * bfhi(xr[i].x); xf[i][2] = mk * bflo(xr[i].y); xf[i][3] = mk * bfhi(xr[i].y); }
#pragma unroll
            for (int tk = 0; tk < 8; ++tk) { float s0 = 0.f, s1 = 0.f, s2 = 0.f, s3 = 0.f;
#pragma unroll
                for (int j = 0; j < 16; ++j) { const float mk = j < wlen ? 1.f : 0.f; s0 += mk * xf[15 + tk - j][0]; s1 += mk * xf[15 + tk - j][1]; s2 += mk * xf[15 + tk - j][2]; s3 += mk * xf[15 + tk - j][3]; }
                const int t = t0 + tk; const int cnt = (t + 1) < wlen ? (t + 1) : wlen; const float ic = 1.0f / (float)cnt;
                v2u w; w.x = pk2(s0 * ic - xf[15 + tk][0], s1 * ic - xf[15 + tk][1]); w.y = pk2(s2 * ic - xf[15 + tk][2], s3 * ic - xf[15 + tk][3]);
                *(GAS v2u*)(Y + (size_t)(rl0 + tk) * 1024 + 512 + gq * 64 + c4) = w; }
        }
    }
    __syncthreads();
}

__device__ __forceinline__ void ph_attn(CArgs& args, int l, const bf16* U, const float* kmean, bf16* Y, LAS unsigned char* lds, const int wave0) {
    const float* dl = args.in[7] + (size_t)l * 128; const float* subg = args.in[8] + (size_t)l * 64;
    float a = 0.f, b = 0.f;
    for (int i = 0; i < 32; ++i) { a += dl[i] * dl[32 + i]; b += dl[64 + i] * dl[96 + i]; }
    int l_s = l; asm volatile("" : "+s"(l_s));
    const float lam_init = (l_s == 0) ? 0.2f : 0.35550906759096926f;
    const float lam = __expf(a) - __expf(b) + lam_init, outscale = 1.0f - lam_init;
    const LAS float* lut = (const LAS float*)(lds + LUT_OFF);
    for (int cu0 = blockIdx.x; cu0 < HB * 4 * 4; cu0 += gridDim.x) {
        const int cu = (gridDim.x == 256) ? ((cu0 & 7) * 32 + (cu0 >> 3)) : cu0;
        const int bh = cu >> 2, pr = cu & 3, bl = bh >> 2, h = bh & 3;
#pragma unroll 1
        for (int k = 0; k < 2; ++k) attn_unit<false>(U, kmean, Y, lut, lds, bl, h, k ? 7 - pr : pr, wave0, 0.f, 0.f, subg);
#pragma unroll 1
        for (int k = 0; k < 2; ++k) attn_unit<true>(U, kmean, Y, lut, lds, bl, h, k ? 7 - pr : pr, wave0, lam, outscale, subg);
    }
}

__device__ __forceinline__ void ph_route(CArgs& args, int l, const bf16* R, unsigned* route, int* tokp, gu32* ctl, LAS unsigned char* lds, const int wave0) {
    const int tid = fresh_tid(), lane = tid & 63, wave = __builtin_amdgcn_readfirstlane(tid >> 6), gw = blockIdx.x * NWAVES + wave, NGW = gridDim.x * NWAVES;
    const float* g = args.in[11] + (size_t)l * D;
    LAS float* rl = (LAS float*)lds;
    { const float* rw = args.in[15]; for (int i = tid; i < D * 8; i += NWAVES * 64) rl[i] = rw[i] * g[i >> 3]; }
    for (int i = blockIdx.x * NWAVES * 64 + tid; i < 2 * CAPROWS; i += gridDim.x * NWAVES * 64) tokp[i] = -1;
    __syncthreads();
    for (int m0 = gw; m0 < M; m0 += 4 * NGW) {
        v4u xr[4][2];
#pragma unroll
        for (int q = 0; q < 4; ++q)
#pragma unroll
            for (int j = 0; j < 2; ++j) xr[q][j] = *(const GAS v4u*)(R + (size_t)(m0 + q * NGW) * D + 8 * lane + 512 * j);
        int i0q[4], i1q[4]; float w0q[4], w1q[4], rq[4];
#pragma unroll
        for (int q = 0; q < 4; ++q) {
            float v[16], ss = 0.f;
#pragma unroll
            for (int j = 0; j < 2; ++j) { v[8 * j + 0] = bflo(xr[q][j].x); v[8 * j + 1] = bfhi(xr[q][j].x); v[8 * j + 2] = bflo(xr[q][j].y); v[8 * j + 3] = bfhi(xr[q][j].y); v[8 * j + 4] = bflo(xr[q][j].z); v[8 * j + 5] = bfhi(xr[q][j].z); v[8 * j + 6] = bflo(xr[q][j].w); v[8 * j + 7] = bfhi(xr[q][j].w); }
#pragma unroll
            for (int k = 0; k < 16; ++k) ss += v[k] * v[k];
            float lg[8];
#pragma unroll
            for (int e = 0; e < 8; ++e) lg[e] = 0.f;
#pragma unroll
            for (int j = 0; j < 2; ++j)
#pragma unroll
                for (int k = 0; k < 8; ++k) { const int c = 8 * lane + 512 * j + k; const f32x4 ra = *(const LAS f32x4*)(rl + c * 8), rb = *(const LAS f32x4*)(rl + c * 8 + 4); const float xv = v[8 * j + k];
                    lg[0] += xv * ra.x; lg[1] += xv * ra.y; lg[2] += xv * ra.z; lg[3] += xv * ra.w; lg[4] += xv * rb.x; lg[5] += xv * rb.y; lg[6] += xv * rb.z; lg[7] += xv * rb.w; }
#define RT_X(k_, val_) __int_as_float(__builtin_amdgcn_ds_bpermute((lane ^ (k_)) << 2, __float_as_int(val_)))
            { const bool b1 = (lane & 1) != 0, b2 = (lane & 2) != 0, b3 = (lane & 4) != 0;
              float a4[4], c2[2], d1;
#pragma unroll
              for (int i = 0; i < 4; ++i) { const float snd = b1 ? lg[i] : lg[4 + i], kp = b1 ? lg[4 + i] : lg[i]; a4[i] = kp + RT_X(1, snd); }
#pragma unroll
              for (int i = 0; i < 2; ++i) { const float snd = b2 ? a4[i] : a4[2 + i], kp = b2 ? a4[2 + i] : a4[i]; c2[i] = kp + RT_X(2, snd); }
              { const float snd = b3 ? c2[0] : c2[1], kp = b3 ? c2[1] : c2[0]; d1 = kp + RT_X(4, snd); }
              d1 += RT_X(8, d1); d1 += RT_X(16, d1); d1 += RT_X(32, d1);
              const float r = 1.0f / sqrtf(wave_sum(ss, lane) * (1.f / D) + RMS_EPS); rq[q] = r;
#pragma unroll
              for (int e = 0; e < 8; ++e) lg[e] = r * __int_as_float(__builtin_amdgcn_readlane(__float_as_int(d1), ((e >> 2) & 1) | (((e >> 1) & 1) << 1) | ((e & 1) << 2))); }
#undef RT_X
            int i0 = 0; float v0 = lg[0];
#pragma unroll
            for (int e = 1; e < 8; ++e) if (lg[e] > v0) { v0 = lg[e]; i0 = e; }
            int i1 = 0; float v1 = -3.0e38f;
#pragma unroll
            for (int e = 0; e < 8; ++e) if (e != i0 && lg[e] > v1) { v1 = lg[e]; i1 = e; }
            const float e1 = __expf(v1 - v0); w0q[q] = 1.0f / (1.0f + e1); w1q[q] = e1 * w0q[q]; i0q[q] = i0; i1q[q] = i1;
        }
        if (lane == 0) {
            unsigned s0[4], s1[4];
#pragma unroll
            for (int q = 0; q < 4; ++q) { s0[q] = atomicAdd((unsigned*)(ctl + CW_CNT + (0 * 8 + i0q[q]) * 64), 1u); s1[q] = atomicAdd((unsigned*)(ctl + CW_CNT + (1 * 8 + i1q[q]) * 64), 1u); }
#pragma unroll
            for (int q = 0; q < 4; ++q) { unsigned* rec = route + (size_t)(m0 + q * NGW) * 8; rec[0] = (unsigned)i0q[q] | ((unsigned)i1q[q] << 8); rec[1] = s0[q]; rec[2] = s1[q]; rec[3] = __float_as_uint(w0q[q]); rec[4] = __float_as_uint(w1q[q]); rec[5] = __float_as_uint(rq[q]); }
        }
    }
}

__device__ __forceinline__ void ph_gather(CArgs& args, int l, const bf16* R, const unsigned* route, int* tokp, float* gatep, int* tile_e, int* n_rt, unsigned char* hperm, gu32* ctl, LAS unsigned char* lds, const int wave0) {
    const int tid = fresh_tid(), lane = tid & 63, wave = __builtin_amdgcn_readfirstlane(tid >> 6), gw = blockIdx.x * NWAVES + wave, NGW = gridDim.x * NWAVES;
    const float* g = args.in[11] + (size_t)l * D;
    LAS int* base = (LAS int*)lds;
    if (tid < 2) { int acc = 0;
        for (int e = 0; e < 8; ++e) { base[tid * 8 + e] = acc; const int c = (int)__hip_atomic_load((unsigned*)(ctl + CW_CNT + (tid * 8 + e) * 64), RLX_AGENT); acc += (c + 255) & ~255; }
        base[16 + tid] = acc; }
    __syncthreads();
    if (blockIdx.x == 0 && tid < 2) { const int p = tid, nt = base[16 + p] >> 8; n_rt[p] = nt;
        for (int rt = 0; rt < nt; ++rt) { int e = 0; for (int k = 1; k < 8; ++k) if (rt * 256 >= base[p * 8 + k]) e = k; tile_e[p * 512 + rt] = e; } }
    for (int m0 = gw; m0 < M; m0 += 4 * NGW) {
        v4u xr[4][2]; unsigned ee[4], sl0[4], sl1[4], gw0[4], gw1[4], rs5[4];
#pragma unroll
        for (int q = 0; q < 4; ++q) { const size_t m = (size_t)(m0 + q * NGW);
#pragma unroll
            for (int j = 0; j < 2; ++j) xr[q][j] = *(const GAS v4u*)(R + m * D + 8 * lane + 512 * j);
            const unsigned* rec = route + m * 8; ee[q] = rec[0]; sl0[q] = rec[1]; sl1[q] = rec[2]; gw0[q] = rec[3]; gw1[q] = rec[4]; rs5[q] = rec[5]; }
#pragma unroll
        for (int q = 0; q < 4; ++q) { const int m = m0 + q * NGW;
            float v[16]; const float r = __uint_as_float(rs5[q]);
#pragma unroll
            for (int j = 0; j < 2; ++j) { const f32x4 g0 = *(const GAS f32x4*)(g + 8 * lane + 512 * j), g1 = *(const GAS f32x4*)(g + 8 * lane + 512 * j + 4); const v4u x = xr[q][j];
                v[8 * j + 0] = bflo(x.x) * (r * g0.x); v[8 * j + 1] = bfhi(x.x) * (r * g0.y); v[8 * j + 2] = bflo(x.y) * (r * g0.z); v[8 * j + 3] = bfhi(x.y) * (r * g0.w);
                v[8 * j + 4] = bflo(x.z) * (r * g1.x); v[8 * j + 5] = bfhi(x.z) * (r * g1.y); v[8 * j + 6] = bflo(x.w) * (r * g1.z); v[8 * j + 7] = bfhi(x.w) * (r * g1.w); }
            const int e0 = ee[q] & 255, e1 = (ee[q] >> 8) & 255;
            const int pos0 = base[e0] + (int)sl0[q], pos1 = base[8 + e1] + (int)sl1[q];
            rowb_store_fp8(hperm + (size_t)pos0 * D, lane, v); rowb_store_fp8(hperm + ((size_t)CAPROWS + pos1) * D, lane, v);
            if (lane == 0) { tokp[pos0] = m; tokp[CAPROWS + pos1] = m; gatep[pos0] = __uint_as_float(gw0[q]); gatep[CAPROWS + pos1] = __uint_as_float(gw1[q]); } }
    }
    __syncthreads();
}

__global__ void __launch_bounds__(NWAVES * 64, 2) mega_fwd(Args args0) {
    extern __shared__ __attribute__((aligned(16))) unsigned char lds_raw[];
    LAS unsigned char* lds = (LAS unsigned char*)lds_raw;
    volatile LAS unsigned* MISC = (volatile LAS unsigned*)(lds + MISC_OFF);
    const int G = gridDim.x;
    const int wave0 = __builtin_amdgcn_readfirstlane((int)(threadIdx.x >> 6));
    gu32* ctl = (gu32*)(args0.ws + WS_CTL);
    { const int tid = threadIdx.x;
      for (int i = tid; i < (LDS_BYTES - LDSCTL_OFF) / 4; i += NWAVES * 64) ((LAS unsigned*)(lds + LDSCTL_OFF))[i] = 0u;
      LAS float* lut = (LAS float*)(lds + LUT_OFF); const float* bt = args0.in[1];
      for (int i = tid; i < 8 * LUT_N; i += NWAVES * 64) { const int hd = i / LUT_N, n = i % LUT_N - LUT_NEG; lut[i] = (n < 0) ? -1.0e30f : 1.4426950408889634f * bt[(int)BKT[n > 128 ? 128 : n] * 8 + hd]; }
      if (tid < 256) { const float gv = __builtin_amdgcn_cvt_f32_fp8(tid, 0); ((LAS float*)(lds + SLUT_OFF))[tid] = 1.0f / (1.0f + __expf(-gv)); } }
    __syncthreads();
    XcdBarrier bar; bar.bar = (unsigned*)(ctl + CW_BAR) + args0.li * XCD_BAR_WORDS; bar.x = 0; bar.st = nullptr;
#if MK_ONE_LAUNCH
    bar = xcd_barrier_post((unsigned*)(ctl + CW_BAR) + args0.li * XCD_BAR_WORDS, MISC + 8);
#define GRID_BAR() xcd_barrier(bar)
#else
    (void)MISC;
#define GRID_BAR() do { } while (0)
#endif
    const int lo = args0.ph_lo, hi = args0.ph_hi;
#define IN(k) (lo <= (k) && (k) < hi)
#define BOTH(k) (IN(k) && IN((k) + 1))

#define OPQ_PTRS CArgs* ka_ = (CArgs*)__builtin_amdgcn_kernarg_segment_ptr(); asm volatile("" : "+s"(ka_)); CArgs& args = *ka_; unsigned char* ws = args.ws; bf16* R = (bf16*)(ws + WS_R); \
        bf16* Hn = (bf16*)(ws + WS_H); bf16* U = (bf16*)(ws + WS_U); bf16* Y = (bf16*)(ws + WS_Y); bf16* MG = (bf16*)(ws + WS_MG); float* kmean = (float*)(ws + WS_KMEAN); \
        unsigned* route = (unsigned*)(ws + WS_ROUTE); int* tokp = (int*)(ws + WS_TOK); float* gatep = (float*)(ws + WS_GATE); int* tile_e = (int*)(ws + WS_TILEE); int* n_rt = (int*)(ws + WS_TILEE + 4096); \
        (void)Hn; (void)U; (void)Y; (void)MG; (void)kmean; (void)route; (void)tokp; (void)gatep; (void)tile_e; (void)n_rt; (void)R
#define OPQ_I(name, v) int name = (v); asm volatile("" : "+s"(name))

    if (IN(0)) { OPQ_PTRS; ph_prologue(args, lds, wave0); ph_norm_bf16(args.in[0], args.in[2], Hn, ws + WS_A8, wave0); if (BOTH(0)) GRID_BAR(); }

    for (int l_ = 0; l_ < 2; ++l_) {
        const int pb = 1 + 17 * l_;
        for (int hf_ = 0; hf_ < 2; ++hf_) {
            const int p2 = pb + 1 + 5 * hf_;
            if (IN(p2)) {
                OPQ_PTRS; OPQ_I(l, l_); OPQ_I(hf, hf_); const size_t r0 = (size_t)hf * HROWS;
                const float* ssq1 = l == 0 ? (const float*)nullptr : (const float*)(ws + SSQ1_OFF) + r0 * 16;
                {
                    pg8::Gemm g{(l == 0 ? Hn : R) + r0 * D, (const bf16*)(ws + WS_WIN) + (size_t)l * GCOL0 * D, D, D, D};
                    pg8::Order S; S.init(HROWS / 256, GCOL0 / 256, G, (int)blockIdx.x, 0, D, D, nullptr, 0);
                    pg8::EpiWin E{U, UST, ssq1, 1 << 20, kmean, C_KA / 256};
                    pg8::gemm_phase<pg8::EpiWin, pg8::Order, true>(lds, fresh_tid(), g, S, E);
                }
                {
                    pg8::Gemm g{(const bf16*)(ws + WS_A8 + r0 * D), (const bf16*)(ws + WS_WG8 + (size_t)l * (WIN - GCOL0) * D), D / 2, D / 2, D / 2};
                    pg8::Order S; S.init(HROWS / 256, (WIN - GCOL0) / 256, G, (int)blockIdx.x, 0, D / 2, D / 2, nullptr, 0);
                    pg8::EpiGate8 E{(unsigned char*)U, 2 * UST, 2 * GCOL0, ssq1};
                    pg8::gemm_phase<pg8::EpiGate8, pg8::Order, true, true>(lds, fresh_tid(), g, S, E);
                }
                if (BOTH(p2)) GRID_BAR();
            }
            if (IN(p2 + 2)) {
                OPQ_PTRS; OPQ_I(l, l_);
                ph_conv_pool(args, l, U, Y, lds, wave0);
                ph_attn(args, l, U, kmean, Y, lds, wave0);
                if (BOTH(p2 + 2)) GRID_BAR();
            }
            if (IN(p2 + 3)) {
                OPQ_PTRS; OPQ_I(l, l_);
                pg8::Gemm g{Y, (const bf16*)(ws + WS_BP) + (size_t)l * 4 * D * 256, 1024, 256, 256};
                pg8::Order S; S.init(HROWS / 256, 4, G, (int)blockIdx.x, 1, 1024, 256, nullptr, (size_t)D * 256 * 2);
                pg8::EpiMerge E{U, UST, GCOL0, MG, 1024, (const LAS float*)(lds + SLUT_OFF)};
                pg8::gemm_phase<pg8::EpiMerge, pg8::Order, true>(lds, fresh_tid(), g, S, E);
                if (BOTH(p2 + 3)) GRID_BAR();
            }
            if (IN(p2 + 4)) {
                OPQ_PTRS; OPQ_I(l, l_); OPQ_I(hf, hf_); const size_t r0 = (size_t)hf * HROWS;
                pg8::Gemm g{MG, (const bf16*)(ws + WS_WOUT) + (size_t)l * D * D, D, D, D};
                pg8::Order S; S.init(HROWS / 256, 4, G, (int)blockIdx.x, 0, D, D, nullptr, 0);
                pg8::EpiRes E{args.in[0] + r0 * D, (l == 0) ? (const bf16*)nullptr : (const bf16*)(R + r0 * D), R + r0 * D, D, (l == 0) ? (float*)(ws + SSQ0_OFF) + r0 * 16 : (float*)nullptr};
                pg8::gemm_phase<pg8::EpiRes, pg8::Order, true>(lds, fresh_tid(), g, S, E);
                if (hf == 1 && BOTH(p2 + 4)) GRID_BAR();
            }
        }
        if (IN(pb + 11)) {
            OPQ_PTRS; OPQ_I(l, l_);
            if (l == 1) { ph_route(args, l, R, route, tokp, ctl, lds, wave0); if (BOTH(pb + 11)) GRID_BAR(); }
        }
        if (IN(pb + 12)) {
            OPQ_PTRS; OPQ_I(l, l_);
            if (l == 1) { ph_gather(args, l, R, route, tokp, gatep, tile_e, n_rt, ws + WS_HPERM, ctl, lds, wave0); if (BOTH(pb + 12)) GRID_BAR(); }
        }
        for (int ps_ = 0; ps_ < 2; ++ps_) {
            const int p3 = pb + 13 + 2 * ps_;
            if (IN(p3)) {
                OPQ_PTRS; OPQ_I(l, l_); OPQ_I(ps, ps_);
                if (l == 1) {
                    if (ps == 0) {
                        const int n0 = __builtin_amdgcn_readfirstlane(n_rt[0]), n1 = __builtin_amdgcn_readfirstlane(n_rt[1]);
                        pg8::Gemm g{(const bf16*)(ws + WS_HPERM), (const bf16*)(ws + WS_W13E), D / 2, D / 2, D / 2};
                        pg8::Order S; S.init(n0 + n1, 2 * FFE / 256, G, (int)blockIdx.x, 0, D / 2, D / 2, tile_e, (size_t)2 * FFE * D, n0, CAPT);
                        pg8::EpiSwiGLU8 E{ws + WS_TE, FFE, 256.0f, 8.0f};
                        pg8::gemm_phase<pg8::EpiSwiGLU8, pg8::Order, true, true>(lds, fresh_tid(), g, S, E);
                        if (BOTH(p3)) GRID_BAR();
                    }
                } else if (ps == 0) {
                    pg8::Gemm g{R, (const bf16*)(ws + WS_W13D), D, D, D};
                    pg8::Order S; S.init(M / 256, 2 * FF0 / 256, G, (int)blockIdx.x, 0, D, D, nullptr, 0);
                    pg8::EpiSwiGLU E{U, FF0, (const float*)(ws + SSQ0_OFF), 1};
                    pg8::gemm_phase<pg8::EpiSwiGLU, pg8::Order, true>(lds, fresh_tid(), g, S, E);
                    if (BOTH(p3)) GRID_BAR();
                }
            }
            if (IN(p3 + 1)) {
                OPQ_PTRS; OPQ_I(l, l_); OPQ_I(ps, ps_);
                if (l == 1) {
                    if (ps == 0) {
                        const int n0 = __builtin_amdgcn_readfirstlane(n_rt[0]), n1 = __builtin_amdgcn_readfirstlane(n_rt[1]);
                        pg8::Gemm g{(const bf16*)(ws + WS_TE), (const bf16*)(ws + WS_W2E), FFE / 2, FFE / 2, FFE / 2};
                        pg8::Order S; S.init(n0 + n1, 4, G, (int)blockIdx.x, 0, FFE / 2, FFE / 2, tile_e, (size_t)D * FFE, n0, CAPT);
                        pg8::EpiScatter E{R, D, tokp, gatep, 1.0f / 128.0f, nullptr, nullptr, (bf16*)args.out, 2048};
                        pg8::gemm_phase<pg8::EpiScatter, pg8::Order, true, true>(lds, fresh_tid(), g, S, E);
                        if (BOTH(p3 + 1)) GRID_BAR();
                    }
                } else if (ps == 0) {
                    pg8::Gemm g{U, (const bf16*)(ws + WS_W2D), FF0 / 2, FF0 / 2, FF0 / 2};
                    pg8::Order S; S.init(M / 256, 4, G, (int)blockIdx.x, 0, FF0 / 2, FF0 / 2, nullptr, 0);
                    pg8::EpiScatter E{R, D, nullptr, nullptr, 1.0f / 128.0f, (float*)(ws + SSQ1_OFF), ws + WS_A8, nullptr, 0};
                    pg8::gemm_phase<pg8::EpiScatter, pg8::Order, true, true>(lds, fresh_tid(), g, S, E);
                    if (BOTH(p3 + 1)) GRID_BAR();
                }
            }
        }
    }
    if (IN(35)) { OPQ_PTRS; ph_final_norm(R, args.in[19], args.out, wave0); }
#undef IN
#undef BOTH
}

extern "C" void kernel_launch(void* const* d_in, const int* in_sizes, int n_in, void* d_out, int out_size, void* d_ws, size_t ws_size, hipStream_t stream) {
    static int grid = 0;
    if (grid == 0) {
        if (n_in != 20 || in_sizes[0] != M * D || out_size != M * D || ws_size < WS_END) { fprintf(stderr, "kernel_launch: unexpected shapes / workspace (n_in %d, ws %zu); nothing launched\n", n_in, ws_size); grid = -1; return; }
        int dev = 0, cus = 0, per_cu = 0;
        if (hipGetDevice(&dev) != hipSuccess || hipDeviceGetAttribute(&cus, hipDeviceAttributeMultiprocessorCount, dev) != hipSuccess) { grid = -1; return; }
        if (hipFuncSetAttribute((const void*)mega_fwd, hipFuncAttributeMaxDynamicSharedMemorySize, LDS_BYTES) != hipSuccess) { fprintf(stderr, "kernel_launch: hipFuncSetAttribute failed\n"); grid = -1; return; }
        if (hipOccupancyMaxActiveBlocksPerMultiprocessor(&per_cu, (const void*)mega_fwd, NWAVES * 64, LDS_BYTES) != hipSuccess || per_cu < 1) { fprintf(stderr, "kernel_launch: occupancy query reports %d\n", per_cu); }
        (void)hipGetLastError();
        grid = cus;
    }
    if (grid < 0) return;
    if (hipMemsetAsync((char*)d_ws + WS_CTL, 0, CTL_ZERO_BYTES, stream) != hipSuccess) return;
    Args a{};
    for (int i = 0; i < 20; ++i) a.in[i] = (const float*)d_in[i];
    a.out = (float*)d_out; a.ws = (unsigned char*)d_ws;
#if MK_ONE_LAUNCH
#ifdef PROBE_DUP
    { const int dup[] = {PROBE_DUP}; const int nd = (int)(sizeof(dup) / sizeof(int)); int lo = 0;
      for (int i = 0; i <= nd; ++i) { a.ph_lo = lo; a.ph_hi = (i < nd) ? dup[i] + 1 : 36; a.li = i; hipLaunchKernelGGL(mega_fwd, dim3(grid), dim3(NWAVES * 64), LDS_BYTES, stream, a); if (i < nd) lo = dup[i]; } }
#else
    a.ph_lo = 0; a.ph_hi = 36;
    hipLaunchKernelGGL(mega_fwd, dim3(grid), dim3(NWAVES * 64), LDS_BYTES, stream, a);
#endif
#else
    for (int p = 0; p < 36; ++p) {
        if (p == 1 + 12 || p == 1 + 15 || p == 1 + 16) continue;
        a.ph_lo = p; a.ph_hi = p + 1;
        hipLaunchKernelGGL(mega_fwd, dim3(grid), dim3(NWAVES * 64), LDS_BYTES, stream, a);
    }
#endif
}
```

```cpp
#include <hip/hip_runtime.h>
#include <cstdio>
#include <cstdint>

#ifndef MK_ONE_LAUNCH
#define MK_ONE_LAUNCH 1
#endif

namespace pg8 {
#define PG8_LAS __attribute__((address_space(3)))
typedef unsigned short bf16_t;
typedef short bf16x8 __attribute__((ext_vector_type(8)));
typedef float f32x4 __attribute__((ext_vector_type(4)));
typedef unsigned u32x4 __attribute__((ext_vector_type(4)));
typedef unsigned u32x2 __attribute__((ext_vector_type(2)));
typedef int i32x4 __attribute__((ext_vector_type(4)));
typedef int i32x8 __attribute__((ext_vector_type(8)));
constexpr int BM = 256, BK = 64, HALF = 128, HTB = HALF * BK * 2  , STAGE_BYTES = 8 * HTB, NXCD = 8, WGM = 8;

__host__ __device__ __forceinline__ int lds_byte(int r, int c) { const int st = (r >> 4) * 2 + (c >> 5), rr = r & 15, cc = c & 31, ob = rr * 64 + cc * 2; return st * 1024 + (ob ^ (((ob >> 9) & 1) << 5)); }
__host__ __device__ __forceinline__ void stage_rc(int b, int& R, int& C) { const int st = b / 1024, sb = b % 1024, swz = sb ^ (((sb >> 9) & 1) << 5); R = (st >> 1) * 16 + swz / 64; C = (st & 1) * 32 + (swz % 64) / 2; }
__host__ __device__ __forceinline__ int perm32(int rho) { const int n = rho >> 4, i = rho & 15; return 8 * (i >> 2) + 4 * n + (i & 3); }

struct Unit { int pm, pn, e, prow, second; size_t aoff, boff; };
struct Gemm { const bf16_t* A; const bf16_t* Bt; int lda, ldb, K; };

struct Order {
    int nM, nN, nwg, G, c, mode, n0, skip; size_t arow  , brow  , estride; const int* tile_e;
    __device__ __forceinline__ void init(int nM_, int nN_, int G_, int c_, int mode_, int lda, int ldb, const int* te, size_t es, int n0_ = 1 << 30, int skip_ = 0) {
        nM = nM_; nN = nN_; nwg = nM * nN; G = G_; c = c_; mode = mode_; arow = (size_t)BM * lda * 2; brow = (size_t)BM * ldb * 2; tile_e = te; estride = es; n0 = n0_; skip = skip_; }
    __device__ __forceinline__ bool base(int i, Unit& u) const {
        const long L = (long)i * G + c; if (L >= nwg) return false;
        int wgid = (int)L; { const int q = nwg / NXCD, r = nwg % NXCD, xcd = wgid % NXCD, off = wgid / NXCD; wgid = (xcd < r ? xcd * (q + 1) : r * (q + 1) + (xcd - r) * q) + off; }
        const int nig = WGM * nN, gid = wgid / nig, fm = gid * WGM, gsz = (nM - fm) < WGM ? (nM - fm) : WGM;
        u.pm = fm + ((wgid % nig) % gsz); u.pn = (wgid % nig) / gsz; return true;
    }
    __device__ __forceinline__ bool next(int i, Unit& u) const {
        if (mode == 1) { if (!base(i >> 2, u)) return false; u.e = i & 3; u.prow = u.pm; u.second = 0; u.aoff = (size_t)u.pm * arow + (size_t)u.e * 512; u.boff = (size_t)u.e * estride + (size_t)u.pn * brow; return true; }
        if (!base(i, u)) return false;
        const bool second = u.pm >= n0; u.prow = second ? skip + (u.pm - n0) : u.pm; u.second = second ? 1 : 0;
        u.e = tile_e ? __builtin_amdgcn_readfirstlane(tile_e[second ? 512 + (u.pm - n0) : u.pm]) : 0; u.aoff = (size_t)u.prow * arow; u.boff = (size_t)u.e * estride + (size_t)u.pn * brow; return true;
    }
    __device__ __forceinline__ void a_ready(const Unit&) const {}
    __device__ __forceinline__ void done(const Unit&) const {}
};

__device__ __forceinline__ int fresh_lane() { int lane; asm volatile("v_mbcnt_lo_u32_b32 %0, -1, 0\n\tv_mbcnt_hi_u32_b32 %0, -1, %0" : "=v"(lane)); return lane; }
typedef float f32x2p __attribute__((ext_vector_type(2)));
typedef __bf16 bf16x2p __attribute__((ext_vector_type(2)));
__device__ __forceinline__ unsigned cvt_pk_bf16(float lo, float hi) { const f32x2p f = {lo, hi}; const bf16x2p b = __builtin_convertvector(f, bf16x2p); return __builtin_bit_cast(unsigned, b); }
__device__ __forceinline__ float bflo(unsigned w) { return __uint_as_float(w << 16); }
__device__ __forceinline__ float bfhi(unsigned w) { return __uint_as_float(w & 0xffff0000u); }
__device__ __forceinline__ float sigmoidf_(float x) { return __builtin_amdgcn_rcpf(1.0f + __expf(-x)); }

__device__ __forceinline__ void ssq_put(float* ssq, int row, int slot, float part, int lane_) {
    part += __int_as_float(__builtin_amdgcn_ds_bpermute((lane_ ^ 16) << 2, __float_as_int(part)));
    part += __int_as_float(__builtin_amdgcn_ds_bpermute((lane_ ^ 32) << 2, __float_as_int(part)));
    if (lane_ < 16) ssq[(size_t)row * 16 + slot] = part;
}
__device__ __forceinline__ float ssq_rs(const float* ssq, int row) {
    const f32x4* p = (const f32x4*)(ssq + (size_t)row * 16); const f32x4 a = p[0], b = p[1], c = p[2], d = p[3];
    const float t = (((a[0] + a[1]) + (a[2] + a[3])) + ((b[0] + b[1]) + (b[2] + b[3]))) + (((c[0] + c[1]) + (c[2] + c[3])) + ((d[0] + d[1]) + (d[2] + d[3])));
    return __builtin_amdgcn_rsqf(t * (1.0f / 1024.0f) + 1e-6f);
}
__device__ __forceinline__ float ssq_ms(const float* ssq, int row) {
    const f32x4* p = (const f32x4*)(ssq + (size_t)row * 16); const f32x4 a = p[0], b = p[1], c = p[2], d = p[3];
    const float t = (((a[0] + a[1]) + (a[2] + a[3])) + ((b[0] + b[1]) + (b[2] + b[3]))) + (((c[0] + c[1]) + (c[2] + c[3])) + ((d[0] + d[1]) + (d[2] + d[3])));
    return t * (1.0f / 1024.0f) + 1e-6f;
}
struct EpiWin {
    static constexpr bool PERM = true, AFTER_DRAIN = false;
    bf16_t* O; int ldc; const float* ssq; int gate_pn; float* kmp; int kpn;
    __device__ __forceinline__ void operator()(const f32x4 (&acc)[2][2][4][2], const Unit& u, int wr, int wc, int, int) const {
        const int lane_ = fresh_lane(), fr = lane_ & 15, fq = lane_ >> 4;
        const int row0 = u.pm * BM + wr * 64 + fr, col0 = u.pn * BM + wc * 32 + 8 * fq; const bool gt = u.pn >= gate_pn;
        const bool km = (u.pn == kpn); float cs[2][8];
#pragma unroll
        for (int b_ = 0; b_ < 2; ++b_)
#pragma unroll
            for (int k_ = 0; k_ < 8; ++k_) cs[b_][k_] = 0.f;
#pragma unroll
        for (int ai = 0; ai < 2; ++ai)
#pragma unroll
            for (int m = 0; m < 4; ++m) { const int r = row0 + ai * HALF + m * 16; bf16_t* rowp = O + (size_t)r * ldc;
                const float rs = ssq ? ssq_rs(ssq, r) : 1.0f;
#pragma unroll
                for (int bj = 0; bj < 2; ++bj) { const f32x4 v0 = acc[ai][bj][m][0] * rs, v1 = acc[ai][bj][m][1] * rs;
                    if (km) { cs[bj][0] += v0[0]; cs[bj][1] += v0[1]; cs[bj][2] += v0[2]; cs[bj][3] += v0[3]; cs[bj][4] += v1[0]; cs[bj][5] += v1[1]; cs[bj][6] += v1[2]; cs[bj][7] += v1[3]; }
                    if (gt) { u32x2 w; { int t_ = 0; t_ = __builtin_amdgcn_cvt_pk_fp8_f32(v0[0], v0[1], t_, false); t_ = __builtin_amdgcn_cvt_pk_fp8_f32(v0[2], v0[3], t_, true); w.x = (unsigned)t_; }
                        { int t_ = 0; t_ = __builtin_amdgcn_cvt_pk_fp8_f32(v1[0], v1[1], t_, false); t_ = __builtin_amdgcn_cvt_pk_fp8_f32(v1[2], v1[3], t_, true); w.y = (unsigned)t_; }
                        *(u32x2*)((unsigned char*)rowp + 512 * gate_pn + (col0 - BM * gate_pn) + bj * HALF) = w; }
                    else { u32x4 w; w.x = cvt_pk_bf16(v0[0], v0[1]); w.y = cvt_pk_bf16(v0[2], v0[3]); w.z = cvt_pk_bf16(v1[0], v1[1]); w.w = cvt_pk_bf16(v1[2], v1[3]);
                        *(u32x4*)(rowp + col0 + bj * HALF) = w; } } }
        if (km) {
#pragma unroll
            for (int b_ = 0; b_ < 2; ++b_)
#pragma unroll
                for (int k_ = 0; k_ < 8; ++k_) { float x = cs[b_][k_];
#pragma unroll
                    for (int o_ = 1; o_ < 16; o_ <<= 1) x += __int_as_float(__builtin_amdgcn_ds_bpermute((lane_ ^ o_) << 2, __float_as_int(x)));
                    cs[b_][k_] = x; }
            if (fr == 0) { float* kp = kmp + ((size_t)u.pm * 2 + wr) * 256 + wc * 32 + 8 * fq;
#pragma unroll
                for (int b_ = 0; b_ < 2; ++b_) { *(f32x4*)(kp + b_ * HALF) = (f32x4){cs[b_][0], cs[b_][1], cs[b_][2], cs[b_][3]}; *(f32x4*)(kp + b_ * HALF + 4) = (f32x4){cs[b_][4], cs[b_][5], cs[b_][6], cs[b_][7]}; } }
        }
    }
};
struct EpiMerge {
    static constexpr bool PERM = true, AFTER_DRAIN = false;
    const bf16_t* U; int ldu, gcol0; bf16_t* O; int ldc; const PG8_LAS float* slut;
    __device__ __forceinline__ void operator()(const f32x4 (&acc)[2][2][4][2], const Unit& u, int wr, int wc, int, int) const {
        const int lane_ = fresh_lane(), fr = lane_ & 15, fq = lane_ >> 4;
        const int row0 = u.pm * BM + wr * 64 + fr, col0 = u.pn * BM + wc * 32 + 8 * fq;
        typedef float f32x2g __attribute__((ext_vector_type(2)));
        const __amdgpu_buffer_rsrc_t rsrc = __builtin_amdgcn_make_buffer_rsrc((void*)O, 0, 0x7fffffff, 0x00020000);
#pragma unroll
        for (int ai = 0; ai < 2; ++ai) {
            u32x2 gq[4][2]; u32x4 pq[4][2];
#pragma unroll
            for (int m = 0; m < 4; ++m) { const size_t r = (size_t)(row0 + ai * HALF + m * 16); const unsigned char* gp = (const unsigned char*)(U + r * ldu) + 2 * gcol0 + u.e * 1024 + col0; const bf16_t* rowp = O + r * ldc + col0;
#pragma unroll
                for (int bj = 0; bj < 2; ++bj) { gq[m][bj] = *(const u32x2*)(gp + bj * HALF); if (u.e != 0) pq[m][bj] = __builtin_bit_cast(u32x4, __builtin_amdgcn_raw_buffer_load_b128(rsrc, (int)((r * ldc + col0 + bj * HALF) * 2), 0, 16  )); else pq[m][bj] = (u32x4){0u, 0u, 0u, 0u}; } }
#pragma unroll
            for (int m = 0; m < 4; ++m) { const size_t r = (size_t)(row0 + ai * HALF + m * 16); bf16_t* rowp = O + r * ldc + col0;
#pragma unroll
                for (int bj = 0; bj < 2; ++bj) { const f32x4 a0 = acc[ai][bj][m][0], a1 = acc[ai][bj][m][1]; const u32x2 g = gq[m][bj]; const u32x4 p = pq[m][bj];
                    const float s0 = slut[g.x & 0xffu], s1 = slut[(g.x >> 8) & 0xffu], s2 = slut[(g.x >> 16) & 0xffu], s3 = slut[g.x >> 24], s4 = slut[g.y & 0xffu], s5 = slut[(g.y >> 8) & 0xffu], s6 = slut[(g.y >> 16) & 0xffu], s7 = slut[g.y >> 24];
                    const float v0 = a0[0] * s0 + bflo(p.x), v1 = a0[1] * s1 + bfhi(p.x), v2 = a0[2] * s2 + bflo(p.y), v3 = a0[3] * s3 + bfhi(p.y);
                    const float v4 = a1[0] * s4 + bflo(p.z), v5 = a1[1] * s5 + bfhi(p.z), v6 = a1[2] * s6 + bflo(p.w), v7 = a1[3] * s7 + bfhi(p.w);
                    u32x4 w; w.x = cvt_pk_bf16(v0, v1); w.y = cvt_pk_bf16(v2, v3); w.z = cvt_pk_bf16(v4, v5); w.w = cvt_pk_bf16(v6, v7);
                    *(u32x4*)(rowp + bj * HALF) = w; } }
        }
    }
};
struct EpiRes {
    static constexpr bool PERM = true, AFTER_DRAIN = false;
    const float* base; const bf16_t* bb; bf16_t* out; int ldc; float* ssq;
    __device__ __forceinline__ void operator()(const f32x4 (&acc)[2][2][4][2], const Unit& u, int wr, int wc, int, int) const {
        const int lane_ = fresh_lane(), fr = lane_ & 15, fq = lane_ >> 4;
        const int row0 = u.pm * BM + wr * 64 + fr, col0 = u.pn * BM + wc * 32 + 8 * fq;
        const __amdgpu_buffer_rsrc_t rsrc = __builtin_amdgcn_make_buffer_rsrc((void*)(bb ? bb : out), 0, 0x7fffffff, 0x00020000);
#pragma unroll
        for (int ai = 0; ai < 2; ++ai)
#pragma unroll
            for (int mh = 0; mh < 2; ++mh) {
                f32x4 b0[2][2], b1[2][2];
#pragma unroll
                for (int mm = 0; mm < 2; ++mm) { const size_t off = (size_t)(row0 + ai * HALF + (2 * mh + mm) * 16) * ldc + col0;
#pragma unroll
                    for (int bj = 0; bj < 2; ++bj) {
                        if (bb) { const u32x4 p = __builtin_bit_cast(u32x4, __builtin_amdgcn_raw_buffer_load_b128(rsrc, (int)((off + bj * HALF) * 2), 0, 16  )); b0[mm][bj] = (f32x4){bflo(p.x), bfhi(p.x), bflo(p.y), bfhi(p.y)}; b1[mm][bj] = (f32x4){bflo(p.z), bfhi(p.z), bflo(p.w), bfhi(p.w)}; }
                        else { b0[mm][bj] = *(const f32x4*)(base + off + bj * HALF); b1[mm][bj] = *(const f32x4*)(base + off + bj * HALF + 4); } } }
#pragma unroll
                for (int mm = 0; mm < 2; ++mm) { const int m = 2 * mh + mm; const size_t off = (size_t)(row0 + ai * HALF + m * 16) * ldc + col0; float sq = 0.f;
#pragma unroll
                    for (int bj = 0; bj < 2; ++bj) { const f32x4 v0 = acc[ai][bj][m][0] + b0[mm][bj], v1 = acc[ai][bj][m][1] + b1[mm][bj];
                        sq += (v0[0] * v0[0] + v0[1] * v0[1]) + (v0[2] * v0[2] + v0[3] * v0[3]) + (v1[0] * v1[0] + v1[1] * v1[1]) + (v1[2] * v1[2] + v1[3] * v1[3]);
                        u32x4 w; w.x = cvt_pk_bf16(v0[0], v0[1]); w.y = cvt_pk_bf16(v0[2], v0[3]); w.z = cvt_pk_bf16(v1[0], v1[1]); w.w = cvt_pk_bf16(v1[2], v1[3]);
                        *(u32x4*)(out + off + bj * HALF) = w; }
                    if (ssq) ssq_put(ssq, row0 + ai * HALF + m * 16, u.pn * 4 + wc, sq, lane_); }
            }
    }
};
__device__ __forceinline__ unsigned cvt4_fp8(float a, float b, float c, float d) { int w = 0; w = __builtin_amdgcn_cvt_pk_fp8_f32(a, b, w, false); w = __builtin_amdgcn_cvt_pk_fp8_f32(c, d, w, true); return (unsigned)w; }
__device__ __forceinline__ u32x4 pair16(u32x2 wa, u32x2 wb) {
    typedef unsigned u2_ __attribute__((ext_vector_type(2)));
    const u2_ s0 = __builtin_amdgcn_permlane16_swap(wa.x, wb.x, false, false), s1 = __builtin_amdgcn_permlane16_swap(wa.y, wb.y, false, false);
    return (u32x4){s0.x, s1.x, s0.y, s1.y};
}
struct EpiSwiGLU {
    static constexpr bool PERM = true, AFTER_DRAIN = false;
    bf16_t* T; int ldt; const float* ssq; int f8;
    __device__ __forceinline__ void calc(const f32x4 (&acc)[2][2][4][2], int ai, int m, int r, float (&v)[8]) const {
        const float q = ssq ? ssq_ms(ssq, r) : 1.0f; const float nk = -1.44269504f * __builtin_amdgcn_rsqf(q);
        const float qd = f8 ? 0.25f * q : q; const f32x2p nk2 = {nk, nk}, q2 = {qd, qd};
#pragma unroll
        for (int n = 0; n < 2; ++n)
#pragma unroll
            for (int h = 0; h < 2; ++h) { const f32x2p a2 = {acc[ai][0][m][n][2 * h], acc[ai][0][m][n][2 * h + 1]}, b2 = {acc[ai][1][m][n][2 * h], acc[ai][1][m][n][2 * h + 1]};
                const f32x2p x2 = a2 * nk2; const f32x2p e2 = {__builtin_amdgcn_exp2f(x2[0]), __builtin_amdgcn_exp2f(x2[1])};
                const f32x2p d2 = e2 * q2 + q2; const f32x2p r2 = {__builtin_amdgcn_rcpf(d2[0]), __builtin_amdgcn_rcpf(d2[1])};
                const f32x2p v2 = (a2 * b2) * r2; v[n * 4 + 2 * h] = v2[0]; v[n * 4 + 2 * h + 1] = v2[1]; }
    }
    __device__ __forceinline__ void operator()(const f32x4 (&acc)[2][2][4][2], const Unit& u, int wr, int wc, int, int) const {
        const int lane_ = fresh_lane(), fr = lane_ & 15, fq = lane_ >> 4;
        const int row0 = u.pm * BM + wr * 64 + fr, col0 = u.pn * HALF + wc * 32 + 8 * fq;
#pragma unroll
        for (int ai = 0; ai < 2; ++ai)
#pragma unroll
            for (int mp = 0; mp < 2; ++mp) { const int ra = row0 + ai * HALF + (2 * mp) * 16, rb = ra + 16; float va[8], vb[8];
                calc(acc, ai, 2 * mp, ra, va); calc(acc, ai, 2 * mp + 1, rb, vb);
                if (f8) {
                    u32x2 wa, wb; wa.x = cvt4_fp8(va[0], va[1], va[2], va[3]); wa.y = cvt4_fp8(va[4], va[5], va[6], va[7]); wb.x = cvt4_fp8(vb[0], vb[1], vb[2], vb[3]); wb.y = cvt4_fp8(vb[4], vb[5], vb[6], vb[7]);
                    const u32x4 w16 = pair16(wa, wb);
                    *(u32x4*)((unsigned char*)T + (size_t)((fq & 1) ? rb : ra) * ldt + u.pn * HALF + wc * 32 + 8 * (fq & 2)) = w16; }
                else { u32x4 w; w.x = cvt_pk_bf16(va[0], va[1]); w.y = cvt_pk_bf16(va[2], va[3]); w.z = cvt_pk_bf16(va[4], va[5]); w.w = cvt_pk_bf16(va[6], va[7]); *(u32x4*)(T + (size_t)ra * ldt + col0) = w;
                    w.x = cvt_pk_bf16(vb[0], vb[1]); w.y = cvt_pk_bf16(vb[2], vb[3]); w.z = cvt_pk_bf16(vb[4], vb[5]); w.w = cvt_pk_bf16(vb[6], vb[7]); *(u32x4*)(T + (size_t)rb * ldt + col0) = w; } }
    }
};
struct EpiSwiGLU8 {
    static constexpr bool PERM = true, AFTER_DRAIN = false;
    unsigned char* T; int ldt; float cc, lc;
    __device__ __forceinline__ u32x2 calc(const f32x4 (&acc)[2][2][4][2], int ai, int m) const {
        float v[8];
        const f32x2p nk2 = {-1.44269504f * 0.03125f, -1.44269504f * 0.03125f}, l2 = {lc, lc}, c2 = {cc, cc};
#pragma unroll
        for (int n = 0; n < 2; ++n)
#pragma unroll
            for (int h = 0; h < 2; ++h) { const f32x2p a2 = {acc[ai][0][m][n][2 * h], acc[ai][0][m][n][2 * h + 1]}, b2 = {acc[ai][1][m][n][2 * h], acc[ai][1][m][n][2 * h + 1]};
                const f32x2p x2 = a2 * nk2 + l2; const f32x2p e2 = {__builtin_amdgcn_exp2f(x2[0]), __builtin_amdgcn_exp2f(x2[1])};
                const f32x2p d2 = e2 + c2; const f32x2p r2 = {__builtin_amdgcn_rcpf(d2[0]), __builtin_amdgcn_rcpf(d2[1])};
                const f32x2p v2 = (a2 * b2) * r2; v[n * 4 + 2 * h] = v2[0]; v[n * 4 + 2 * h + 1] = v2[1]; }
        u32x2 w; w.x = cvt4_fp8(v[0], v[1], v[2], v[3]); w.y = cvt4_fp8(v[4], v[5], v[6], v[7]); return w;
    }
    __device__ __forceinline__ void operator()(const f32x4 (&acc)[2][2][4][2], const Unit& u, int wr, int wc, int, int) const {
        const int lane_ = fresh_lane(), fr = lane_ & 15, fq = lane_ >> 4;
        const int row0 = u.prow * BM + wr * 64 + fr;
#pragma unroll
        for (int ai = 0; ai < 2; ++ai)
#pragma unroll
            for (int mp = 0; mp < 2; ++mp) {
                const u32x4 w16 = pair16(calc(acc, ai, 2 * mp), calc(acc, ai, 2 * mp + 1));
                *(u32x4*)(T + (size_t)(row0 + ai * HALF + (2 * mp + (fq & 1)) * 16) * ldt + u.pn * HALF + wc * 32 + 8 * (fq & 2)) = w16; }
    }
};
struct EpiGate8 {
    static constexpr bool PERM = true, AFTER_DRAIN = false;
    unsigned char* O; int ldo, goff; const float* ssq;
    __device__ __forceinline__ void operator()(const f32x4 (&acc)[2][2][4][2], const Unit& u, int wr, int wc, int, int) const {
        const int lane_ = fresh_lane(), fr = lane_ & 15, fq = lane_ >> 4;
        const int row0 = u.pm * BM + wr * 64 + fr;
#pragma unroll
        for (int ai = 0; ai < 2; ++ai)
#pragma unroll
            for (int m = 0; m < 4; ++m) { const int r = row0 + ai * HALF + m * 16;
                const float rs = (ssq ? ssq_rs(ssq, r) : 1.0f) * 0.03125f;
                u32x2 w[2];
#pragma unroll
                for (int bj = 0; bj < 2; ++bj) { const f32x4 v0 = acc[ai][bj][m][0] * rs, v1 = acc[ai][bj][m][1] * rs; w[bj].x = cvt4_fp8(v0[0], v0[1], v0[2], v0[3]); w[bj].y = cvt4_fp8(v1[0], v1[1], v1[2], v1[3]); }
                *(u32x4*)(O + (size_t)r * ldo + goff + u.pn * BM + (fq & 1) * HALF + wc * 32 + 8 * (fq & 2)) = pair16(w[0], w[1]); }
    }
};
struct EpiScatter {
    static constexpr bool PERM = true, AFTER_DRAIN = false;
    bf16_t* R; int ldc; const int* tok; const float* gate; float scale; float* ssq; unsigned char* r8; bf16_t* Z; int ldz;
    __device__ __forceinline__ void operator()(const f32x4 (&acc)[2][2][4][2], const Unit& u, int wr, int wc, int, int) const {
        const int lane_ = fresh_lane(), fr = lane_ & 15, fq = lane_ >> 4;
        const int row0 = u.prow * BM + wr * 64 + fr, col0 = u.pn * BM + wc * 32 + 8 * fq;
        if (Z) {
#pragma unroll
            for (int ai = 0; ai < 2; ++ai)
#pragma unroll
                for (int m = 0; m < 4; ++m) { const int r = row0 + ai * HALF + m * 16; const int t = tok[r]; const float g = gate[r] * scale;
                    if (t >= 0) { bf16_t* zp = Z + (size_t)t * ldz + u.second * 1024 + col0;
#pragma unroll
                        for (int bj = 0; bj < 2; ++bj) { const f32x4 a0 = acc[ai][bj][m][0] * g, a1 = acc[ai][bj][m][1] * g;
                            u32x4 w; w.x = cvt_pk_bf16(a0[0], a0[1]); w.y = cvt_pk_bf16(a0[2], a0[3]); w.z = cvt_pk_bf16(a1[0], a1[1]); w.w = cvt_pk_bf16(a1[2], a1[3]);
                            *(u32x4*)(zp + bj * HALF) = w; } } }
            return; }
        const __amdgpu_buffer_rsrc_t rsrc = __builtin_amdgcn_make_buffer_rsrc((void*)R, 0, 0x7fffffff, 0x00020000);
        int tk[2][4]; float gg[2][4];
#pragma unroll
        for (int ai = 0; ai < 2; ++ai)
#pragma unroll
            for (int m = 0; m < 4; ++m) { const int r = row0 + ai * HALF + m * 16; tk[ai][m] = tok ? tok[r] : r; gg[ai][m] = tok ? gate[r] * scale : scale; }
#pragma unroll
        for (int ai = 0; ai < 2; ++ai) {
            u32x4 pq[4][2];
#pragma unroll
            for (int m = 0; m < 4; ++m) { const int t = tk[ai][m] < 0 ? 0 : tk[ai][m]; const bf16_t* rp = R + (size_t)t * ldc + col0;
#pragma unroll
                for (int bj = 0; bj < 2; ++bj) pq[m][bj] = __builtin_bit_cast(u32x4, __builtin_amdgcn_raw_buffer_load_b128(rsrc, (int)(((size_t)t * ldc + col0 + bj * HALF) * 2), 0, 16  )); (void)rp; }
#pragma unroll
            for (int m = 0; m < 4; ++m) { const int t = tk[ai][m]; const float g = gg[ai][m];
                if (t >= 0) { bf16_t* rp = R + (size_t)t * ldc + col0; float sq = 0.f;
#pragma unroll
                    for (int bj = 0; bj < 2; ++bj) { const u32x4 p = pq[m][bj]; const f32x4 a0 = acc[ai][bj][m][0] * g, a1 = acc[ai][bj][m][1] * g;
                        const float e0 = bflo(p.x) + a0[0], e1 = bfhi(p.x) + a0[1], e2 = bflo(p.y) + a0[2], e3 = bfhi(p.y) + a0[3], e4 = bflo(p.z) + a1[0], e5 = bfhi(p.z) + a1[1], e6 = bflo(p.w) + a1[2], e7 = bfhi(p.w) + a1[3];
                        sq += (e0 * e0 + e1 * e1) + (e2 * e2 + e3 * e3) + (e4 * e4 + e5 * e5) + (e6 * e6 + e7 * e7);
                        u32x4 w; w.x = cvt_pk_bf16(e0, e1); w.y = cvt_pk_bf16(e2, e3); w.z = cvt_pk_bf16(e4, e5); w.w = cvt_pk_bf16(e6, e7);
                        *(u32x4*)(rp + bj * HALF) = w;
                        if (r8) { u32x2 w8; w8.x = cvt4_fp8(e0, e1, e2, e3); w8.y = cvt4_fp8(e4, e5, e6, e7); *(u32x2*)(r8 + (size_t)t * 1024 + col0 + bj * HALF) = w8; } }
                    if (ssq) ssq_put(ssq, row0 + ai * HALF + m * 16, u.pn * 4 + wc, sq, lane_); } }
        }
    }
};

template <class Epi, class Sched, bool ALIGN_EPI = false, bool FP8 = false>
__device__ __forceinline__ void gemm_phase(PG8_LAS unsigned char* lds, const int tid, const Gemm g, const Sched& S, const Epi& E) {
    const int wid = __builtin_amdgcn_readfirstlane(tid >> 6), lane = tid & 63, wr = wid >> 2, wc = wid & 3, fr = lane & 15, fq = lane >> 4;
    const int K = g.K, nt = K / BK;
    unsigned voffA, voffB;
    { int R, C; stage_rc(tid * 16, R, C); const int Rb = Epi::PERM ? ((R & ~31) + perm32(R & 31)) : R;
      voffA = (unsigned)(R * g.lda + C) * 2u; voffB = (unsigned)(Rb * g.ldb + C) * 2u; }
    const size_t rstepA = (size_t)64 * g.lda * 2, rstepB = (size_t)64 * g.ldb * 2;
    const size_t kstep = (size_t)(BK * 2);
    const size_t hstepA = (size_t)HALF * g.lda * 2, hstepB = (size_t)HALF * g.ldb * 2;
    const unsigned ldsw = (unsigned)wid * 1024u;
    const int aoff = lds_byte(wr * 64 + fr, fq * 8), boff = lds_byte(wc * 32 + fr, fq * 8);
#define PG8_SA(b, h) (((b) * 2 + (h)) * HTB)
#define PG8_SB(b, h) ((4 + (b) * 2 + (h)) * HTB)
#define PG8_STAGE(bufoff, gbase, voff) do { _Pragma("unroll") for (int _i = 0; _i < 2; ++_i) { const char* gb_ = (const char*)(gbase) + (size_t)_i * rstep##voff; asm volatile("" : "+s"(gb_));     \
        __builtin_amdgcn_global_load_lds((const unsigned*)(gb_ + (voff)), (PG8_LAS unsigned*)(lds + (bufoff) + ldsw + _i * 8192), 16, 0, 0); } } while (0)
#define rstepvoffA rstepA
#define rstepvoffB rstepB
#define PG8_LDA(dst, b, h) do { if constexpr (FP8) { _Pragma("unroll") for (int m = 0; m < 4; ++m) dst##8[m] = __builtin_shufflevector(*(const PG8_LAS i32x4*)(lds + PG8_SA(b, h) + aoff + m * 2048), *(const PG8_LAS i32x4*)(lds + PG8_SA(b, h) + aoff + m * 2048 + 1024), 0, 1, 2, 3, 4, 5, 6, 7); } \
        else { _Pragma("unroll") for (int m = 0; m < 4; ++m) _Pragma("unroll") for (int k = 0; k < 2; ++k) dst[m][k] = *(const PG8_LAS bf16x8*)(lds + PG8_SA(b, h) + aoff + m * 2048 + k * 1024); } } while (0)
#define PG8_LDB(dst, b, h) do { if constexpr (FP8) { _Pragma("unroll") for (int n = 0; n < 2; ++n) dst##8[n] = __builtin_shufflevector(*(const PG8_LAS i32x4*)(lds + PG8_SB(b, h) + boff + n * 2048), *(const PG8_LAS i32x4*)(lds + PG8_SB(b, h) + boff + n * 2048 + 1024), 0, 1, 2, 3, 4, 5, 6, 7); } \
        else { _Pragma("unroll") for (int n = 0; n < 2; ++n) _Pragma("unroll") for (int k = 0; k < 2; ++k) dst[n][k] = *(const PG8_LAS bf16x8*)(lds + PG8_SB(b, h) + boff + n * 2048 + k * 1024); } } while (0)
#define PG8_MMA(ai, bj, At, Bt) do { __builtin_amdgcn_s_setprio(1); \
        if constexpr (FP8) { _Pragma("unroll") for (int m = 0; m < 4; ++m) _Pragma("unroll") for (int n = 0; n < 2; ++n) \
            acc[ai][bj][m][n] = __builtin_amdgcn_mfma_scale_f32_16x16x128_f8f6f4(Bt##8[n], At##8[m], acc[ai][bj][m][n], 0, 0, 0, 0x7f7f7f7f, 0, 0x7f7f7f7f); } \
        else { _Pragma("unroll") for (int m = 0; m < 4; ++m) _Pragma("unroll") for (int n = 0; n < 2; ++n) _Pragma("unroll") for (int k = 0; k < 2; ++k) \
            acc[ai][bj][m][n] = __builtin_amdgcn_mfma_f32_16x16x32_bf16(Bt[n][k], At[m][k], acc[ai][bj][m][n], 0, 0, 0); } \
        __builtin_amdgcn_s_setprio(0); } while (0)
#define PG8_WAIT_V(n) asm volatile("s_waitcnt vmcnt(" #n ")" ::: "memory")
#define PG8_WAIT_L(n) asm volatile("s_waitcnt lgkmcnt(" #n ")" ::: "memory")
#define PG8_BAR __builtin_amdgcn_s_barrier()
#define PG8_SCHED __builtin_amdgcn_sched_barrier(0)
    Unit cur, nxt; int ui = 0;
    if (!S.next(0, cur)) return;
    f32x4 acc[2][2][4][2];
#pragma unroll
    for (int a = 0; a < 2; ++a)
#pragma unroll
        for (int b = 0; b < 2; ++b)
#pragma unroll
            for (int m = 0; m < 4; ++m)
#pragma unroll
                for (int n = 0; n < 2; ++n) acc[a][b][m][n] = (f32x4){0.f, 0.f, 0.f, 0.f};
    bf16x8 At[4][2], B0[2][2], B1[2][2]; i32x8 At8[4], B08[2], B18[2];
    const char* cA = (const char*)g.A + cur.aoff; const char* cB = (const char*)g.Bt + cur.boff;
    S.a_ready(cur);
    PG8_STAGE(PG8_SB(0, 0), cB, voffB); PG8_STAGE(PG8_SB(0, 1), cB + hstepB, voffB); PG8_STAGE(PG8_SA(0, 0), cA, voffA); PG8_STAGE(PG8_SA(0, 1), cA + hstepA, voffA);
    if (wr == 1) PG8_BAR;
    PG8_WAIT_V(2); PG8_BAR;
    PG8_STAGE(PG8_SB(1, 0), cB + kstep, voffB); PG8_STAGE(PG8_SA(1, 0), cA + kstep, voffA); PG8_STAGE(PG8_SB(1, 1), cB + hstepB + kstep, voffB);
    PG8_WAIT_V(6); PG8_BAR;
    for (;;) {
        const bool has_next = S.next(ui + 1, nxt);
        const char* nA = has_next ? (const char*)g.A + nxt.aoff : cA; const char* nB = has_next ? (const char*)g.Bt + nxt.boff : cB;
#pragma unroll 1
        for (int t = 0; t < nt; t += 2) {
            const bool last = (t == nt - 2);
            const char* a1 = cA + (size_t)(t + 1) * kstep;
            const char* a2 = last ? nA : cA + (size_t)(t + 2) * kstep; const char* b2 = last ? nB : cB + (size_t)(t + 2) * kstep;
            const char* a3 = a2 + kstep; const char* b3 = b2 + kstep;
            if (last && has_next) S.a_ready(nxt);
            PG8_LDB(B0, 0, 0); PG8_LDB(B1, 0, 1); PG8_SCHED; PG8_LDA(At, 0, 0); PG8_STAGE(PG8_SA(1, 1), a1 + hstepA, voffA);
            PG8_WAIT_V(8); PG8_WAIT_L(0); PG8_BAR; PG8_MMA(0, 0, At, B0); PG8_MMA(0, 1, At, B1); PG8_BAR; PG8_SCHED;
            PG8_LDA(At, 0, 1); PG8_STAGE(PG8_SB(0, 0), b2, voffB); PG8_STAGE(PG8_SB(0, 1), b2 + hstepB, voffB); PG8_STAGE(PG8_SA(0, 0), a2, voffA);
            PG8_WAIT_V(8); PG8_WAIT_L(0); PG8_BAR; PG8_MMA(1, 0, At, B0); PG8_MMA(1, 1, At, B1); PG8_BAR; PG8_SCHED;
            PG8_LDB(B0, 1, 0); PG8_LDB(B1, 1, 1); PG8_SCHED; PG8_LDA(At, 1, 0); PG8_STAGE(PG8_SA(0, 1), a2 + hstepA, voffA);
            PG8_WAIT_V(8); PG8_WAIT_L(0); PG8_BAR; PG8_MMA(0, 0, At, B0); PG8_MMA(0, 1, At, B1); PG8_BAR; PG8_SCHED;
            PG8_LDA(At, 1, 1); PG8_STAGE(PG8_SB(1, 0), b3, voffB); PG8_STAGE(PG8_SB(1, 1), b3 + hstepB, voffB); PG8_STAGE(PG8_SA(1, 0), a3, voffA);
            PG8_WAIT_V(8); PG8_WAIT_L(0); PG8_BAR; PG8_MMA(1, 0, At, B0); PG8_MMA(1, 1, At, B1); PG8_BAR; PG8_SCHED;
        }
        if constexpr (ALIGN_EPI) { if (wr == 0) PG8_BAR; }
        E(acc, cur, wr, wc, fr, fq); S.done(cur);
        if (!has_next) break;
#pragma unroll
        for (int a = 0; a < 2; ++a)
#pragma unroll
            for (int b = 0; b < 2; ++b)
#pragma unroll
                for (int m = 0; m < 4; ++m)
#pragma unroll
                    for (int n = 0; n < 2; ++n) acc[a][b][m][n] = (f32x4){0.f, 0.f, 0.f, 0.f};
        cur = nxt; cA = nA; cB = nB; ++ui;
        if constexpr (ALIGN_EPI) { if (wr == 1) PG8_BAR; }
    }
    PG8_WAIT_V(0);
    if constexpr (!ALIGN_EPI) { if (wr == 0) PG8_BAR; }
    PG8_BAR;
#undef PG8_SA
#undef PG8_SB
#undef PG8_STAGE
#undef rstepvoffA
#undef rstepvoffB
#undef PG8_LDA
#undef PG8_LDB
#undef PG8_MMA
#undef PG8_WAIT_V
#undef PG8_WAIT_L
#undef PG8_BAR
#undef PG8_SCHED
}
}

constexpr int NB = 32, SEQ = 2048, D = 1024, M = NB * SEQ;
constexpr int WIN = 6656, GCOL0 = 2560;
constexpr int UST = 4608;
constexpr int FF0 = 2816, FFE = 3584, NEXP = 8;
constexpr int HROWS = M / 2, HB = NB / 2;
constexpr int CAPROWS = M + NEXP * 256, CAPT = CAPROWS / 256;
constexpr float RMS_EPS = 1e-6f, SUBLN_EPS = 1e-5f;
constexpr int NWAVES = 8;
constexpr int C_QA = 0, C_KA = 256, C_VA = 512, C_XB = 768, C_BB = 1024, C_CB = 1280, C_PC = 1536, C_QD = 1792, C_KD = 2048, C_VD = 2304;

constexpr size_t MiB = 1u << 20;
constexpr size_t WS_CTL = 0, CTL_ZERO_BYTES = 1 * MiB;
constexpr size_t WS_ROUTE = 2 * MiB;
constexpr size_t WS_TOK = 4 * MiB;
constexpr size_t WS_GATE = 5 * MiB;
constexpr size_t WS_TILEE = 6 * MiB;
constexpr size_t WS_KMEAN = 7 * MiB;
constexpr size_t WS_WIN = 8 * MiB;
constexpr size_t WS_WG8 = 24 * MiB;
constexpr size_t WS_BP = 34 * MiB;
constexpr size_t WS_WOUT = 38 * MiB;
constexpr size_t WS_W13D = 42 * MiB;
constexpr size_t WS_W2D = 53 * MiB;
constexpr size_t WS_W13E = 60 * MiB;
constexpr size_t WS_W2E = 116 * MiB;
constexpr size_t WS_R = 144 * MiB;
constexpr size_t WS_H = 272 * MiB;
constexpr size_t WS_U = 400 * MiB;
constexpr size_t WS_A8 = 752 * MiB;
constexpr size_t WS_Y = 816 * MiB;
constexpr size_t WS_MG = 880 * MiB;
constexpr size_t WS_HPERM = 272 * MiB;
constexpr size_t WS_TE = 404 * MiB;
constexpr size_t WS_END = 952 * MiB;
static_assert(WS_W13E + (size_t)8 * 2 * FFE * D <= WS_W2E && WS_W2E + (size_t)8 * D * FFE <= WS_R && WS_U + (size_t)HROWS * UST * 2 <= WS_A8 && WS_A8 + (size_t)M * D <= WS_Y && WS_HPERM + 2 * (size_t)CAPROWS * D <= WS_TE && WS_TE + 2 * (size_t)CAPROWS * FFE <= WS_END - 8 * MiB && WS_U + (size_t)M * FF0 * 2 <= WS_A8 && WS_MG + (size_t)HROWS * D * 2 <= WS_END, "d_ws map");
constexpr int CW_BAR = 4096;
constexpr int CW_QUEUE = 16384;
constexpr int CW_CNT = 20480;
constexpr size_t SSQ0_OFF = 944 * MiB, SSQ1_OFF = 948 * MiB;

constexpr int RING_BYTES = 131072;
constexpr int LUT_OFF = RING_BYTES;
constexpr int LUT_N = 320, LUT_NEG = 96;
constexpr int SLUT_OFF = LUT_OFF + 8 * LUT_N * 4;
constexpr int LDSCTL_OFF = RING_BYTES + 12288, MISC_OFF = LDSCTL_OFF + 320;
constexpr int LDS_BYTES = 147456;

#define GAS __attribute__((address_space(1)))
#define LAS __attribute__((address_space(3)))
typedef unsigned short bf16;
typedef unsigned v4u __attribute__((ext_vector_type(4)));
typedef unsigned v2u __attribute__((ext_vector_type(2)));
typedef float f32x4 __attribute__((ext_vector_type(4)));
typedef GAS unsigned gu32;
#define RLX_AGENT __ATOMIC_RELAXED, __HIP_MEMORY_SCOPE_AGENT
#define LDS_WAIT() asm volatile("s_waitcnt lgkmcnt(0)" ::: "memory")
#define VM_WAIT() asm volatile("s_waitcnt vmcnt(0)" ::: "memory")
__device__ __forceinline__ unsigned f2bf(float f) { unsigned u = __builtin_bit_cast(unsigned, f); return (u + 0x7fffu + ((u >> 16) & 1u)) >> 16; }
__device__ __forceinline__ unsigned pk2(float lo, float hi) { return f2bf(lo) | (f2bf(hi) << 16); }
__device__ __forceinline__ float bflo(unsigned w) { return __uint_as_float(w << 16); }
__device__ __forceinline__ float bfhi(unsigned w) { return __uint_as_float(w & 0xffff0000u); }

#define XB_TMO      128
#define XB_XCNT(j)  (256  + 64 * (j))
#define XB_XSUB(j)  (1280 + 64 * (j))
#define XB_XGEN(j)  (2304 + 64 * (j))
#define XB_TOP      3328
#define XB_TOPGEN   3392
#define XCD_BAR_WORDS 3456
#define XB_SPIN_CAP (1u << 22)

__device__ __forceinline__ unsigned xb_ld(unsigned* p)              { return __hip_atomic_load(p, __ATOMIC_RELAXED, __HIP_MEMORY_SCOPE_AGENT); }
__device__ __forceinline__ unsigned xb_add(unsigned* p, unsigned v) { return __hip_atomic_fetch_add(p, v, __ATOMIC_RELAXED, __HIP_MEMORY_SCOPE_AGENT); }
__device__ __forceinline__ unsigned xb_xcc_id() { return (unsigned)__builtin_amdgcn_s_getreg((3 << 11) | 20) & 0xFu; }
#define XB_SPIN(cond, bar) do { unsigned _sp = 0; while (cond) { __builtin_amdgcn_s_sleep(1); \
    if ((++_sp & 255u) == 0u) { if (xb_ld(&(bar)[XB_TMO])) break; if (_sp > XB_SPIN_CAP) { atomicAdd(&(bar)[XB_TMO], 1u); break; } } } } while (0)

struct XcdBarrier { unsigned* bar; unsigned x; volatile LAS unsigned* st; };

__device__ __forceinline__ XcdBarrier xcd_barrier_post(unsigned* bar, volatile LAS unsigned* st) {
    XcdBarrier b; b.bar = bar; b.x = xb_xcc_id(); b.st = st;
    if (threadIdx.x == 0) (void)xb_add(&bar[XB_XCNT(b.x)], 1u);
    return b;
}
__device__ __forceinline__ void xcd_barrier_complete(unsigned* bar, unsigned x, unsigned& nloc, unsigned& nx) {
    const unsigned G = gridDim.x * gridDim.y * gridDim.z;
    unsigned sum, cnt, mine, sp = 0u;
    for (;;) {
        sum = 0u; cnt = 0u; mine = 0u;
#pragma unroll
        for (unsigned j = 0; j < 16; ++j) { const unsigned c = xb_ld(&bar[XB_XCNT(j)]); sum += c; cnt += (c > 0u) ? 1u : 0u; mine = (j == x) ? c : mine; }
        if (sum == G) break;
        __builtin_amdgcn_s_sleep(1);
        if ((++sp & 255u) == 0u) { if (xb_ld(&bar[XB_TMO])) break; if (sp > XB_SPIN_CAP) { atomicAdd(&bar[XB_TMO], 1u); break; } }
    }
    nloc = mine > 0u ? mine : 1u; nx = cnt > 0u ? cnt : 1u;
}
__device__ __forceinline__ void xcd_barrier(const XcdBarrier& b) {
    asm volatile("s_waitcnt vmcnt(0)" ::: "memory");
    __syncthreads();
    if (threadIdx.x == 0) {
        unsigned* bar = b.bar;
        __builtin_amdgcn_s_waitcnt(0);
        unsigned nloc = b.st[0], nx = b.st[1];
        if (nloc == 0u) { xcd_barrier_complete(bar, b.x, nloc, nx); b.st[0] = nloc; b.st[1] = nx; }
        const unsigned old = xb_add(&bar[XB_XSUB(b.x)], 1u);
        const unsigned gen = old / nloc;
        if (old + 1u == (gen + 1u) * nloc) {
            __builtin_amdgcn_fence(__ATOMIC_RELEASE, "agent");
            asm volatile("s_waitcnt vmcnt(0)" ::: "memory");
            const unsigned og = xb_add(&bar[XB_TOP], 1u);
            const unsigned tg = og / nx;
            if (og + 1u == (tg + 1u) * nx) xb_add(&bar[XB_TOPGEN], 1u);
            else XB_SPIN(xb_ld(&bar[XB_TOPGEN]) == tg, bar);
            __builtin_amdgcn_fence(__ATOMIC_ACQUIRE, "agent");
            xb_add(&bar[XB_XGEN(b.x)], 1u);
            asm volatile("s_waitcnt vmcnt(0)" ::: "memory");
        } else {
            XB_SPIN(xb_ld(&bar[XB_XGEN(b.x)]) == gen, bar);
            __builtin_amdgcn_fence(__ATOMIC_ACQUIRE, "agent");
            asm volatile("s_waitcnt vmcnt(0)" ::: "memory");
        }
    }
    __syncthreads();
}

__device__ __forceinline__ float wave_sum(float v, int lane) {
#pragma unroll
    for (int o = 1; o < 64; o <<= 1) v += __int_as_float(__builtin_amdgcn_ds_bpermute((lane ^ o) << 2, __float_as_int(v)));
    return v;
}
__device__ __forceinline__ void wave_sync() { asm volatile("s_waitcnt lgkmcnt(0)" ::: "memory"); __builtin_amdgcn_wave_barrier(); }

__device__ const unsigned char BKT[129] = {
    0, 1, 2, 3, 4, 5, 6, 7, 8, 9, 10, 11, 12, 13, 14, 15, 16, 16, 16, 17, 17, 18, 18, 18, 19, 19, 19, 20, 20, 20, 20, 21, 21, 21, 21, 22, 22, 22, 22, 22, 23, 23, 23, 23, 23, 23,
    24, 24, 24, 24, 24, 24, 25, 25, 25, 25, 25, 25, 25, 26, 26, 26, 26, 26, 26, 26, 26, 27, 27, 27, 27, 27, 27, 27, 27, 27, 27, 28, 28, 28, 28, 28, 28, 28, 28, 28, 28,
    29, 29, 29, 29, 29, 29, 29, 29, 29, 29, 29, 29, 30, 30, 30, 30, 30, 30, 30, 30, 30, 30, 30, 30, 30, 30, 31, 31, 31, 31, 31, 31, 31, 31, 31, 31, 31, 31, 31, 31, 31, 31 };

__device__ __forceinline__ void transpose_item(const float* W, int K, int N, bf16* WT, int row_off, int il, LAS float* scr, int item, int lane, const float* gk = nullptr, int ldw = 0) {
    if (ldw == 0) ldw = N;
    const int nblk = N / 32, kb = item / nblk, nb = item % nblk, k0 = 64 * kb, n0 = 32 * nb;
#pragma unroll 8
    for (int i = 0; i < 32; ++i) { const int kk = 2 * i + (lane >> 5); scr[kk * 33 + (lane & 31)] = __builtin_nontemporal_load(W + (size_t)(k0 + kk) * ldw + n0 + (lane & 31)) * (gk ? gk[k0 + kk] : 1.0f); }
    LDS_WAIT(); asm volatile("" ::: "memory"); __builtin_amdgcn_wave_barrier();
    const int c = lane & 7;
    const int r0 = il ? ((n0 >> 7) * 256 + row_off + (n0 & 127)) : (row_off + n0);
#pragma unroll
    for (int j = 0; j < 4; ++j) { const int n = (lane >> 3) + 8 * j; const LAS float* s = scr + (8 * c) * 33 + n;
        v4u o; o.x = pk2(s[0 * 33], s[1 * 33]); o.y = pk2(s[2 * 33], s[3 * 33]); o.z = pk2(s[4 * 33], s[5 * 33]); o.w = pk2(s[6 * 33], s[7 * 33]);
        *(GAS v4u*)(WT + (size_t)(r0 + n) * K + k0 + 8 * c) = o; }
    LDS_WAIT(); asm volatile("" ::: "memory"); __builtin_amdgcn_wave_barrier();
}


__device__ __forceinline__ int fresh_tid_w(int wave) { int lane; asm volatile("v_mbcnt_lo_u32_b32 %0, -1, 0\n\tv_mbcnt_hi_u32_b32 %0, -1, %0" : "=v"(lane)); return wave * 64 + lane; }
#define fresh_tid() fresh_tid_w(wave0)

__device__ __forceinline__ unsigned moba_mask(const bf16* u, const LAS float* kmb, int bl, int h, int qc, int lane) {
    const int t = qc * 32 + (lane & 31), own = qc >> 3;
    if (own <= 3) return (1u << own) - 1u;
    const bf16* qp = u + ((size_t)bl * SEQ + t) * UST + C_QA + h * 64;
    v4u xq[8];
#pragma unroll
    for (int i = 0; i < 8; ++i) xq[i] = *(const GAS v4u*)(qp + 8 * i);
    float gs[7];
#pragma unroll
    for (int blk = 0; blk < 7; ++blk) gs[blk] = 0.f;
#pragma unroll
    for (int i = 0; i < 8; ++i) { const v4u x = xq[i];
        const float qv[8] = {bflo(x.x), bfhi(x.x), bflo(x.y), bfhi(x.y), bflo(x.z), bfhi(x.z), bflo(x.w), bfhi(x.w)};
#pragma unroll
        for (int blk = 0; blk < 7; ++blk) { const f32x4 k0 = *(const LAS f32x4*)(kmb + blk * 64 + 8 * i), k1 = *(const LAS f32x4*)(kmb + blk * 64 + 8 * i + 4);
            gs[blk] += (qv[0] * k0.x + qv[1] * k0.y) + (qv[2] * k0.z + qv[3] * k0.w) + (qv[4] * k1.x + qv[5] * k1.y) + (qv[6] * k1.z + qv[7] * k1.w); } }
    unsigned mask = 0u;
#pragma unroll
    for (int k = 0; k < 3; ++k) { float bv = -3.3e38f; int best = 0;
#pragma unroll
        for (int blk = 0; blk < 7; ++blk) { const bool ok = (blk < own) && (((mask >> blk) & 1u) == 0u); if (ok && gs[blk] > bv) { bv = gs[blk]; best = blk; } }
        mask |= 1u << best; }
    return mask;
}

typedef short bf16x8v __attribute__((ext_vector_type(8)));
typedef float f32x16 __attribute__((ext_vector_type(16)));
constexpr int AT_KP = 144, AT_VP = 136, AT_KB = 64 * AT_KP, AT_BUF = AT_KB + 64 * AT_VP;

typedef float f32x2c __attribute__((ext_vector_type(2)));
typedef __bf16 bf16x2c __attribute__((ext_vector_type(2)));
__device__ __forceinline__ unsigned pk2c(float lo, float hi) { const f32x2c f = {lo, hi}; const bf16x2c b = __builtin_convertvector(f, bf16x2c); return __builtin_bit_cast(unsigned, b); }

__device__ __forceinline__ void softmax_step(f32x16 (&e)[2], float& m, float& l, f32x16 (&o)[2], bf16x8v (&pb)[2][2], bool first, int xaddr) {
    float pm = -1.0e30f;
#pragma unroll
    for (int st = 0; st < 2; ++st)
#pragma unroll
        for (int i = 0; i < 16; ++i) pm = fmaxf(pm, e[st][i]);
    pm = fmaxf(pm, __int_as_float(__builtin_amdgcn_ds_bpermute(xaddr, __float_as_int(pm))));
    if (first || __ballot(pm > 8.0f) != 0ull) {
        const float delta = first ? pm : fmaxf(pm, 0.f);
        const float f = __builtin_amdgcn_exp2f(-delta);
        m += delta; l *= f;
#pragma unroll
        for (int mb = 0; mb < 2; ++mb)
#pragma unroll
            for (int i = 0; i < 16; ++i) o[mb][i] *= f;
#pragma unroll
        for (int st = 0; st < 2; ++st)
#pragma unroll
            for (int i = 0; i < 16; ++i) e[st][i] -= delta;
    }
#pragma unroll
    for (int st = 0; st < 2; ++st)
#pragma unroll
        for (int sp = 0; sp < 2; ++sp) { float pv[8];
#pragma unroll
            for (int j = 0; j < 8; ++j) { pv[j] = __builtin_amdgcn_exp2f(e[st][8 * sp + j]); l += pv[j]; }
            union { v4u u; bf16x8v b; } cv; cv.u.x = pk2c(pv[0], pv[1]); cv.u.y = pk2c(pv[2], pv[3]); cv.u.z = pk2c(pv[4], pv[5]); cv.u.w = pk2c(pv[6], pv[7]); pb[st][sp] = cv.b; }
}

template <bool DIFF>
__device__ __forceinline__ void attn_unit(const bf16* U, const float* kmean, bf16* Y, const LAS float* lut, LAS unsigned char* lds, int bl, int h, int qb, const int wave0, float lam, float outscale, const float* subg) {
    const int tid = fresh_tid(), lane = tid & 63, w = wave0, c = lane & 31, hh = lane >> 5;
    const int qcol = (DIFF ? C_QD : C_QA) + h * 64, kcol = (DIFF ? C_KD : C_KA) + h * 64, vcol = (DIFF ? C_VD : C_VA) + h * 64;
    const int q0w = qb * 256 + 32 * w, tq = q0w + c;
    const size_t qrow = (size_t)bl * SEQ + tq;
    bf16x8v qf[4];
#pragma unroll
    for (int s = 0; s < 4; ++s) qf[s] = *(const GAS bf16x8v*)(U + qrow * UST + qcol + 16 * s + 8 * hh);
    unsigned mask = 0xffu;
    if (!DIFF) {
        LAS float* kmb = (LAS float*)(lds + 2 * AT_BUF);
        if (qb >= 4) {
            if (tid < 7 * 64) { const float* km = kmean + ((size_t)(bl * 8 + (tid >> 6))) * 512 + h * 64 + (tid & 63); kmb[tid] = km[0] + km[256]; }
            __syncthreads();
        }
        mask = moba_mask(U, kmb, bl, h, qb * 8 + w, lane);
    }
    const LAS float* lh = lut + (DIFF ? 4 + h : h) * LUT_N;
    const float cfar = lh[LUT_NEG + 128];
    const float qs2 = (DIFF ? 0.17677669529663687f : 0.125f) * 1.4426950408889634f;
    f32x16 o1[2], o2[2];
#pragma unroll
    for (int mb = 0; mb < 2; ++mb)
#pragma unroll
        for (int i = 0; i < 16; ++i) { o1[mb][i] = 0.f; o2[mb][i] = 0.f; }
    float m1 = 0.f, l1 = 0.f, m2 = 0.f, l2 = 0.f;
    const int ntiles = 4 * (qb + 1), my_last = qb * 4 + (w >> 1);
    const int xaddr = (lane ^ 32) << 2;
#define AT_KT(it) ((it) < 4 ? 4 * qb + (it) : (it) - 4)
    const bf16* kg = U + ((size_t)bl * SEQ + (tid >> 3)) * UST + kcol + 8 * (tid & 7);
    const bf16* vg = U + ((size_t)bl * SEQ + (tid & 63)) * UST + vcol + 8 * (tid >> 6);
    const int kst = (tid >> 3) * AT_KP + (tid & 7) * 16;
    const int vst = AT_KB + (8 * (tid >> 6)) * AT_VP + (tid & 63) * 2;
    v4u kreg = *(const GAS v4u*)(kg + (size_t)AT_KT(0) * 64 * UST), vreg = *(const GAS v4u*)(vg + (size_t)AT_KT(0) * 64 * UST);
#define AT_WRITE(bufb) do { LAS unsigned char* b_ = lds + (bufb) * AT_BUF; *(LAS v4u*)(b_ + kst) = kreg; \
        LAS unsigned short* v_ = (LAS unsigned short*)(b_ + vst); \
        v_[0 * (AT_VP / 2)] = (unsigned short)(vreg.x & 0xffffu); v_[1 * (AT_VP / 2)] = (unsigned short)(vreg.x >> 16); v_[2 * (AT_VP / 2)] = (unsigned short)(vreg.y & 0xffffu); v_[3 * (AT_VP / 2)] = (unsigned short)(vreg.y >> 16); \
        v_[4 * (AT_VP / 2)] = (unsigned short)(vreg.z & 0xffffu); v_[5 * (AT_VP / 2)] = (unsigned short)(vreg.z >> 16); v_[6 * (AT_VP / 2)] = (unsigned short)(vreg.w & 0xffffu); v_[7 * (AT_VP / 2)] = (unsigned short)(vreg.w >> 16); } while (0)
    AT_WRITE(0);
    __syncthreads();
    for (int it = 0; it < ntiles; ++it) {
        const bool more = (it + 1 < ntiles);
        if (more) { const int ktn = AT_KT(it + 1); kreg = *(const GAS v4u*)(kg + (size_t)ktn * 64 * UST); vreg = *(const GAS v4u*)(vg + (size_t)ktn * 64 * UST); }
        const int kt = AT_KT(it);
        const int blk = kt >> 2; const bool past = blk < qb;
        const bool lane_on = past ? (((mask >> blk) & 1u) != 0u) : true;
        if (kt <= my_last && (DIFF || !past || __ballot(lane_on) != 0ull)) {
            const LAS unsigned char* kb = lds + (it & 1) * AT_BUF; const LAS unsigned char* vb = kb + AT_KB;
            const int key0 = kt * 64;
            f32x16 s1[2], s2[2];
#pragma unroll
            for (int st = 0; st < 2; ++st) {
#pragma unroll
                for (int i = 0; i < 16; ++i) { s1[st][i] = 0.f; s2[st][i] = 0.f; }
#pragma unroll
                for (int s = 0; s < 4; ++s) { const bf16x8v a = *(const LAS bf16x8v*)(kb + (32 * st + c) * AT_KP + (16 * s + 8 * hh) * 2);
                    if (DIFF && s >= 2) s2[st] = __builtin_amdgcn_mfma_f32_32x32x16_bf16(a, qf[s], s2[st], 0, 0, 0);
                    else s1[st] = __builtin_amdgcn_mfma_f32_32x32x16_bf16(a, qf[s], s1[st], 0, 0, 0); }
            }
            const float off1 = lane_on ? -m1 : -1.0e30f, off2 = -m2;
            if (key0 + 63 + 128 <= q0w) {
                const float x1 = cfar + off1, x2 = cfar + off2;
#pragma unroll
                for (int st = 0; st < 2; ++st)
#pragma unroll
                    for (int i = 0; i < 16; ++i) { s1[st][i] = s1[st][i] * qs2 + x1; if (DIFF) s2[st][i] = s2[st][i] * qs2 + x2; }
            } else {
                const LAS float* lp = lh + (LUT_NEG + tq - key0 - 4 * hh);
#pragma unroll
                for (int st = 0; st < 2; ++st)
#pragma unroll
                    for (int i = 0; i < 16; ++i) { const float b = lp[-(32 * st + (i & 3) + 8 * (i >> 2))]; s1[st][i] = s1[st][i] * qs2 + (b + off1); if (DIFF) s2[st][i] = s2[st][i] * qs2 + (b + off2); }
            }
            bf16x8v p1[2][2], p2[2][2];
            softmax_step(s1, m1, l1, o1, p1, it == 0, xaddr);
            if (DIFF) softmax_step(s2, m2, l2, o2, p2, it == 0, xaddr);
#pragma unroll
            for (int mb = 0; mb < 2; ++mb)
#pragma unroll
                for (int s = 0; s < 4; ++s) { const LAS unsigned char* vr = vb + (32 * mb + c) * AT_VP + (16 * s + 4 * hh) * 2;
                    const v2u lo = *(const LAS v2u*)vr, hi = *(const LAS v2u*)(vr + 16);
                    union { v4u u; bf16x8v b; } cv; cv.u.x = lo.x; cv.u.y = lo.y; cv.u.z = hi.x; cv.u.w = hi.y;
                    o1[mb] = __builtin_amdgcn_mfma_f32_32x32x16_bf16(cv.b, p1[s >> 1][s & 1], o1[mb], 0, 0, 0);
                    if (DIFF) o2[mb] = __builtin_amdgcn_mfma_f32_32x32x16_bf16(cv.b, p2[s >> 1][s & 1], o2[mb], 0, 0, 0); }
        }
        if (more) AT_WRITE((it + 1) & 1);
        __syncthreads();
    }
#undef AT_WRITE
#undef AT_KT
    l1 += __int_as_float(__builtin_amdgcn_ds_bpermute(xaddr, __float_as_int(l1)));
    const float i1 = 1.0f / l1;
    bf16* yp = Y + qrow * 1024 + (DIFF ? 768 : 0) + h * 64;
    if (!DIFF) {
#pragma unroll
        for (int mb = 0; mb < 2; ++mb)
#pragma unroll
            for (int g = 0; g < 4; ++g) { v2u wv; wv.x = pk2c(o1[mb][4 * g] * i1, o1[mb][4 * g + 1] * i1); wv.y = pk2c(o1[mb][4 * g + 2] * i1, o1[mb][4 * g + 3] * i1);
                *(GAS v2u*)(yp + 32 * mb + 8 * g + 4 * hh) = wv; }
    } else {
        l2 += __int_as_float(__builtin_amdgcn_ds_bpermute(xaddr, __float_as_int(l2)));
        const float i2 = lam / l2; float ss = 0.f;
#pragma unroll
        for (int mb = 0; mb < 2; ++mb)
#pragma unroll
            for (int i = 0; i < 16; ++i) { const float v = o1[mb][i] * i1 - o2[mb][i] * i2; o1[mb][i] = v; ss += v * v; }
        ss += __int_as_float(__builtin_amdgcn_ds_bpermute(xaddr, __float_as_int(ss)));
        const float r = outscale / sqrtf(ss * (1.0f / 64.0f) + SUBLN_EPS);
#pragma unroll
        for (int mb = 0; mb < 2; ++mb)
#pragma unroll
            for (int g = 0; g < 4; ++g) { const int d = 32 * mb + 8 * g + 4 * hh; const f32x4 sg = *(const f32x4*)(subg + d);
                v2u wv; wv.x = pk2c(o1[mb][4 * g] * r * sg.x, o1[mb][4 * g + 1] * r * sg.y); wv.y = pk2c(o1[mb][4 * g + 2] * r * sg.z, o1[mb][4 * g + 3] * r * sg.w);
                *(GAS v2u*)(yp + d) = wv; }
    }
}

__device__ __forceinline__ unsigned cvt4_fp8g(float a, float b, float c, float d) { int w = 0; w = __builtin_amdgcn_cvt_pk_fp8_f32(a, b, w, false); w = __builtin_amdgcn_cvt_pk_fp8_f32(c, d, w, true); return (unsigned)w; }
__device__ __forceinline__ void transpose_item8(const float* W, int K, int N, unsigned char* WT, int row_off, int il, LAS float* scr, int item, int lane, const float* gk = nullptr, int ldw = 0) {
    if (ldw == 0) ldw = N;
    const int nblk = N / 32, kb = item / nblk, nb = item % nblk, k0 = 64 * kb, n0 = 32 * nb;
#pragma unroll 8
    for (int i = 0; i < 32; ++i) { const int kk = 2 * i + (lane >> 5); scr[kk * 33 + (lane & 31)] = __builtin_nontemporal_load(W + (size_t)(k0 + kk) * ldw + n0 + (lane & 31)) * (gk ? gk[k0 + kk] : 1.0f); }
    LDS_WAIT(); asm volatile("" ::: "memory"); __builtin_amdgcn_wave_barrier();
    const int c = lane & 7;
    const int r0 = il ? ((n0 >> 7) * 256 + row_off + (n0 & 127)) : (row_off + n0);
#pragma unroll
    for (int j = 0; j < 4; ++j) { const int n = (lane >> 3) + 8 * j; const LAS float* sp = scr + (8 * c) * 33 + n;
        v2u o; o.x = cvt4_fp8g(32.f * sp[0 * 33], 32.f * sp[1 * 33], 32.f * sp[2 * 33], 32.f * sp[3 * 33]); o.y = cvt4_fp8g(32.f * sp[4 * 33], 32.f * sp[5 * 33], 32.f * sp[6 * 33], 32.f * sp[7 * 33]);
        *(GAS v2u*)(WT + (size_t)(r0 + n) * K + k0 + 8 * c) = o; }
    LDS_WAIT(); asm volatile("" ::: "memory"); __builtin_amdgcn_wave_barrier();
}

struct Args {
    const float* in[20]; float* out; unsigned char* ws; int ph_lo, ph_hi, li, pad;
};
typedef const __attribute__((address_space(4))) Args CArgs;

__device__ __forceinline__ float row_rms_load(const float* xrow, const float* g, int lane, f32x4 (&v)[4]) {
    const GAS f32x4* xr = (const GAS f32x4*)xrow + lane; float s = 0.f;
#pragma unroll
    for (int j = 0; j < 4; ++j) { v[j] = __builtin_nontemporal_load(xr + 64 * j); s += (v[j].x * v[j].x + v[j].y * v[j].y) + (v[j].z * v[j].z + v[j].w * v[j].w); }
    const float r = 1.0f / sqrtf(wave_sum(s, lane) * (1.f / D) + RMS_EPS);
    const GAS f32x4* gr = (const GAS f32x4*)g + lane;
#pragma unroll
    for (int j = 0; j < 4; ++j) { const f32x4 gg = gr[64 * j]; v[j] = v[j] * r * gg; }
    return r;
}
__device__ __forceinline__ void row_store_bf16(bf16* orow, int lane, const f32x4 (&v)[4]) {
    GAS unsigned long long* o8 = (GAS unsigned long long*)orow + lane;
#pragma unroll
    for (int j = 0; j < 4; ++j) o8[64 * j] = (unsigned long long)pk2(v[j].x, v[j].y) | ((unsigned long long)pk2(v[j].z, v[j].w) << 32);
}

__device__ __forceinline__ float rowb_rms_load(const bf16* xrow, const float* g, int lane, float (&v)[16]) {
    float s = 0.f;
#pragma unroll
    for (int j = 0; j < 2; ++j) { const v4u x = *(const GAS v4u*)(xrow + 8 * lane + 512 * j);
        v[8 * j + 0] = bflo(x.x); v[8 * j + 1] = bfhi(x.x); v[8 * j + 2] = bflo(x.y); v[8 * j + 3] = bfhi(x.y); v[8 * j + 4] = bflo(x.z); v[8 * j + 5] = bfhi(x.z); v[8 * j + 6] = bflo(x.w); v[8 * j + 7] = bfhi(x.w); }
#pragma unroll
    for (int k = 0; k < 16; ++k) s += v[k] * v[k];
    const float r = 1.0f / sqrtf(wave_sum(s, lane) * (1.f / D) + RMS_EPS);
#pragma unroll
    for (int j = 0; j < 2; ++j) { const f32x4 g0 = *(const GAS f32x4*)(g + 8 * lane + 512 * j), g1 = *(const GAS f32x4*)(g + 8 * lane + 512 * j + 4);
        v[8 * j + 0] *= r * g0.x; v[8 * j + 1] *= r * g0.y; v[8 * j + 2] *= r * g0.z; v[8 * j + 3] *= r * g0.w; v[8 * j + 4] *= r * g1.x; v[8 * j + 5] *= r * g1.y; v[8 * j + 6] *= r * g1.z; v[8 * j + 7] *= r * g1.w; }
    return r;
}
__device__ __forceinline__ float rowb_rms_from(const v4u (&x)[2], const float* g, int lane, float (&v)[16]) {
    float s = 0.f;
#pragma unroll
    for (int j = 0; j < 2; ++j) { v[8 * j + 0] = bflo(x[j].x); v[8 * j + 1] = bfhi(x[j].x); v[8 * j + 2] = bflo(x[j].y); v[8 * j + 3] = bfhi(x[j].y); v[8 * j + 4] = bflo(x[j].z); v[8 * j + 5] = bfhi(x[j].z); v[8 * j + 6] = bflo(x[j].w); v[8 * j + 7] = bfhi(x[j].w); }
#pragma unroll
    for (int k = 0; k < 16; ++k) s += v[k] * v[k];
    const float r = 1.0f / sqrtf(wave_sum(s, lane) * (1.f / D) + RMS_EPS);
#pragma unroll
    for (int j = 0; j < 2; ++j) { const f32x4 g0 = *(const GAS f32x4*)(g + 8 * lane + 512 * j), g1 = *(const GAS f32x4*)(g + 8 * lane + 512 * j + 4);
        v[8 * j + 0] *= r * g0.x; v[8 * j + 1] *= r * g0.y; v[8 * j + 2] *= r * g0.z; v[8 * j + 3] *= r * g0.w; v[8 * j + 4] *= r * g1.x; v[8 * j + 5] *= r * g1.y; v[8 * j + 6] *= r * g1.z; v[8 * j + 7] *= r * g1.w; }
    return r;
}
__device__ __forceinline__ void rowb_store_bf16(bf16* orow, int lane, const float (&v)[16]) {
#pragma unroll
    for (int j = 0; j < 2; ++j) { v4u w; w.x = pk2(v[8 * j], v[8 * j + 1]); w.y = pk2(v[8 * j + 2], v[8 * j + 3]); w.z = pk2(v[8 * j + 4], v[8 * j + 5]); w.w = pk2(v[8 * j + 6], v[8 * j + 7]);
        *(GAS v4u*)(orow + 8 * lane + 512 * j) = w; }
}
__device__ __forceinline__ void rowb_store_fp8(unsigned char* orow, int lane, const float (&v)[16]) {
#pragma unroll
    for (int j = 0; j < 2; ++j) { v2u w; w.x = cvt4_fp8g(v[8 * j], v[8 * j + 1], v[8 * j + 2], v[8 * j + 3]); w.y = cvt4_fp8g(v[8 * j + 4], v[8 * j + 5], v[8 * j + 6], v[8 * j + 7]);
        *(GAS v2u*)(orow + 8 * lane + 512 * j) = w; }
}
__device__ __forceinline__ void row_store_fp8(unsigned char* orow, int lane, const f32x4 (&v)[4]) {
    GAS unsigned* o4 = (GAS unsigned*)orow + lane;
#pragma unroll
    for (int j = 0; j < 4; ++j) o4[64 * j] = cvt4_fp8g(v[j].x, v[j].y, v[j].z, v[j].w);
}
__device__ __forceinline__ void ph_prologue(CArgs& args, LAS unsigned char* lds, const int wave0) {
    const int tid = fresh_tid(), lane = tid & 63, wave = __builtin_amdgcn_readfirstlane(tid >> 6), gw = blockIdx.x * NWAVES + wave, NGW = gridDim.x * NWAVES;
    unsigned char* ws = args.ws;
    LAS float* scr = (LAS float*)(lds + wave * 16384);
    constexpr int I_WIN = 16 * (GCOL0 / 32), I_WG = 16 * ((WIN - GCOL0) / 32), I_BP = 4 * 32, I_WO = 16 * 32, I_D1 = 16 * (FF0 / 32), I_D2 = (FF0 / 64) * 32, I_E1 = 16 * (FFE / 32), I_E2 = (FFE / 64) * 32;
    constexpr int NIT = 2 * I_WIN + 2 * I_WG + 8 * I_BP + 2 * I_WO + 2 * I_D1 + I_D2 + 16 * I_E1 + 8 * I_E2;
    for (int it = gw; it < NIT; it += NGW) {
        int r = it;
        if (r < 2 * I_WIN) { const int l = r / I_WIN; transpose_item(args.in[3] + (size_t)l * D * WIN, D, GCOL0, (bf16*)(ws + WS_WIN) + (size_t)l * GCOL0 * D, 0, 0, scr, r % I_WIN, lane, l ? args.in[2] + D : nullptr, WIN); continue; } r -= 2 * I_WIN;
        if (r < 2 * I_WG) { const int l = r / I_WG; transpose_item8(args.in[3] + (size_t)l * D * WIN + GCOL0, D, WIN - GCOL0, ws + WS_WG8 + (size_t)l * (WIN - GCOL0) * D, 0, 0, scr, r % I_WG, lane, l ? args.in[2] + D : nullptr, WIN); continue; } r -= 2 * I_WG;
        if (r < 8 * I_BP) { const int q = r / I_BP;
            if ((q & 3) != 2) { transpose_item(args.in[9] + (size_t)q * 256 * D, 256, D, (bf16*)(ws + WS_BP) + (size_t)q * D * 256, 0, 0, scr, r % I_BP, lane); continue; }
            const int it2 = r % I_BP; if (it2 < 64) { const int l = q >> 2, g = it2 >> 4, n = (it2 & 15) * 64 + lane;
                const float* pw = args.in[5] + ((size_t)l * 4 + g) * 64 * 64; const float* psc = args.in[6] + (size_t)l * 256 + g * 64; const float* b2 = args.in[9] + ((size_t)q * 256 + g * 64) * D + n;
                bf16* dst = (bf16*)(ws + WS_BP) + (size_t)q * D * 256 + (size_t)n * 256 + g * 64;
#pragma unroll 1
                for (int ch = 0; ch < 4; ++ch) {
                    float accw[16];
#pragma unroll
                    for (int c = 0; c < 16; ++c) accw[c] = 0.f;
#pragma unroll 4
                    for (int d = 0; d < 64; ++d) { const float bv = b2[(size_t)d * D] * psc[d];
#pragma unroll
                        for (int c = 0; c < 16; ++c) accw[c] += pw[(ch * 16 + c) * 64 + d] * bv; }
#pragma unroll
                    for (int c8 = 0; c8 < 2; ++c8) { v4u w; w.x = pk2(accw[8 * c8], accw[8 * c8 + 1]); w.y = pk2(accw[8 * c8 + 2], accw[8 * c8 + 3]); w.z = pk2(accw[8 * c8 + 4], accw[8 * c8 + 5]); w.w = pk2(accw[8 * c8 + 6], accw[8 * c8 + 7]);
                        *(GAS v4u*)(dst + ch * 16 + 8 * c8) = w; } } }
            continue; } r -= 8 * I_BP;
        if (r < 2 * I_WO) { const int l = r / I_WO; transpose_item(args.in[10] + (size_t)l * D * D, D, D, (bf16*)(ws + WS_WOUT) + (size_t)l * D * D, 0, 0, scr, r % I_WO, lane); continue; } r -= 2 * I_WO;
        if (r < I_D1) { transpose_item(args.in[12], D, FF0, (bf16*)(ws + WS_W13D), 0, 1, scr, r, lane, args.in[11]); continue; } r -= I_D1;
        if (r < I_D1) { transpose_item(args.in[13], D, FF0, (bf16*)(ws + WS_W13D), 128, 1, scr, r, lane, args.in[11]); continue; } r -= I_D1;
        if (r < I_D2) { transpose_item8(args.in[14], FF0, D, ws + WS_W2D, 0, 0, scr, r, lane); continue; } r -= I_D2;
        if (r < 8 * I_E1) { const int e = r / I_E1; transpose_item8(args.in[16] + (size_t)e * D * FFE, D, FFE, ws + WS_W13E + (size_t)e * 2 * FFE * D, 0, 1, scr, r % I_E1, lane); continue; } r -= 8 * I_E1;
        if (r < 8 * I_E1) { const int e = r / I_E1; transpose_item8(args.in[17] + (size_t)e * D * FFE, D, FFE, ws + WS_W13E + (size_t)e * 2 * FFE * D, 128, 1, scr, r % I_E1, lane); continue; } r -= 8 * I_E1;
        { const int e = r / I_E2; transpose_item8(args.in[18] + (size_t)e * FFE * D, FFE, D, ws + WS_W2E + (size_t)e * D * FFE, 0, 0, scr, r % I_E2, lane); }
    }
}

__device__ __forceinline__ void ph_norm_rb(const bf16* src, const float* g, bf16* dst, const int wave0) {
    const int tid = fresh_tid(), lane = tid & 63, wave = __builtin_amdgcn_readfirstlane(tid >> 6), gw = blockIdx.x * NWAVES + wave, NGW = gridDim.x * NWAVES;
    for (int m = gw; m < M; m += NGW) { float v[16]; (void)rowb_rms_load(src + (size_t)m * D, g, lane, v); rowb_store_bf16(dst + (size_t)m * D, lane, v); }
}
__device__ __forceinline__ void ph_norm_bf16(const float* src, const float* g, bf16* dst, unsigned char* dst8, const int wave0) {
    const int tid = fresh_tid(), lane = tid & 63, wave = __builtin_amdgcn_readfirstlane(tid >> 6), gw = blockIdx.x * NWAVES + wave, NGW = gridDim.x * NWAVES;
    for (int m = gw; m < M; m += NGW) { f32x4 v[4]; (void)row_rms_load(src + (size_t)m * D, g, lane, v); row_store_bf16(dst + (size_t)m * D, lane, v); row_store_fp8(dst8 + (size_t)m * D, lane, v); }
}
__device__ __forceinline__ void ph_final_norm(const bf16* R, const float* g, float* out, const int wave0) {
    const int tid = fresh_tid(), lane = tid & 63, wave = __builtin_amdgcn_readfirstlane(tid >> 6), gw = blockIdx.x * NWAVES + wave, NGW = gridDim.x * NWAVES;
    f32x4 gg[4];
#pragma unroll
    for (int j = 0; j < 2; ++j) { gg[2 * j] = *(const GAS f32x4*)(g + 8 * lane + 512 * j); gg[2 * j + 1] = *(const GAS f32x4*)(g + 8 * lane + 512 * j + 4); }
    for (int m0 = gw; m0 < M; m0 += 2 * NGW) {
        v4u x[2][2], z[2][2], z0[2][2];
#pragma unroll
        for (int q = 0; q < 2; ++q)
#pragma unroll
            for (int j = 0; j < 2; ++j) { x[q][j] = *(const GAS v4u*)(R + (size_t)(m0 + q * NGW) * D + 8 * lane + 512 * j);
                z[q][j] = *(const GAS v4u*)((const bf16*)(out + (size_t)(m0 + q * NGW) * D + 512) + 8 * lane + 512 * j);
                z0[q][j] = *(const GAS v4u*)((const bf16*)(out + (size_t)(m0 + q * NGW) * D) + 8 * lane + 512 * j); }
#pragma unroll
        for (int q = 0; q < 2; ++q) { float v[16];
#pragma unroll
            for (int j = 0; j < 2; ++j) { const v4u w = x[q][j], y = z[q][j], y0 = z0[q][j];
                v[8 * j + 0] = bflo(w.x) + (bflo(y0.x) + bflo(y.x)); v[8 * j + 1] = bfhi(w.x) + (bfhi(y0.x) + bfhi(y.x)); v[8 * j + 2] = bflo(w.y) + (bflo(y0.y) + bflo(y.y)); v[8 * j + 3] = bfhi(w.y) + (bfhi(y0.y) + bfhi(y.y));
                v[8 * j + 4] = bflo(w.z) + (bflo(y0.z) + bflo(y.z)); v[8 * j + 5] = bfhi(w.z) + (bfhi(y0.z) + bfhi(y.z)); v[8 * j + 6] = bflo(w.w) + (bflo(y0.w) + bflo(y.w)); v[8 * j + 7] = bfhi(w.w) + (bfhi(y0.w) + bfhi(y.w)); }
            float s = 0.f;
#pragma unroll
            for (int k = 0; k < 16; ++k) s += v[k] * v[k];
            const float r = 1.0f / sqrtf(wave_sum(s, lane) * (1.f / D) + RMS_EPS);
            float* o = out + (size_t)(m0 + q * NGW) * D + 8 * lane;
#pragma unroll
            for (int j = 0; j < 2; ++j) { const f32x4 a = gg[2 * j], b = gg[2 * j + 1];
                *(GAS f32x4*)(o + 512 * j) = (f32x4){v[8 * j] * r * a.x, v[8 * j + 1] * r * a.y, v[8 * j + 2] * r * a.z, v[8 * j + 3] * r * a.w};
                *(GAS f32x4*)(o + 512 * j + 4) = (f32x4){v[8 * j + 4] * r * b.x, v[8 * j + 5] * r * b.y, v[8 * j + 6] * r * b.z, v[8 * j + 7] * r * b.w}; } }
    }
}

__device__ __forceinline__ void ph_kmean(const bf16* U, float* kmean, LAS unsigned char* lds, const int wave0) {
    const int tid = fresh_tid();
    LAS float* red = (LAS float*)lds;
    for (int task = blockIdx.x; task < HB * 8; task += gridDim.x) {
        const int bl = task >> 3, blk = task & 7, cg = tid & 31, rq = tid >> 5;
        const bf16* kp = U + ((size_t)bl * SEQ + blk * 256 + rq * 16) * UST + C_KA + 8 * cg;
        v4u x[16];
#pragma unroll
        for (int i = 0; i < 16; ++i) x[i] = *(const GAS v4u*)(kp + (size_t)i * UST);
        float sm[8];
#pragma unroll
        for (int k = 0; k < 8; ++k) sm[k] = 0.f;
#pragma unroll
        for (int i = 0; i < 16; ++i) { sm[0] += bflo(x[i].x); sm[1] += bfhi(x[i].x); sm[2] += bflo(x[i].y); sm[3] += bfhi(x[i].y); sm[4] += bflo(x[i].z); sm[5] += bfhi(x[i].z); sm[6] += bflo(x[i].w); sm[7] += bfhi(x[i].w); }
#pragma unroll
        for (int k = 0; k < 8; ++k) red[rq * 256 + 8 * cg + k] = sm[k];
        __syncthreads();
        if (tid < 256) { float t = 0.f;
#pragma unroll
            for (int q = 0; q < 16; ++q) t += red[q * 256 + tid];
            kmean[(size_t)task * 256 + tid] = t * (1.0f / 256.0f); }
        __syncthreads();
    }
}

__device__ __forceinline__ void ph_conv_pool(CArgs& args, int l, const bf16* U, bf16* Y, LAS unsigned char* lds, const int wave0) {
    const int tid = fresh_tid(), lane = tid & 63, wave = __builtin_amdgcn_readfirstlane(tid >> 6), gw = blockIdx.x * NWAVES + wave, NGW = gridDim.x * NWAVES;
    {
        const float* cw = args.in[4] + (size_t)l * 3 * 256; const int c0 = (lane & 31) * 8;
        float w0[8], w1[8], w2[8];
#pragma unroll
        for (int k = 0; k < 8; ++k) { w0[k] = cw[c0 + k]; w1[k] = cw[256 + c0 + k]; w2[k] = cw[512 + c0 + k]; }
        for (int ch = gw; ch < HROWS / 8; ch += NGW) {
            const int rl0 = ch * 8 + (lane >> 5) * 4, t = rl0 & (SEQ - 1);
            const bf16* up = U + (size_t)rl0 * UST; const int back = t > 0 ? 1 : 0; const float mb = t > 0 ? 1.f : 0.f;
            v4u xv[6], gv[6], bv[4];
#pragma unroll
            for (int k = 0; k < 6; ++k) { const long ro = (k < 2) ? (long)(k - 2) * back : (long)(k - 2); xv[k] = *(const GAS v4u*)(up + ro * UST + C_XB + c0); gv[k] = *(const GAS v4u*)(up + ro * UST + C_CB + c0); }
#pragma unroll
            for (int i = 0; i < 4; ++i) bv[i] = *(const GAS v4u*)(up + (size_t)i * UST + C_BB + c0);
            float uu[6][8];
#pragma unroll
            for (int k = 0; k < 6; ++k) { const float mk = (k < 2) ? mb : 1.f;
                uu[k][0] = mk * bflo(xv[k].x) * bflo(gv[k].x); uu[k][1] = mk * bfhi(xv[k].x) * bfhi(gv[k].x); uu[k][2] = mk * bflo(xv[k].y) * bflo(gv[k].y); uu[k][3] = mk * bfhi(xv[k].y) * bfhi(gv[k].y);
                uu[k][4] = mk * bflo(xv[k].z) * bflo(gv[k].z); uu[k][5] = mk * bfhi(xv[k].z) * bfhi(gv[k].z); uu[k][6] = mk * bflo(xv[k].w) * bflo(gv[k].w); uu[k][7] = mk * bfhi(xv[k].w) * bfhi(gv[k].w); }
#pragma unroll
            for (int i = 0; i < 4; ++i) { float cv[8];
#pragma unroll
                for (int k = 0; k < 8; ++k) cv[k] = w2[k] * uu[i + 2][k] + w1[k] * uu[i + 1][k] + w0[k] * uu[i][k];
                v4u w; w.x = pk2(cv[0] * bflo(bv[i].x), cv[1] * bfhi(bv[i].x)); w.y = pk2(cv[2] * bflo(bv[i].y), cv[3] * bfhi(bv[i].y)); w.z = pk2(cv[4] * bflo(bv[i].z), cv[5] * bfhi(bv[i].z)); w.w = pk2(cv[6] * bflo(bv[i].w), cv[7] * bfhi(bv[i].w));
                *(GAS v4u*)(Y + (size_t)(rl0 + i) * 1024 + 256 + c0) = w; }
        }
    }
    {
        const int gq = lane >> 4, c4 = (lane & 15) * 4, wlen = 2 << gq;
        for (int ch = gw; ch < HROWS / 8; ch += NGW) {
            const int rl0 = ch * 8, t0 = rl0 & (SEQ - 1); const bf16* pp = U + (size_t)rl0 * UST + C_PC + gq * 64 + c4;
            v2u xr[23];
#pragma unroll
            for (int i = 0; i < 23; ++i) { const int d = i - 15; const long ro = (t0 + d >= 0) ? (long)d : 0; xr[i] = *(const GAS v2u*)(pp + ro * UST); }
            float xf[23][4];
#pragma unroll
            for (int i = 0; i < 23; ++i) { const float mk = (t0 + i - 15 >= 0) ? 1.f : 0.f; xf[i][0] = mk * bflo(xr[i].x); xf[i][1] = mk * bfhi(xr[i].x); xf[i][2] = mk * bflo(xr[i].y); xf[i][3] = mk * bfhi(xr[i].y); }
#pragma unroll
            for (int tk = 0; tk < 8; ++tk) { float s0 = 0.f, s1 = 0.f, s2 = 0.f, s3 = 0.f;
#pragma unroll
                for (int j = 0; j < 16; ++j) { const float mk = j < wlen ? 1.f : 0.f; s0 += mk * xf[15 + tk - j][0]; s1 += mk * xf[15 + tk - j][1]; s2 += mk * xf[15 + tk - j][2]; s3 += mk * xf[15 + tk - j][3]; }
                const int t = t0 + tk; const int cnt = (t + 1) < wlen ? (t + 1) : wlen; const float ic = 1.0f / (float)cnt;
                v2u w; w.x = pk2(s0 * ic - xf[15 + tk][0], s1 * ic - xf[15 + tk][1]); w.y = pk2(s2 * ic - xf[15 + tk][2], s3 * ic - xf[15 + tk][3]);
                *(GAS v2u*)(Y + (size_t)(rl0 + tk) * 1024 + 512 + gq * 64 + c4) = w; }
        }
    }
    __syncthreads();
}

__device__ __forceinline__ void ph_attn(CArgs& args, int l, const bf16* U, const float* kmean, bf16* Y, LAS unsigned char* lds, const int wave0) {
    const float* dl = args.in[7] + (size_t)l * 128; const float* subg = args.in[8] + (size_t)l * 64;
    float a = 0.f, b = 0.f;
    for (int i = 0; i < 32; ++i) { a += dl[i] * dl[32 + i]; b += dl[64 + i] * dl[96 + i]; }
    int l_s = l; asm volatile("" : "+s"(l_s));
    const float lam_init = (l_s == 0) ? 0.2f : 0.35550906759096926f;
    const float lam = __expf(a) - __expf(b) + lam_init, outscale = 1.0f - lam_init;
    const LAS float* lut = (const LAS float*)(lds + LUT_OFF);
    for (int cu0 = blockIdx.x; cu0 < HB * 4 * 4; cu0 += gridDim.x) {
        const int cu = (gridDim.x == 256) ? ((cu0 & 7) * 32 + (cu0 >> 3)) : cu0;
        const int bh = cu >> 2, pr = cu & 3, bl = bh >> 2, h = bh & 3;
#pragma unroll 1
        for (int k = 0; k < 2; ++k) attn_unit<false>(U, kmean, Y, lut, lds, bl, h, k ? 7 - pr : pr, wave0, 0.f, 0.f, subg);
#pragma unroll 1
        for (int k = 0; k < 2; ++k) attn_unit<true>(U, kmean, Y, lut, lds, bl, h, k ? 7 - pr : pr, wave0, lam, outscale, subg);
    }
}

__device__ __forceinline__ void ph_route(CArgs& args, int l, const bf16* R, unsigned* route, int* tokp, gu32* ctl, LAS unsigned char* lds, const int wave0) {
    const int tid = fresh_tid(), lane = tid & 63, wave = __builtin_amdgcn_readfirstlane(tid >> 6), gw = blockIdx.x * NWAVES + wave, NGW = gridDim.x * NWAVES;
    const float* g = args.in[11] + (size_t)l * D;
    LAS float* rl = (LAS float*)lds;
    { const float* rw = args.in[15]; for (int i = tid; i < D * 8; i += NWAVES * 64) rl[i] = rw[i] * g[i >> 3]; }
    for (int i = blockIdx.x * NWAVES * 64 + tid; i < 2 * CAPROWS; i += gridDim.x * NWAVES * 64) tokp[i] = -1;
    __syncthreads();
    for (int m0 = gw; m0 < M; m0 += 4 * NGW) {
        v4u xr[4][2];
#pragma unroll
        for (int q = 0; q < 4; ++q)
#pragma unroll
            for (int j = 0; j < 2; ++j) xr[q][j] = *(const GAS v4u*)(R + (size_t)(m0 + q * NGW) * D + 8 * lane + 512 * j);
        int i0q[4], i1q[4]; float w0q[4], w1q[4], rq[4];
#pragma unroll
        for (int q = 0; q < 4; ++q) {
            float v[16], ss = 0.f;
#pragma unroll
            for (int j = 0; j < 2; ++j) { v[8 * j + 0] = bflo(xr[q][j].x); v[8 * j + 1] = bfhi(xr[q][j].x); v[8 * j + 2] = bflo(xr[q][j].y); v[8 * j + 3] = bfhi(xr[q][j].y); v[8 * j + 4] = bflo(xr[q][j].z); v[8 * j + 5] = bfhi(xr[q][j].z); v[8 * j + 6] = bflo(xr[q][j].w); v[8 * j + 7] = bfhi(xr[q][j].w); }
#pragma unroll
            for (int k = 0; k < 16; ++k) ss += v[k] * v[k];
            float lg[8];
#pragma unroll
            for (int e = 0; e < 8; ++e) lg[e] = 0.f;
#pragma unroll
            for (int j = 0; j < 2; ++j)
#pragma unroll
                for (int k = 0; k < 8; ++k) { const int c = 8 * lane + 512 * j + k; const f32x4 ra = *(const LAS f32x4*)(rl + c * 8), rb = *(const LAS f32x4*)(rl + c * 8 + 4); const float xv = v[8 * j + k];
                    lg[0] += xv * ra.x; lg[1] += xv * ra.y; lg[2] += xv * ra.z; lg[3] += xv * ra.w; lg[4] += xv * rb.x; lg[5] += xv * rb.y; lg[6] += xv * rb.z; lg[7] += xv * rb.w; }
#define RT_X(k_, val_) __int_as_float(__builtin_amdgcn_ds_bpermute((lane ^ (k_)) << 2, __float_as_int(val_)))
            { const bool b1 = (lane & 1) != 0, b2 = (lane & 2) != 0, b3 = (lane & 4) != 0;
              float a4[4], c2[2], d1;
#pragma unroll
              for (int i = 0; i < 4; ++i) { const float snd = b1 ? lg[i] : lg[4 + i], kp = b1 ? lg[4 + i] : lg[i]; a4[i] = kp + RT_X(1, snd); }
#pragma unroll
              for (int i = 0; i < 2; ++i) { const float snd = b2 ? a4[i] : a4[2 + i], kp = b2 ? a4[2 + i] : a4[i]; c2[i] = kp + RT_X(2, snd); }
              { const float snd = b3 ? c2[0] : c2[1], kp = b3 ? c2[1] : c2[0]; d1 = kp + RT_X(4, snd); }
              d1 += RT_X(8, d1); d1 += RT_X(16, d1); d1 += RT_X(32, d1);
              const float r = 1.0f / sqrtf(wave_sum(ss, lane) * (1.f / D) + RMS_EPS); rq[q] = r;
#pragma unroll
              for (int e = 0; e < 8; ++e) lg[e] = r * __int_as_float(__builtin_amdgcn_readlane(__float_as_int(d1), ((e >> 2) & 1) | (((e >> 1) & 1) << 1) | ((e & 1) << 2))); }
#undef RT_X
            int i0 = 0; float v0 = lg[0];
#pragma unroll
            for (int e = 1; e < 8; ++e) if (lg[e] > v0) { v0 = lg[e]; i0 = e; }
            int i1 = 0; float v1 = -3.0e38f;
#pragma unroll
            for (int e = 0; e < 8; ++e) if (e != i0 && lg[e] > v1) { v1 = lg[e]; i1 = e; }
            const float e1 = __expf(v1 - v0); w0q[q] = 1.0f / (1.0f + e1); w1q[q] = e1 * w0q[q]; i0q[q] = i0; i1q[q] = i1;
        }
        if (lane == 0) {
            unsigned s0[4], s1[4];
#pragma unroll
            for (int q = 0; q < 4; ++q) { s0[q] = atomicAdd((unsigned*)(ctl + CW_CNT + (0 * 8 + i0q[q]) * 64), 1u); s1[q] = atomicAdd((unsigned*)(ctl + CW_CNT + (1 * 8 + i1q[q]) * 64), 1u); }
#pragma unroll
            for (int q = 0; q < 4; ++q) { unsigned* rec = route + (size_t)(m0 + q * NGW) * 8; rec[0] = (unsigned)i0q[q] | ((unsigned)i1q[q] << 8); rec[1] = s0[q]; rec[2] = s1[q]; rec[3] = __float_as_uint(w0q[q]); rec[4] = __float_as_uint(w1q[q]); rec[5] = __float_as_uint(rq[q]); }
        }
    }
}

__device__ __forceinline__ void ph_gather(CArgs& args, int l, const bf16* R, const unsigned* route, int* tokp, float* gatep, int* tile_e, int* n_rt, unsigned char* hperm, gu32* ctl, LAS unsigned char* lds, const int wave0) {
    const int tid = fresh_tid(), lane = tid & 63, wave = __builtin_amdgcn_readfirstlane(tid >> 6), gw = blockIdx.x * NWAVES + wave, NGW = gridDim.x * NWAVES;
    const float* g = args.in[11] + (size_t)l * D;
    LAS int* base = (LAS int*)lds;
    if (tid < 2) { int acc = 0;
        for (int e = 0; e < 8; ++e) { base[tid * 8 + e] = acc; const int c = (int)__hip_atomic_load((unsigned*)(ctl + CW_CNT + (tid * 8 + e) * 64), RLX_AGENT); acc += (c + 255) & ~255; }
        base[16 + tid] = acc; }
    __syncthreads();
    if (blockIdx.x == 0 && tid < 2) { const int p = tid, nt = base[16 + p] >> 8; n_rt[p] = nt;
        for (int rt = 0; rt < nt; ++rt) { int e = 0; for (int k = 1; k < 8; ++k) if (rt * 256 >= base[p * 8 + k]) e = k; tile_e[p * 512 + rt] = e; } }
    for (int m0 = gw; m0 < M; m0 += 4 * NGW) {
        v4u xr[4][2]; unsigned ee[4], sl0[4], sl1[4], gw0[4], gw1[4], rs5[4];
#pragma unroll
        for (int q = 0; q < 4; ++q) { const size_t m = (size_t)(m0 + q * NGW);
#pragma unroll
            for (int j = 0; j < 2; ++j) xr[q][j] = *(const GAS v4u*)(R + m * D + 8 * lane + 512 * j);
            const unsigned* rec = route + m * 8; ee[q] = rec[0]; sl0[q] = rec[1]; sl1[q] = rec[2]; gw0[q] = rec[3]; gw1[q] = rec[4]; rs5[q] = rec[5]; }
#pragma unroll
        for (int q = 0; q < 4; ++q) { const int m = m0 + q * NGW;
            float v[16]; const float r = __uint_as_float(rs5[q]);
#pragma unroll
            for (int j = 0; j < 2; ++j) { const f32x4 g0 = *(const GAS f32x4*)(g + 8 * lane + 512 * j), g1 = *(const GAS f32x4*)(g + 8 * lane + 512 * j + 4); const v4u x = xr[q][j];
                v[8 * j + 0] = bflo(x.x) * (r * g0.x); v[8 * j + 1] = bfhi(x.x) * (r * g0.y); v[8 * j + 2] = bflo(x.y) * (r * g0.z); v[8 * j + 3] = bfhi(x.y) * (r * g0.w);
                v[8 * j + 4] = bflo(x.z) * (r * g1.x); v[8 * j + 5] = bfhi(x.z) * (r * g1.y); v[8 * j + 6] = bflo(x.w) * (r * g1.z); v[8 * j + 7] = bfhi(x.w) * (r * g1.w); }
            const int e0 = ee[q] & 255, e1 = (ee[q] >> 8) & 255;
            const int pos0 = base[e0] + (int)sl0[q], pos1 = base[8 + e1] + (int)sl1[q];
            rowb_store_fp8(hperm + (size_t)pos0 * D, lane, v); rowb_store_fp8(hperm + ((size_t)CAPROWS + pos1) * D, lane, v);
            if (lane == 0) { tokp[pos0] = m; tokp[CAPROWS + pos1] = m; gatep[pos0] = __uint_as_float(gw0[q]); gatep[CAPROWS + pos1] = __uint_as_float(gw1[q]); } }
    }
    __syncthreads();
}

__global__ void __launch_bounds__(NWAVES * 64, 2) mega_fwd(Args args0) {
    extern __shared__ __attribute__((aligned(16))) unsigned char lds_raw[];
    LAS unsigned char* lds = (LAS unsigned char*)lds_raw;
    volatile LAS unsigned* MISC = (volatile LAS unsigned*)(lds + MISC_OFF);
    const int G = gridDim.x;
    const int wave0 = __builtin_amdgcn_readfirstlane((int)(threadIdx.x >> 6));
    gu32* ctl = (gu32*)(args0.ws + WS_CTL);
    { const int tid = threadIdx.x;
      for (int i = tid; i < (LDS_BYTES - LDSCTL_OFF) / 4; i += NWAVES * 64) ((LAS unsigned*)(lds + LDSCTL_OFF))[i] = 0u;
      LAS float* lut = (LAS float*)(lds + LUT_OFF); const float* bt = args0.in[1];
      for (int i = tid; i < 8 * LUT_N; i += NWAVES * 64) { const int hd = i / LUT_N, n = i % LUT_N - LUT_NEG; lut[i] = (n < 0) ? -1.0e30f : 1.4426950408889634f * bt[(int)BKT[n > 128 ? 128 : n] * 8 + hd]; }
      if (tid < 256) { const float gv = __builtin_amdgcn_cvt_f32_fp8(tid, 0); ((LAS float*)(lds + SLUT_OFF))[tid] = 1.0f / (1.0f + __expf(-gv)); } }
    __syncthreads();
    XcdBarrier bar; bar.bar = (unsigned*)(ctl + CW_BAR) + args0.li * XCD_BAR_WORDS; bar.x = 0; bar.st = nullptr;
#if MK_ONE_LAUNCH
    bar = xcd_barrier_post((unsigned*)(ctl + CW_BAR) + args0.li * XCD_BAR_WORDS, MISC + 8);
#define GRID_BAR() xcd_barrier(bar)
#else
    (void)MISC;
#define GRID_BAR() do { } while (0)
#endif
    const int lo = args0.ph_lo, hi = args0.ph_hi;
#define IN(k) (lo <= (k) && (k) < hi)
#define BOTH(k) (IN(k) && IN((k) + 1))

#define OPQ_PTRS CArgs* ka_ = (CArgs*)__builtin_amdgcn_kernarg_segment_ptr(); asm volatile("" : "+s"(ka_)); CArgs& args = *ka_; unsigned char* ws = args.ws; bf16* R = (bf16*)(ws + WS_R); \
        bf16* Hn = (bf16*)(ws + WS_H); bf16* U = (bf16*)(ws + WS_U); bf16* Y = (bf16*)(ws + WS_Y); bf16* MG = (bf16*)(ws + WS_MG); float* kmean = (float*)(ws + WS_KMEAN); \
        unsigned* route = (unsigned*)(ws + WS_ROUTE); int* tokp = (int*)(ws + WS_TOK); float* gatep = (float*)(ws + WS_GATE); int* tile_e = (int*)(ws + WS_TILEE); int* n_rt = (int*)(ws + WS_TILEE + 4096); \
        (void)Hn; (void)U; (void)Y; (void)MG; (void)kmean; (void)route; (void)tokp; (void)gatep; (void)tile_e; (void)n_rt; (void)R
#define OPQ_I(name, v) int name = (v); asm volatile("" : "+s"(name))

    if (IN(0)) { OPQ_PTRS; ph_prologue(args, lds, wave0); ph_norm_bf16(args.in[0], args.in[2], Hn, ws + WS_A8, wave0); if (BOTH(0)) GRID_BAR(); }

    for (int l_ = 0; l_ < 2; ++l_) {
        const int pb = 1 + 17 * l_;
        for (int hf_ = 0; hf_ < 2; ++hf_) {
            const int p2 = pb + 1 + 5 * hf_;
            if (IN(p2)) {
                OPQ_PTRS; OPQ_I(l, l_); OPQ_I(hf, hf_); const size_t r0 = (size_t)hf * HROWS;
                const float* ssq1 = l == 0 ? (const float*)nullptr : (const float*)(ws + SSQ1_OFF) + r0 * 16;
                {
                    pg8::Gemm g{(l == 0 ? Hn : R) + r0 * D, (const bf16*)(ws + WS_WIN) + (size_t)l * GCOL0 * D, D, D, D};
                    pg8::Order S; S.init(HROWS / 256, GCOL0 / 256, G, (int)blockIdx.x, 0, D, D, nullptr, 0);
                    pg8::EpiWin E{U, UST, ssq1, 1 << 20, kmean, C_KA / 256};
                    pg8::gemm_phase<pg8::EpiWin, pg8::Order, true>(lds, fresh_tid(), g, S, E);
                }
                {
                    pg8::Gemm g{(const bf16*)(ws + WS_A8 + r0 * D), (const bf16*)(ws + WS_WG8 + (size_t)l * (WIN - GCOL0) * D), D / 2, D / 2, D / 2};
                    pg8::Order S; S.init(HROWS / 256, (WIN - GCOL0) / 256, G, (int)blockIdx.x, 0, D / 2, D / 2, nullptr, 0);
                    pg8::EpiGate8 E{(unsigned char*)U, 2 * UST, 2 * GCOL0, ssq1};
                    pg8::gemm_phase<pg8::EpiGate8, pg8::Order, true, true>(lds, fresh_tid(), g, S, E);
                }
                if (BOTH(p2)) GRID_BAR();
            }
            if (IN(p2 + 2)) {
                OPQ_PTRS; OPQ_I(l, l_);
                ph_conv_pool(args, l, U, Y, lds, wave0);
                ph_attn(args, l, U, kmean, Y, lds, wave0);
                if (BOTH(p2 + 2)) GRID_BAR();
            }
            if (IN(p2 + 3)) {
                OPQ_PTRS; OPQ_I(l, l_);
                pg8::Gemm g{Y, (const bf16*)(ws + WS_BP) + (size_t)l * 4 * D * 256, 1024, 256, 256};
                pg8::Order S; S.init(HROWS / 256, 4, G, (int)blockIdx.x, 1, 1024, 256, nullptr, (size_t)D * 256 * 2);
                pg8::EpiMerge E{U, UST, GCOL0, MG, 1024, (const LAS float*)(lds + SLUT_OFF)};
                pg8::gemm_phase<pg8::EpiMerge, pg8::Order, true>(lds, fresh_tid(), g, S, E);
                if (BOTH(p2 + 3)) GRID_BAR();
            }
            if (IN(p2 + 4)) {
                OPQ_PTRS; OPQ_I(l, l_); OPQ_I(hf, hf_); const size_t r0 = (size_t)hf * HROWS;
                pg8::Gemm g{MG, (const bf16*)(ws + WS_WOUT) + (size_t)l * D * D, D, D, D};
                pg8::Order S; S.init(HROWS / 256, 4, G, (int)blockIdx.x, 0, D, D, nullptr, 0);
                pg8::EpiRes E{args.in[0] + r0 * D, (l == 0) ? (const bf16*)nullptr : (const bf16*)(R + r0 * D), R + r0 * D, D, (l == 0) ? (float*)(ws + SSQ0_OFF) + r0 * 16 : (float*)nullptr};
                pg8::gemm_phase<pg8::EpiRes, pg8::Order, true>(lds, fresh_tid(), g, S, E);
                if (hf == 1 && BOTH(p2 + 4)) GRID_BAR();
            }
        }
        if (IN(pb + 11)) {
            OPQ_PTRS; OPQ_I(l, l_);
            if (l == 1) { ph_route(args, l, R, route, tokp, ctl, lds, wave0); if (BOTH(pb + 11)) GRID_BAR(); }
        }
        if (IN(pb + 12)) {
            OPQ_PTRS; OPQ_I(l, l_);
            if (l == 1) { ph_gather(args, l, R, route, tokp, gatep, tile_e, n_rt, ws + WS_HPERM, ctl, lds, wave0); if (BOTH(pb + 12)) GRID_BAR(); }
        }
        for (int ps_ = 0; ps_ < 2; ++ps_) {
            const int p3 = pb + 13 + 2 * ps_;
            if (IN(p3)) {
                OPQ_PTRS; OPQ_I(l, l_); OPQ_I(ps, ps_);
                if (l == 1) {
                    if (ps == 0) {
                        const int n0 = __builtin_amdgcn_readfirstlane(n_rt[0]), n1 = __builtin_amdgcn_readfirstlane(n_rt[1]);
                        pg8::Gemm g{(const bf16*)(ws + WS_HPERM), (const bf16*)(ws + WS_W13E), D / 2, D / 2, D / 2};
                        pg8::Order S; S.init(n0 + n1, 2 * FFE / 256, G, (int)blockIdx.x, 0, D / 2, D / 2, tile_e, (size_t)2 * FFE * D, n0, CAPT);
                        pg8::EpiSwiGLU8 E{ws + WS_TE, FFE, 256.0f, 8.0f};
                        pg8::gemm_phase<pg8::EpiSwiGLU8, pg8::Order, true, true>(lds, fresh_tid(), g, S, E);
                        if (BOTH(p3)) GRID_BAR();
                    }
                } else if (ps == 0) {
                    pg8::Gemm g{R, (const bf16*)(ws + WS_W13D), D, D, D};
                    pg8::Order S; S.init(M / 256, 2 * FF0 / 256, G, (int)blockIdx.x, 0, D, D, nullptr, 0);
                    pg8::EpiSwiGLU E{U, FF0, (const float*)(ws + SSQ0_OFF), 1};
                    pg8::gemm_phase<pg8::EpiSwiGLU, pg8::Order, true>(lds, fresh_tid(), g, S, E);
                    if (BOTH(p3)) GRID_BAR();
                }
            }
            if (IN(p3 + 1)) {
                OPQ_PTRS; OPQ_I(l, l_); OPQ_I(ps, ps_);
                if (l == 1) {
                    if (ps == 0) {
                        const int n0 = __builtin_amdgcn_readfirstlane(n_rt[0]), n1 = __builtin_amdgcn_readfirstlane(n_rt[1]);
                        pg8::Gemm g{(const bf16*)(ws + WS_TE), (const bf16*)(ws + WS_W2E), FFE / 2, FFE / 2, FFE / 2};
                        pg8::Order S; S.init(n0 + n1, 4, G, (int)blockIdx.x, 0, FFE / 2, FFE / 2, tile_e, (size_t)D * FFE, n0, CAPT);
                        pg8::EpiScatter E{R, D, tokp, gatep, 1.0f / 128.0f, nullptr, nullptr, (bf16*)args.out, 2048};
                        pg8::gemm_phase<pg8::EpiScatter, pg8::Order, true, true>(lds, fresh_tid(), g, S, E);
                        if (BOTH(p3 + 1)) GRID_BAR();
                    }
                } else if (ps == 0) {
                    pg8::Gemm g{U, (const bf16*)(ws + WS_W2D), FF0 / 2, FF0 / 2, FF0 / 2};
                    pg8::Order S; S.init(M / 256, 4, G, (int)blockIdx.x, 0, FF0 / 2, FF0 / 2, nullptr, 0);
                    pg8::EpiScatter E{R, D, nullptr, nullptr, 1.0f / 128.0f, (float*)(ws + SSQ1_OFF), ws + WS_A8, nullptr, 0};
                    pg8::gemm_phase<pg8::EpiScatter, pg8::Order, true, true>(lds, fresh_tid(), g, S, E);
                    if (BOTH(p3 + 1)) GRID_BAR();
                }
            }
        }
    }
    if (IN(35)) { OPQ_PTRS; ph_final_norm(R, args.in[19], args.out, wave0); }
#undef IN
#undef BOTH
}

extern "C" void kernel_launch(void* const* d_in, const int* in_sizes, int n_in, void* d_out, int out_size, void* d_ws, size_t ws_size, hipStream_t stream) {
    static int grid = 0;
    if (grid == 0) {
        if (n_in != 20 || in_sizes[0] != M * D || out_size != M * D || ws_size < WS_END) { fprintf(stderr, "kernel_launch: unexpected shapes / workspace (n_in %d, ws %zu); nothing launched\n", n_in, ws_size); grid = -1; return; }
        int dev = 0, cus = 0, per_cu = 0;
        if (hipGetDevice(&dev) != hipSuccess || hipDeviceGetAttribute(&cus, hipDeviceAttributeMultiprocessorCount, dev) != hipSuccess) { grid = -1; return; }
        if (hipFuncSetAttribute((const void*)mega_fwd, hipFuncAttributeMaxDynamicSharedMemorySize, LDS_BYTES) != hipSuccess) { fprintf(stderr, "kernel_launch: hipFuncSetAttribute failed\n"); grid = -1; return; }
        if (hipOccupancyMaxActiveBlocksPerMultiprocessor(&per_cu, (const void*)mega_fwd, NWAVES * 64, LDS_BYTES) != hipSuccess || per_cu < 1) { fprintf(stderr, "kernel_launch: occupancy query reports %d\n", per_cu); }
        (void)hipGetLastError();
        grid = cus;
    }
    if (grid < 0) return;
    if (hipMemsetAsync((char*)d_ws + WS_CTL, 0, CTL_ZERO_BYTES, stream) != hipSuccess) return;
    Args a{};
    for (int i = 0; i < 20; ++i) a.in[i] = (const float*)d_in[i];
    a.out = (float*)d_out; a.ws = (unsigned char*)d_ws;
#if MK_ONE_LAUNCH
#ifdef PROBE_DUP
    { const int dup[] = {PROBE_DUP}; const int nd = (int)(sizeof(dup) / sizeof(int)); int lo = 0;
      for (int i = 0; i <= nd; ++i) { a.ph_lo = lo; a.ph_hi = (i < nd) ? dup[i] + 1 : 36; a.li = i; hipLaunchKernelGGL(mega_fwd, dim3(grid), dim3(NWAVES * 64), LDS_BYTES, stream, a); if (i < nd) lo = dup[i]; } }
#else
    a.ph_lo = 0; a.ph_hi = 36;
    hipLaunchKernelGGL(mega_fwd, dim3(grid), dim3(NWAVES * 64), LDS_BYTES, stream, a);
#endif
#else
    for (int p = 0; p < 36; ++p) {
        if (p == 1 + 12 || p == 1 + 15 || p == 1 + 16) continue;
        a.ph_lo = p; a.ph_hi = p + 1;
        hipLaunchKernelGGL(mega_fwd, dim3(grid), dim3(NWAVES * 64), LDS_BYTES, stream, a);
    }
#endif
}
```

```cpp
#include <hip/hip_runtime.h>
#include <cstdio>
#include <cstdint>

#ifndef MK_ONE_LAUNCH
#define MK_ONE_LAUNCH 1
#endif

namespace pg8 {
#define PG8_LAS __attribute__((address_space(3)))
typedef unsigned short bf16_t;
typedef short bf16x8 __attribute__((ext_vector_type(8)));
typedef float f32x4 __attribute__((ext_vector_type(4)));
typedef unsigned u32x4 __attribute__((ext_vector_type(4)));
typedef unsigned u32x2 __attribute__((ext_vector_type(2)));
typedef int i32x4 __attribute__((ext_vector_type(4)));
typedef int i32x8 __attribute__((ext_vector_type(8)));
constexpr int BM = 256, BK = 64, HALF = 128, HTB = HALF * BK * 2  , STAGE_BYTES = 8 * HTB, NXCD = 8, WGM = 8;

__host__ __device__ __forceinline__ int lds_byte(int r, int c) { const int st = (r >> 4) * 2 + (c >> 5), rr = r & 15, cc = c & 31, ob = rr * 64 + cc * 2; return st * 1024 + (ob ^ (((ob >> 9) & 1) << 5)); }
__host__ __device__ __forceinline__ void stage_rc(int b, int& R, int& C) { const int st = b / 1024, sb = b % 1024, swz = sb ^ (((sb >> 9) & 1) << 5); R = (st >> 1) * 16 + swz / 64; C = (st & 1) * 32 + (swz % 64) / 2; }
__host__ __device__ __forceinline__ int perm32(int rho) { const int n = rho >> 4, i = rho & 15; return 8 * (i >> 2) + 4 * n + (i & 3); }

struct Unit { int pm, pn, e, prow, second; size_t aoff, boff; };
struct Gemm { const bf16_t* A; const bf16_t* Bt; int lda, ldb, K; };

struct Order {
    int nM, nN, nwg, G, c, mode, n0, skip; size_t arow  , brow  , estride; const int* tile_e;
    __device__ __forceinline__ void init(int nM_, int nN_, int G_, int c_, int mode_, int lda, int ldb, const int* te, size_t es, int n0_ = 1 << 30, int skip_ = 0) {
        nM = nM_; nN = nN_; nwg = nM * nN; G = G_; c = c_; mode = mode_; arow = (size_t)BM * lda * 2; brow = (size_t)BM * ldb * 2; tile_e = te; estride = es; n0 = n0_; skip = skip_; }
    __device__ __forceinline__ bool base(int i, Unit& u) const {
        const long L = (long)i * G + c; if (L >= nwg) return false;
        int wgid = (int)L; { const int q = nwg / NXCD, r = nwg % NXCD, xcd = wgid % NXCD, off = wgid / NXCD; wgid = (xcd < r ? xcd * (q + 1) : r * (q + 1) + (xcd - r) * q) + off; }
        const int nig = WGM * nN, gid = wgid / nig, fm = gid * WGM, gsz = (nM - fm) < WGM ? (nM - fm) : WGM;
        u.pm = fm + ((wgid % nig) % gsz); u.pn = (wgid % nig) / gsz; return true;
    }
    __device__ __forceinline__ bool next(int i, Unit& u) const {
        if (mode == 1) { if (!base(i >> 2, u)) return false; u.e = i & 3; u.prow = u.pm; u.second = 0; u.aoff = (size_t)u.pm * arow + (size_t)u.e * 512; u.boff = (size_t)u.e * estride + (size_t)u.pn * brow; return true; }
        if (!base(i, u)) return false;
        const bool second = u.pm >= n0; u.prow = second ? skip + (u.pm - n0) : u.pm; u.second = second ? 1 : 0;
        u.e = tile_e ? __builtin_amdgcn_readfirstlane(tile_e[second ? 512 + (u.pm - n0) : u.pm]) : 0; u.aoff = (size_t)u.prow * arow; u.boff = (size_t)u.e * estride + (size_t)u.pn * brow; return true;
    }
    __device__ __forceinline__ void a_ready(const Unit&) const {}
    __device__ __forceinline__ void done(const Unit&) const {}
};

__device__ __forceinline__ int fresh_lane() { int lane; asm volatile("v_mbcnt_lo_u32_b32 %0, -1, 0\n\tv_mbcnt_hi_u32_b32 %0, -1, %0" : "=v"(lane)); return lane; }
typedef float f32x2p __attribute__((ext_vector_type(2)));
typedef __bf16 bf16x2p __attribute__((ext_vector_type(2)));
__device__ __forceinline__ unsigned cvt_pk_bf16(float lo, float hi) { const f32x2p f = {lo, hi}; const bf16x2p b = __builtin_convertvector(f, bf16x2p); return __builtin_bit_cast(unsigned, b); }
__device__ __forceinline__ float bflo(unsigned w) { return __uint_as_float(w << 16); }
__device__ __forceinline__ float bfhi(unsigned w) { return __uint_as_float(w & 0xffff0000u); }
__device__ __forceinline__ float sigmoidf_(float x) { return __builtin_amdgcn_rcpf(1.0f + __expf(-x)); }

__device__ __forceinline__ void ssq_put(float* ssq, int row, int slot, float part, int lane_) {
    part += __int_as_float(__builtin_amdgcn_ds_bpermute((lane_ ^ 16) << 2, __float_as_int(part)));
    part += __int_as_float(__builtin_amdgcn_ds_bpermute((lane_ ^ 32) << 2, __float_as_int(part)));
    if (lane_ < 16) ssq[(size_t)row * 16 + slot] = part;
}
__device__ __forceinline__ float ssq_rs(const float* ssq, int row) {
    const f32x4* p = (const f32x4*)(ssq + (size_t)row * 16); const f32x4 a = p[0], b = p[1], c = p[2], d = p[3];
    const float t = (((a[0] + a[1]) + (a[2] + a[3])) + ((b[0] + b[1]) + (b[2] + b[3]))) + (((c[0] + c[1]) + (c[2] + c[3])) + ((d[0] + d[1]) + (d[2] + d[3])));
    return __builtin_amdgcn_rsqf(t * (1.0f / 1024.0f) + 1e-6f);
}
__device__ __forceinline__ float ssq_ms(const float* ssq, int row) {
    const f32x4* p = (const f32x4*)(ssq + (size_t)row * 16); const f32x4 a = p[0], b = p[1], c = p[2], d = p[3];
    const float t = (((a[0] + a[1]) + (a[2] + a[3])) + ((b[0] + b[1]) + (b[2] + b[3]))) + (((c[0] + c[1]) + (c[2] + c[3])) + ((d[0] + d[1]) + (d[2] + d[3])));
    return t * (1.0f / 1024.0f) + 1e-6f;
}
struct EpiWin {
    static constexpr bool PERM = true, AFTER_DRAIN = false;
    bf16_t* O; int ldc; const float* ssq; int gate_pn; float* kmp; int kpn;
    __device__ __forceinline__ void operator()(const f32x4 (&acc)[2][2][4][2], const Unit& u, int wr, int wc, int, int) const {
        const int lane_ = fresh_lane(), fr = lane_ & 15, fq = lane_ >> 4;
        const int row0 = u.pm * BM + wr * 64 + fr, col0 = u.pn * BM + wc * 32 + 8 * fq; const bool gt = u.pn >= gate_pn;
        const bool km = (u.pn == kpn); float cs[2][8];
#pragma unroll
        for (int b_ = 0; b_ < 2; ++b_)
#pragma unroll
            for (int k_ = 0; k_ < 8; ++k_) cs[b_][k_] = 0.f;
#pragma unroll
        for (int ai = 0; ai < 2; ++ai)
#pragma unroll
            for (int m = 0; m < 4; ++m) { const int r = row0 + ai * HALF + m * 16; bf16_t* rowp = O + (size_t)r * ldc;
                const float rs = ssq ? ssq_rs(ssq, r) : 1.0f;
#pragma unroll
                for (int bj = 0; bj < 2; ++bj) { const f32x4 v0 = acc[ai][bj][m][0] * rs, v1 = acc[ai][bj][m][1] * rs;
                    if (km) { cs[bj][0] += v0[0]; cs[bj][1] += v0[1]; cs[bj][2] += v0[2]; cs[bj][3] += v0[3]; cs[bj][4] += v1[0]; cs[bj][5] += v1[1]; cs[bj][6] += v1[2]; cs[bj][7] += v1[3]; }
                    if (gt) { u32x2 w; { int t_ = 0; t_ = __builtin_amdgcn_cvt_pk_fp8_f32(v0[0], v0[1], t_, false); t_ = __builtin_amdgcn_cvt_pk_fp8_f32(v0[2], v0[3], t_, true); w.x = (unsigned)t_; }
                        { int t_ = 0; t_ = __builtin_amdgcn_cvt_pk_fp8_f32(v1[0], v1[1], t_, false); t_ = __builtin_amdgcn_cvt_pk_fp8_f32(v1[2], v1[3], t_, true); w.y = (unsigned)t_; }
                        *(u32x2*)((unsigned char*)rowp + 512 * gate_pn + (col0 - BM * gate_pn) + bj * HALF) = w; }
                    else { u32x4 w; w.x = cvt_pk_bf16(v0[0], v0[1]); w.y = cvt_pk_bf16(v0[2], v0[3]); w.z = cvt_pk_bf16(v1[0], v1[1]); w.w = cvt_pk_bf16(v1[2], v1[3]);
                        *(u32x4*)(rowp + col0 + bj * HALF) = w; } } }
        if (km) {
#pragma unroll
            for (int b_ = 0; b_ < 2; ++b_)
#pragma unroll
                for (int k_ = 0; k_ < 8; ++k_) { float x = cs[b_][k_];
#pragma unroll
                    for (int o_ = 1; o_ < 16; o_ <<= 1) x += __int_as_float(__builtin_amdgcn_ds_bpermute((lane_ ^ o_) << 2, __float_as_int(x)));
                    cs[b_][k_] = x; }
            if (fr == 0) { float* kp = kmp + ((size_t)u.pm * 2 + wr) * 256 + wc * 32 + 8 * fq;
#pragma unroll
                for (int b_ = 0; b_ < 2; ++b_) { *(f32x4*)(kp + b_ * HALF) = (f32x4){cs[b_][0], cs[b_][1], cs[b_][2], cs[b_][3]}; *(f32x4*)(kp + b_ * HALF + 4) = (f32x4){cs[b_][4], cs[b_][5], cs[b_][6], cs[b_][7]}; } }
        }
    }
};
struct EpiMerge {
    static constexpr bool PERM = true, AFTER_DRAIN = false;
    const bf16_t* U; int ldu, gcol0; bf16_t* O; int ldc; const PG8_LAS float* slut;
    __device__ __forceinline__ void operator()(const f32x4 (&acc)[2][2][4][2], const Unit& u, int wr, int wc, int, int) const {
        const int lane_ = fresh_lane(), fr = lane_ & 15, fq = lane_ >> 4;
        const int row0 = u.pm * BM + wr * 64 + fr, col0 = u.pn * BM + wc * 32 + 8 * fq;
        typedef float f32x2g __attribute__((ext_vector_type(2)));
        const __amdgpu_buffer_rsrc_t rsrc = __builtin_amdgcn_make_buffer_rsrc((void*)O, 0, 0x7fffffff, 0x00020000);
#pragma unroll
        for (int ai = 0; ai < 2; ++ai) {
            u32x2 gq[4][2]; u32x4 pq[4][2];
#pragma unroll
            for (int m = 0; m < 4; ++m) { const size_t r = (size_t)(row0 + ai * HALF + m * 16); const unsigned char* gp = (const unsigned char*)(U + r * ldu) + 2 * gcol0 + u.e * 1024 + col0; const bf16_t* rowp = O + r * ldc + col0;
#pragma unroll
                for (int bj = 0; bj < 2; ++bj) { gq[m][bj] = *(const u32x2*)(gp + bj * HALF); if (u.e != 0) pq[m][bj] = __builtin_bit_cast(u32x4, __builtin_amdgcn_raw_buffer_load_b128(rsrc, (int)((r * ldc + col0 + bj * HALF) * 2), 0, 16  )); else pq[m][bj] = (u32x4){0u, 0u, 0u, 0u}; } }
#pragma unroll
            for (int m = 0; m < 4; ++m) { const size_t r = (size_t)(row0 + ai * HALF + m * 16); bf16_t* rowp = O + r * ldc + col0;
#pragma unroll
                for (int bj = 0; bj < 2; ++bj) { const f32x4 a0 = acc[ai][bj][m][0], a1 = acc[ai][bj][m][1]; const u32x2 g = gq[m][bj]; const u32x4 p = pq[m][bj];
                    const float s0 = slut[g.x & 0xffu], s1 = slut[(g.x >> 8) & 0xffu], s2 = slut[(g.x >> 16) & 0xffu], s3 = slut[g.x >> 24], s4 = slut[g.y & 0xffu], s5 = slut[(g.y >> 8) & 0xffu], s6 = slut[(g.y >> 16) & 0xffu], s7 = slut[g.y >> 24];
                    const float v0 = a0[0] * s0 + bflo(p.x), v1 = a0[1] * s1 + bfhi(p.x), v2 = a0[2] * s2 + bflo(p.y), v3 = a0[3] * s3 + bfhi(p.y);
                    const float v4 = a1[0] * s4 + bflo(p.z), v5 = a1[1] * s5 + bfhi(p.z), v6 = a1[2] * s6 + bflo(p.w), v7 = a1[3] * s7 + bfhi(p.w);
                    u32x4 w; w.x = cvt_pk_bf16(v0, v1); w.y = cvt_pk_bf16(v2, v3); w.z = cvt_pk_bf16(v4, v5); w.w = cvt_pk_bf16(v6, v7);
                    *(u32x4*)(rowp + bj * HALF) = w; } }
        }
    }
};
struct EpiRes {
    static constexpr bool PERM = true, AFTER_DRAIN = false;
    const float* base; const bf16_t* bb; bf16_t* out; int ldc; float* ssq;
    __device__ __forceinline__ void operator()(const f32x4 (&acc)[2][2][4][2], const Unit& u, int wr, int wc, int, int) const {
        const int lane_ = fresh_lane(), fr = lane_ & 15, fq = lane_ >> 4;
        const int row0 = u.pm * BM + wr * 64 + fr, col0 = u.pn * BM + wc * 32 + 8 * fq;
        const __amdgpu_buffer_rsrc_t rsrc = __builtin_amdgcn_make_buffer_rsrc((void*)(bb ? bb : out), 0, 0x7fffffff, 0x00020000);
#pragma unroll
        for (int ai = 0; ai < 2; ++ai)
#pragma unroll
            for (int mh = 0; mh < 2; ++mh) {
                f32x4 b0[2][2], b1[2][2];
#pragma unroll
                for (int mm = 0; mm < 2; ++mm) { const size_t off = (size_t)(row0 + ai * HALF + (2 * mh + mm) * 16) * ldc + col0;
#pragma unroll
                    for (int bj = 0; bj < 2; ++bj) {
                        if (bb) { const u32x4 p = __builtin_bit_cast(u32x4, __builtin_amdgcn_raw_buffer_load_b128(rsrc, (int)((off + bj * HALF) * 2), 0, 16  )); b0[mm][bj] = (f32x4){bflo(p.x), bfhi(p.x), bflo(p.y), bfhi(p.y)}; b1[mm][bj] = (f32x4){bflo(p.z), bfhi(p.z), bflo(p.w), bfhi(p.w)}; }
                        else { b0[mm][bj] = *(const f32x4*)(base + off + bj * HALF); b1[mm][bj] = *(const f32x4*)(base + off + bj * HALF + 4); } } }
#pragma unroll
                for (int mm = 0; mm < 2; ++mm) { const int m = 2 * mh + mm; const size_t off = (size_t)(row0 + ai * HALF + m * 16) * ldc + col0; float sq = 0.f;
#pragma unroll
                    for (int bj = 0; bj < 2; ++bj) { const f32x4 v0 = acc[ai][bj][m][0] + b0[mm][bj], v1 = acc[ai][bj][m][1] + b1[mm][bj];
                        sq += (v0[0] * v0[0] + v0[1] * v0[1]) + (v0[2] * v0[2] + v0[3] * v0[3]) + (v1[0] * v1[0] + v1[1] * v1[1]) + (v1[2] * v1[2] + v1[3] * v1[3]);
                        u32x4 w; w.x = cvt_pk_bf16(v0[0], v0[1]); w.y = cvt_pk_bf16(v0[2], v0[3]); w.z = cvt_pk_bf16(v1[0], v1[1]); w.w = cvt_pk_bf16(v1[2], v1[3]);
                        *(u32x4*)(out + off + bj * HALF) = w; }
                    if (ssq) ssq_put(ssq, row0 + ai * HALF + m * 16, u.pn * 4 + wc, sq, lane_); }
            }
    }
};
__device__ __forceinline__ unsigned cvt4_fp8(float a, float b, float c, float d) { int w = 0; w = __builtin_amdgcn_cvt_pk_fp8_f32(a, b, w, false); w = __builtin_amdgcn_cvt_pk_fp8_f32(c, d, w, true); return (unsigned)w; }
__device__ __forceinline__ u32x4 pair16(u32x2 wa, u32x2 wb) {
    typedef unsigned u2_ __attribute__((ext_vector_type(2)));
    const u2_ s0 = __builtin_amdgcn_permlane16_swap(wa.x, wb.x, false, false), s1 = __builtin_amdgcn_permlane16_swap(wa.y, wb.y, false, false);
    return (u32x4){s0.x, s1.x, s0.y, s1.y};
}
struct EpiSwiGLU {
    static constexpr bool PERM = true, AFTER_DRAIN = false;
    bf16_t* T; int ldt; const float* ssq; int f8;
    __device__ __forceinline__ void calc(const f32x4 (&acc)[2][2][4][2], int ai, int m, int r, float (&v)[8]) const {
        const float q = ssq ? ssq_ms(ssq, r) : 1.0f; const float nk = -1.44269504f * __builtin_amdgcn_rsqf(q);
        const float qd = f8 ? 0.25f * q : q; const f32x2p nk2 = {nk, nk}, q2 = {qd, qd};
#pragma unroll
        for (int n = 0; n < 2; ++n)
#pragma unroll
            for (int h = 0; h < 2; ++h) { const f32x2p a2 = {acc[ai][0][m][n][2 * h], acc[ai][0][m][n][2 * h + 1]}, b2 = {acc[ai][1][m][n][2 * h], acc[ai][1][m][n][2 * h + 1]};
                const f32x2p x2 = a2 * nk2; const f32x2p e2 = {__builtin_amdgcn_exp2f(x2[0]), __builtin_amdgcn_exp2f(x2[1])};
                const f32x2p d2 = e2 * q2 + q2; const f32x2p r2 = {__builtin_amdgcn_rcpf(d2[0]), __builtin_amdgcn_rcpf(d2[1])};
                const f32x2p v2 = (a2 * b2) * r2; v[n * 4 + 2 * h] = v2[0]; v[n * 4 + 2 * h + 1] = v2[1]; }
    }
    __device__ __forceinline__ void operator()(const f32x4 (&acc)[2][2][4][2], const Unit& u, int wr, int wc, int, int) const {
        const int lane_ = fresh_lane(), fr = lane_ & 15, fq = lane_ >> 4;
        const int row0 = u.pm * BM + wr * 64 + fr, col0 = u.pn * HALF + wc * 32 + 8 * fq;
#pragma unroll
        for (int ai = 0; ai < 2; ++ai)
#pragma unroll
            for (int mp = 0; mp < 2; ++mp) { const int ra = row0 + ai * HALF + (2 * mp) * 16, rb = ra + 16; float va[8], vb[8];
                calc(acc, ai, 2 * mp, ra, va); calc(acc, ai, 2 * mp + 1, rb, vb);
                if (f8) {
                    u32x2 wa, wb; wa.x = cvt4_fp8(va[0], va[1], va[2], va[3]); wa.y = cvt4_fp8(va[4], va[5], va[6], va[7]); wb.x = cvt4_fp8(vb[0], vb[1], vb[2], vb[3]); wb.y = cvt4_fp8(vb[4], vb[5], vb[6], vb[7]);
                    const u32x4 w16 = pair16(wa, wb);
                    *(u32x4*)((unsigned char*)T + (size_t)((fq & 1) ? rb : ra) * ldt + u.pn * HALF + wc * 32 + 8 * (fq & 2)) = w16; }
                else { u32x4 w; w.x = cvt_pk_bf16(va[0], va[1]); w.y = cvt_pk_bf16(va[2], va[3]); w.z = cvt_pk_bf16(va[4], va[5]); w.w = cvt_pk_bf16(va[6], va[7]); *(u32x4*)(T + (size_t)ra * ldt + col0) = w;
                    w.x = cvt_pk_bf16(vb[0], vb[1]); w.y = cvt_pk_bf16(vb[2], vb[3]); w.z = cvt_pk_bf16(vb[4], vb[5]); w.w = cvt_pk_bf16(vb[6], vb[7]); *(u32x4*)(T + (size_t)rb * ldt + col0) = w; } }
    }
};
struct EpiSwiGLU8 {
    static constexpr bool PERM = true, AFTER_DRAIN = false;
    unsigned char* T; int ldt; float cc, lc;
    __device__ __forceinline__ u32x2 calc(const f32x4 (&acc)[2][2][4][2], int ai, int m) const {
        float v[8];
        const f32x2p nk2 = {-1.44269504f * 0.03125f, -1.44269504f * 0.03125f}, l2 = {lc, lc}, c2 = {cc, cc};
#pragma unroll
        for (int n = 0; n < 2; ++n)
#pragma unroll
            for (int h = 0; h < 2; ++h) { const f32x2p a2 = {acc[ai][0][m][n][2 * h], acc[ai][0][m][n][2 * h + 1]}, b2 = {acc[ai][1][m][n][2 * h], acc[ai][1][m][n][2 * h + 1]};
                const f32x2p x2 = a2 * nk2 + l2; const f32x2p e2 = {__builtin_amdgcn_exp2f(x2[0]), __builtin_amdgcn_exp2f(x2[1])};
                const f32x2p d2 = e2 + c2; const f32x2p r2 = {__builtin_amdgcn_rcpf(d2[0]), __builtin_amdgcn_rcpf(d2[1])};
                const f32x2p v2 = (a2 * b2) * r2; v[n * 4 + 2 * h] = v2[0]; v[n * 4 + 2 * h + 1] = v2[1]; }
        u32x2 w; w.x = cvt4_fp8(v[0], v[1], v[2], v[3]); w.y = cvt4_fp8(v[4], v[5], v[6], v[7]); return w;
    }
    __device__ __forceinline__ void operator()(const f32x4 (&acc)[2][2][4][2], const Unit& u, int wr, int wc, int, int) const {
        const int lane_ = fresh_lane(), fr = lane_ & 15, fq = lane_ >> 4;
        const int row0 = u.prow * BM + wr * 64 + fr;
#pragma unroll
        for (int ai = 0; ai < 2; ++ai)
#pragma unroll
            for (int mp = 0; mp < 2; ++mp) {
                const u32x4 w16 = pair16(calc(acc, ai, 2 * mp), calc(acc, ai, 2 * mp + 1));
                *(u32x4*)(T + (size_t)(row0 + ai * HALF + (2 * mp + (fq & 1)) * 16) * ldt + u.pn * HALF + wc * 32 + 8 * (fq & 2)) = w16; }
    }
};
struct EpiGate8 {
    static constexpr bool PERM = true, AFTER_DRAIN = false;
    unsigned char* O; int ldo, goff; const float* ssq;
    __device__ __forceinline__ void operator()(const f32x4 (&acc)[2][2][4][2], const Unit& u, int wr, int wc, int, int) const {
        const int lane_ = fresh_lane(), fr = lane_ & 15, fq = lane_ >> 4;
        const int row0 = u.pm * BM + wr * 64 + fr;
#pragma unroll
        for (int ai = 0; ai < 2; ++ai)
#pragma unroll
            for (int m = 0; m < 4; ++m) { const int r = row0 + ai * HALF + m * 16;
                const float rs = (ssq ? ssq_rs(ssq, r) : 1.0f) * 0.03125f;
                u32x2 w[2];
#pragma unroll
                for (int bj = 0; bj < 2; ++bj) { const f32x4 v0 = acc[ai][bj][m][0] * rs, v1 = acc[ai][bj][m][1] * rs; w[bj].x = cvt4_fp8(v0[0], v0[1], v0[2], v0[3]); w[bj].y = cvt4_fp8(v1[0], v1[1], v1[2], v1[3]); }
                *(u32x4*)(O + (size_t)r * ldo + goff + u.pn * BM + (fq & 1) * HALF + wc * 32 + 8 * (fq & 2)) = pair16(w[0], w[1]); }
    }
};
struct EpiScatter {
    static constexpr bool PERM = true, AFTER_DRAIN = false;
    bf16_t* R; int ldc; const int* tok; const float* gate; float scale; float* ssq; unsigned char* r8; bf16_t* Z; int ldz;
    __device__ __forceinline__ void operator()(const f32x4 (&acc)[2][2][4][2], const Unit& u, int wr, int wc, int, int) const {
        const int lane_ = fresh_lane(), fr = lane_ & 15, fq = lane_ >> 4;
        const int row0 = u.prow * BM + wr * 64 + fr, col0 = u.pn * BM + wc * 32 + 8 * fq;
        if (Z) {
#pragma unroll
            for (int ai = 0; ai < 2; ++ai)
#pragma unroll
                for (int m = 0; m < 4; ++m) { const int r = row0 + ai * HALF + m * 16; const int t = tok[r]; const float g = gate[r] * scale;
                    if (t >= 0) { bf16_t* zp = Z + (size_t)t * ldz + u.second * 1024 + col0;
#pragma unroll
                        for (int bj = 0; bj < 2; ++bj) { const f32x4 a0 = acc[ai][bj][m][0] * g, a1 = acc[ai][bj][m][1] * g;
                            u32x4 w; w.x = cvt_pk_bf16(a0[0], a0[1]); w.y = cvt_pk_bf16(a0[2], a0[3]); w.z = cvt_pk_bf16(a1[0], a1[1]); w.w = cvt_pk_bf16(a1[2], a1[3]);
                            *(u32x4*)(zp + bj * HALF) = w; } } }
            return; }
        const __amdgpu_buffer_rsrc_t rsrc = __builtin_amdgcn_make_buffer_rsrc((void*)R, 0, 0x7fffffff, 0x00020000);
        int tk[2][4]; float gg[2][4];
#pragma unroll
        for (int ai = 0; ai < 2; ++ai)
#pragma unroll
            for (int m = 0; m < 4; ++m) { const int r = row0 + ai * HALF + m * 16; tk[ai][m] = tok ? tok[r] : r; gg[ai][m] = tok ? gate[r] * scale : scale; }
#pragma unroll
        for (int ai = 0; ai < 2; ++ai) {
            u32x4 pq[4][2];
#pragma unroll
            for (int m = 0; m < 4; ++m) { const int t = tk[ai][m] < 0 ? 0 : tk[ai][m]; const bf16_t* rp = R + (size_t)t * ldc + col0;
#pragma unroll
                for (int bj = 0; bj < 2; ++bj) pq[m][bj] = __builtin_bit_cast(u32x4, __builtin_amdgcn_raw_buffer_load_b128(rsrc, (int)(((size_t)t * ldc + col0 + bj * HALF) * 2), 0, 16  )); (void)rp; }
#pragma unroll
            for (int m = 0; m < 4; ++m) { const int t = tk[ai][m]; const float g = gg[ai][m];
                if (t >= 0) { bf16_t* rp = R + (size_t)t * ldc + col0; float sq = 0.f;
#pragma unroll
                    for (int bj = 0; bj < 2; ++bj) { const u32x4 p = pq[m][bj]; const f32x4 a0 = acc[ai][bj][m][0] * g, a1 = acc[ai][bj][m][1] * g;
                        const float e0 = bflo(p.x) + a0[0], e1 = bfhi(p.x) + a0[1], e2 = bflo(p.y) + a0[2], e3 = bfhi(p.y) + a0[3], e4 = bflo(p.z) + a1[0], e5 = bfhi(p.z) + a1[1], e6 = bflo(p.w) + a1[2], e7 = bfhi(p.w) + a1[3];
                        sq += (e0 * e0 + e1 * e1) + (e2 * e2 + e3 * e3) + (e4 * e4 + e5 * e5) + (e6 * e6 + e7 * e7);
                        u32x4 w; w.x = cvt_pk_bf16(e0, e1); w.y = cvt_pk_bf16(e2, e3); w.z = cvt_pk_bf16(e4, e5); w.w = cvt_pk_bf16(e6, e7);
                        *(u32x4*)(rp + bj * HALF) = w;
                        if (r8) { u32x2 w8; w8.x = cvt4_fp8(e0, e1, e2, e3); w8.y = cvt4_fp8(e4, e5, e6, e7); *(u32x2*)(r8 + (size_t)t * 1024 + col0 + bj * HALF) = w8; } }
                    if (ssq) ssq_put(ssq, row0 + ai * HALF + m * 16, u.pn * 4 + wc, sq, lane_); } }
        }
    }
};

template <class Epi, class Sched, bool ALIGN_EPI = false, bool FP8 = false>
__device__ __forceinline__ void gemm_phase(PG8_LAS unsigned char* lds, const int tid, const Gemm g, const Sched& S, const Epi& E) {
    const int wid = __builtin_amdgcn_readfirstlane(tid >> 6), lane = tid & 63, wr = wid >> 2, wc = wid & 3, fr = lane & 15, fq = lane >> 4;
    const int K = g.K, nt = K / BK;
    unsigned voffA, voffB;
    { int R, C; stage_rc(tid * 16, R, C); const int Rb = Epi::PERM ? ((R & ~31) + perm32(R & 31)) : R;
      voffA = (unsigned)(R * g.lda + C) * 2u; voffB = (unsigned)(Rb * g.ldb + C) * 2u; }
    const size_t rstepA = (size_t)64 * g.lda * 2, rstepB = (size_t)64 * g.ldb * 2;
    const size_t kstep = (size_t)(BK * 2);
    const size_t hstepA = (size_t)HALF * g.lda * 2, hstepB = (size_t)HALF * g.ldb * 2;
    const unsigned ldsw = (unsigned)wid * 1024u;
    const int aoff = lds_byte(wr * 64 + fr, fq * 8), boff = lds_byte(wc * 32 + fr, fq * 8);
#define PG8_SA(b, h) (((b) * 2 + (h)) * HTB)
#define PG8_SB(b, h) ((4 + (b) * 2 + (h)) * HTB)
#define PG8_STAGE(bufoff, gbase, voff) do { _Pragma("unroll") for (int _i = 0; _i < 2; ++_i) { const char* gb_ = (const char*)(gbase) + (size_t)_i * rstep##voff; asm volatile("" : "+s"(gb_));     \
        __builtin_amdgcn_global_load_lds((const unsigned*)(gb_ + (voff)), (PG8_LAS unsigned*)(lds + (bufoff) + ldsw + _i * 8192), 16, 0, 0); } } while (0)
#define rstepvoffA rstepA
#define rstepvoffB rstepB
#define PG8_LDA(dst, b, h) do { if constexpr (FP8) { _Pragma("unroll") for (int m = 0; m < 4; ++m) dst##8[m] = __builtin_shufflevector(*(const PG8_LAS i32x4*)(lds + PG8_SA(b, h) + aoff + m * 2048), *(const PG8_LAS i32x4*)(lds + PG8_SA(b, h) + aoff + m * 2048 + 1024), 0, 1, 2, 3, 4, 5, 6, 7); } \
        else { _Pragma("unroll") for (int m = 0; m < 4; ++m) _Pragma("unroll") for (int k = 0; k < 2; ++k) dst[m][k] = *(const PG8_LAS bf16x8*)(lds + PG8_SA(b, h) + aoff + m * 2048 + k * 1024); } } while (0)
#define PG8_LDB(dst, b, h) do { if constexpr (FP8) { _Pragma("unroll") for (int n = 0; n < 2; ++n) dst##8[n] = __builtin_shufflevector(*(const PG8_LAS i32x4*)(lds + PG8_SB(b, h) + boff + n * 2048), *(const PG8_LAS i32x4*)(lds + PG8_SB(b, h) + boff + n * 2048 + 1024), 0, 1, 2, 3, 4, 5, 6, 7); } \
        else { _Pragma("unroll") for (int n = 0; n < 2; ++n) _Pragma("unroll") for (int k = 0; k < 2; ++k) dst[n][k] = *(const PG8_LAS bf16x8*)(lds + PG8_SB(b, h) + boff + n * 2048 + k * 1024); } } while (0)
#define PG8_MMA(ai, bj, At, Bt) do { __builtin_amdgcn_s_setprio(1); \
        if constexpr (FP8) { _Pragma("unroll") for (int m = 0; m < 4; ++m) _Pragma("unroll") for (int n = 0; n < 2; ++n) \
            acc[ai][bj][m][n] = __builtin_amdgcn_mfma_scale_f32_16x16x128_f8f6f4(Bt##8[n], At##8[m], acc[ai][bj][m][n], 0, 0, 0, 0x7f7f7f7f, 0, 0x7f7f7f7f); } \
        else { _Pragma("unroll") for (int m = 0; m < 4; ++m) _Pragma("unroll") for (int n = 0; n < 2; ++n) _Pragma("unroll") for (int k = 0; k < 2; ++k) \
            acc[ai][bj][m][n] = __builtin_amdgcn_mfma_f32_16x16x32_bf16(Bt[n][k], At[m][k], acc[ai][bj][m][n], 0, 0, 0); } \
        __builtin_amdgcn_s_setprio(0); } while (0)
#define PG8_WAIT_V(n) asm volatile("s_waitcnt vmcnt(" #n ")" ::: "memory")
#define PG8_WAIT_L(n) asm volatile("s_waitcnt lgkmcnt(" #n ")" ::: "memory")
#define PG8_BAR __builtin_amdgcn_s_barrier()
#define PG8_SCHED __builtin_amdgcn_sched_barrier(0)
    Unit cur, nxt; int ui = 0;
    if (!S.next(0, cur)) return;
    f32x4 acc[2][2][4][2];
#pragma unroll
    for (int a = 0; a < 2; ++a)
#pragma unroll
        for (int b = 0; b < 2; ++b)
#pragma unroll
            for (int m = 0; m < 4; ++m)
#pragma unroll
                for (int n = 0; n < 2; ++n) acc[a][b][m][n] = (f32x4){0.f, 0.f, 0.f, 0.f};
    bf16x8 At[4][2], B0[2][2], B1[2][2]; i32x8 At8[4], B08[2], B18[2];
    const char* cA = (const char*)g.A + cur.aoff; const char* cB = (const char*)g.Bt + cur.boff;
    S.a_ready(cur);
    PG8_STAGE(PG8_SB(0, 0), cB, voffB); PG8_STAGE(PG8_SB(0, 1), cB + hstepB, voffB); PG8_STAGE(PG8_SA(0, 0), cA, voffA); PG8_STAGE(PG8_SA(0, 1), cA + hstepA, voffA);
    if (wr == 1) PG8_BAR;
    PG8_WAIT_V(2); PG8_BAR;
    PG8_STAGE(PG8_SB(1, 0), cB + kstep, voffB); PG8_STAGE(PG8_SA(1, 0), cA + kstep, voffA); PG8_STAGE(PG8_SB(1, 1), cB + hstepB + kstep, voffB);
    PG8_WAIT_V(6); PG8_BAR;
    for (;;) {
        const bool has_next = S.next(ui + 1, nxt);
        const char* nA = has_next ? (const char*)g.A + nxt.aoff : cA; const char* nB = has_next ? (const char*)g.Bt + nxt.boff : cB;
#pragma unroll 1
        for (int t = 0; t < nt; t += 2) {
            const bool last = (t == nt - 2);
            const char* a1 = cA + (size_t)(t + 1) * kstep;
            const char* a2 = last ? nA : cA + (size_t)(t + 2) * kstep; const char* b2 = last ? nB : cB + (size_t)(t + 2) * kstep;
            const char* a3 = a2 + kstep; const char* b3 = b2 + kstep;
            if (last && has_next) S.a_ready(nxt);
            PG8_LDB(B0, 0, 0); PG8_LDB(B1, 0, 1); PG8_SCHED; PG8_LDA(At, 0, 0); PG8_STAGE(PG8_SA(1, 1), a1 + hstepA, voffA);
            PG8_WAIT_V(8); PG8_WAIT_L(0); PG8_BAR; PG8_MMA(0, 0, At, B0); PG8_MMA(0, 1, At, B1); PG8_BAR; PG8_SCHED;
            PG8_LDA(At, 0, 1); PG8_STAGE(PG8_SB(0, 0), b2, voffB); PG8_STAGE(PG8_SB(0, 1), b2 + hstepB, voffB); PG8_STAGE(PG8_SA(0, 0), a2, voffA);
            PG8_WAIT_V(8); PG8_WAIT_L(0); PG8_BAR; PG8_MMA(1, 0, At, B0); PG8_MMA(1, 1, At, B1); PG8_BAR; PG8_SCHED;
            PG8_LDB(B0, 1, 0); PG8_LDB(B1, 1, 1); PG8_SCHED; PG8_LDA(At, 1, 0); PG8_STAGE(PG8_SA(0, 1), a2 + hstepA, voffA);
            PG8_WAIT_V(8); PG8_WAIT_L(0); PG8_BAR; PG8_MMA(0, 0, At, B0); PG8_MMA(0, 1, At, B1); PG8_BAR; PG8_SCHED;
            PG8_LDA(At, 1, 1); PG8_STAGE(PG8_SB(1, 0), b3, voffB); PG8_STAGE(PG8_SB(1, 1), b3 + hstepB, voffB); PG8_STAGE(PG8_SA(1, 0), a3, voffA);
            PG8_WAIT_V(8); PG8_WAIT_L(0); PG8_BAR; PG8_MMA(1, 0, At, B0); PG8_MMA(1, 1, At, B1); PG8_BAR; PG8_SCHED;
        }
        if constexpr (ALIGN_EPI) { if (wr == 0) PG8_BAR; }
        E(acc, cur, wr, wc, fr, fq); S.done(cur);
        if (!has_next) break;
#pragma unroll
        for (int a = 0; a < 2; ++a)
#pragma unroll
            for (int b = 0; b < 2; ++b)
#pragma unroll
                for (int m = 0; m < 4; ++m)
#pragma unroll
                    for (int n = 0; n < 2; ++n) acc[a][b][m][n] = (f32x4){0.f, 0.f, 0.f, 0.f};
        cur = nxt; cA = nA; cB = nB; ++ui;
        if constexpr (ALIGN_EPI) { if (wr == 1) PG8_BAR; }
    }
    PG8_WAIT_V(0);
    if constexpr (!ALIGN_EPI) { if (wr == 0) PG8_BAR; }
    PG8_BAR;
#undef PG8_SA
#undef PG8_SB
#undef PG8_STAGE
#undef rstepvoffA
#undef rstepvoffB
#undef PG8_LDA
#undef PG8_LDB
#undef PG8_MMA
#undef PG8_WAIT_V
#undef PG8_WAIT_L
#undef PG8_BAR
#undef PG8_SCHED
}
}

constexpr int NB = 32, SEQ = 2048, D = 1024, M = NB * SEQ;
constexpr int WIN = 6656, GCOL0 = 2560;
constexpr int UST = 4608;
constexpr int FF0 = 2816, FFE = 3584, NEXP = 8;
constexpr int HROWS = M / 2, HB = NB / 2;
constexpr int CAPROWS = M + NEXP * 256, CAPT = CAPROWS / 256;
constexpr float RMS_EPS = 1e-6f, SUBLN_EPS = 1e-5f;
constexpr int NWAVES = 8;
constexpr int C_QA = 0, C_KA = 256, C_VA = 512, C_XB = 768, C_BB = 1024, C_CB = 1280, C_PC = 1536, C_QD = 1792, C_KD = 2048, C_VD = 2304;

constexpr size_t MiB = 1u << 20;
constexpr size_t WS_CTL = 0, CTL_ZERO_BYTES = 1 * MiB;
constexpr size_t WS_ROUTE = 2 * MiB;
constexpr size_t WS_TOK = 4 * MiB;
constexpr size_t WS_GATE = 5 * MiB;
constexpr size_t WS_TILEE = 6 * MiB;
constexpr size_t WS_KMEAN = 7 * MiB;
constexpr size_t WS_WIN = 8 * MiB;
constexpr size_t WS_WG8 = 24 * MiB;
constexpr size_t WS_BP = 34 * MiB;
constexpr size_t WS_WOUT = 38 * MiB;
constexpr size_t WS_W13D = 42 * MiB;
constexpr size_t WS_W2D = 53 * MiB;
constexpr size_t WS_W13E = 60 * MiB;
constexpr size_t WS_W2E = 116 * MiB;
constexpr size_t WS_R = 144 * MiB;
constexpr size_t WS_H = 272 * MiB;
constexpr size_t WS_U = 400 * MiB;
constexpr size_t WS_A8 = 752 * MiB;
constexpr size_t WS_Y = 816 * MiB;
constexpr size_t WS_MG = 880 * MiB;
constexpr size_t WS_HPERM = 272 * MiB;
constexpr size_t WS_TE = 404 * MiB;
constexpr size_t WS_END = 952 * MiB;
static_assert(WS_W13E + (size_t)8 * 2 * FFE * D <= WS_W2E && WS_W2E + (size_t)8 * D * FFE <= WS_R && WS_U + (size_t)HROWS * UST * 2 <= WS_A8 && WS_A8 + (size_t)M * D <= WS_Y && WS_HPERM + 2 * (size_t)CAPROWS * D <= WS_TE && WS_TE + 2 * (size_t)CAPROWS * FFE <= WS_END - 8 * MiB && WS_U + (size_t)M * FF0 * 2 <= WS_A8 && WS_MG + (size_t)HROWS * D * 2 <= WS_END, "d_ws map");
constexpr int CW_BAR = 4096;
constexpr int CW_QUEUE = 16384;
constexpr int CW_CNT = 20480;
constexpr size_t SSQ0_OFF = 944 * MiB, SSQ1_OFF = 948 * MiB;

constexpr int RING_BYTES = 131072;
constexpr int LUT_OFF = RING_BYTES;
constexpr int LUT_N = 320, LUT_NEG = 96;
constexpr int SLUT_OFF = LUT_OFF + 8 * LUT_N * 4;
constexpr int LDSCTL_OFF = RING_BYTES + 12288, MISC_OFF = LDSCTL_OFF + 320;
constexpr int LDS_BYTES = 147456;

#define GAS __attribute__((address_space(1)))
#define LAS __attribute__((address_space(3)))
typedef unsigned short bf16;
typedef unsigned v4u __attribute__((ext_vector_type(4)));
typedef unsigned v2u __attribute__((ext_vector_type(2)));
typedef float f32x4 __attribute__((ext_vector_type(4)));
typedef GAS unsigned gu32;
#define RLX_AGENT __ATOMIC_RELAXED, __HIP_MEMORY_SCOPE_AGENT
#define LDS_WAIT() asm volatile("s_waitcnt lgkmcnt(0)" ::: "memory")
#define VM_WAIT() asm volatile("s_waitcnt vmcnt(0)" ::: "memory")
__device__ __forceinline__ unsigned f2bf(float f) { unsigned u = __builtin_bit_cast(unsigned, f); return (u + 0x7fffu + ((u >> 16) & 1u)) >> 16; }
__device__ __forceinline__ unsigned pk2(float lo, float hi) { return f2bf(lo) | (f2bf(hi) << 16); }
__device__ __forceinline__ float bflo(unsigned w) { return __uint_as_float(w << 16); }
__device__ __forceinline__ float bfhi(unsigned w) { return __uint_as_float(w & 0xffff0000u); }

#define XB_TMO      128
#define XB_XCNT(j)  (256  + 64 * (j))
#define XB_XSUB(j)  (1280 + 64 * (j))
#define XB_XGEN(j)  (2304 + 64 * (j))
#define XB_TOP      3328
#define XB_TOPGEN   3392
#define XCD_BAR_WORDS 3456
#define XB_SPIN_CAP (1u << 22)

__device__ __forceinline__ unsigned xb_ld(unsigned* p)              { return __hip_atomic_load(p, __ATOMIC_RELAXED, __HIP_MEMORY_SCOPE_AGENT); }
__device__ __forceinline__ unsigned xb_add(unsigned* p, unsigned v) { return __hip_atomic_fetch_add(p, v, __ATOMIC_RELAXED, __HIP_MEMORY_SCOPE_AGENT); }
__device__ __forceinline__ unsigned xb_xcc_id() { return (unsigned)__builtin_amdgcn_s_getreg((3 << 11) | 20) & 0xFu; }
#define XB_SPIN(cond, bar) do { unsigned _sp = 0; while (cond) { __builtin_amdgcn_s_sleep(1); \
    if ((++_sp & 255u) == 0u) { if (xb_ld(&(bar)[XB_TMO])) break; if (_sp > XB_SPIN_CAP) { atomicAdd(&(bar)[XB_TMO], 1u); break; } } } } while (0)

struct XcdBarrier { unsigned* bar; unsigned x; volatile LAS unsigned* st; };

__device__ __forceinline__ XcdBarrier xcd_barrier_post(unsigned* bar, volatile LAS unsigned* st) {
    XcdBarrier b; b.bar = bar; b.x = xb_xcc_id(); b.st = st;
    if (threadIdx.x == 0) (void)xb_add(&bar[XB_XCNT(b.x)], 1u);
    return b;
}
__device__ __forceinline__ void xcd_barrier_complete(unsigned* bar, unsigned x, unsigned& nloc, unsigned& nx) {
    const unsigned G = gridDim.x * gridDim.y * gridDim.z;
    unsigned sum, cnt, mine, sp = 0u;
    for (;;) {
        sum = 0u; cnt = 0u; mine = 0u;
#pragma unroll
        for (unsigned j = 0; j < 16; ++j) { const unsigned c = xb_ld(&bar[XB_XCNT(j)]); sum += c; cnt += (c > 0u) ? 1u : 0u; mine = (j == x) ? c : mine; }
        if (sum == G) break;
        __builtin_amdgcn_s_sleep(1);
        if ((++sp & 255u) == 0u) { if (xb_ld(&bar[XB_TMO])) break; if (sp > XB_SPIN_CAP) { atomicAdd(&bar[XB_TMO], 1u); break; } }
    }
    nloc = mine > 0u ? mine : 1u; nx = cnt > 0u ? cnt : 1u;
}
__device__ __forceinline__ void xcd_barrier(const XcdBarrier& b) {
    asm volatile("s_waitcnt vmcnt(0)" ::: "memory");
    __syncthreads();
    if (threadIdx.x == 0) {
        unsigned* bar = b.bar;
        __builtin_amdgcn_s_waitcnt(0);
        unsigned nloc = b.st[0], nx = b.st[1];
        if (nloc == 0u) { xcd_barrier_complete(bar, b.x, nloc, nx); b.st[0] = nloc; b.st[1] = nx; }
        const unsigned old = xb_add(&bar[XB_XSUB(b.x)], 1u);
        const unsigned gen = old / nloc;
        if (old + 1u == (gen + 1u) * nloc) {
            __builtin_amdgcn_fence(__ATOMIC_RELEASE, "agent");
            asm volatile("s_waitcnt vmcnt(0)" ::: "memory");
            const unsigned og = xb_add(&bar[XB_TOP], 1u);
            const unsigned tg = og / nx;
            if (og + 1u == (tg + 1u) * nx) xb_add(&bar[XB_TOPGEN], 1u);
            else XB_SPIN(xb_ld(&bar[XB_TOPGEN]) == tg, bar);
            __builtin_amdgcn_fence(__ATOMIC_ACQUIRE, "agent");
            xb_add(&bar[XB_XGEN(b.x)], 1u);
            asm volatile("s_waitcnt vmcnt(0)" ::: "memory");
        } else {
            XB_SPIN(xb_ld(&bar[XB_XGEN(b.x)]) == gen, bar);
            __builtin_amdgcn_fence(__ATOMIC_ACQUIRE, "agent");
            asm volatile("s_waitcnt vmcnt(0)" ::: "memory");
        }
    }
    __syncthreads();
}

__device__ __forceinline__ float wave_sum(float v, int lane) {
#pragma unroll
    for (int o = 1; o < 64; o <<= 1) v += __int_as_float(__builtin_amdgcn_ds_bpermute((lane ^ o) << 2, __float_as_int(v)));
    return v;
}
__device__ __forceinline__ void wave_sync() { asm volatile("s_waitcnt lgkmcnt(0)" ::: "memory"); __builtin_amdgcn_wave_barrier(); }

__device__ const unsigned char BKT[129] = {
    0, 1, 2, 3, 4, 5, 6, 7, 8, 9, 10, 11, 12, 13, 14, 15, 16, 16, 16, 17, 17, 18, 18, 18, 19, 19, 19, 20, 20, 20, 20, 21, 21, 21, 21, 22, 22, 22, 22, 22, 23, 23, 23, 23, 23, 23,
    24, 24, 24, 24, 24, 24, 25, 25, 25, 25, 25, 25, 25, 26, 26, 26, 26, 26, 26, 26, 26, 27, 27, 27, 27, 27, 27, 27, 27, 27, 27, 28, 28, 28, 28, 28, 28, 28, 28, 28, 28,
    29, 29, 29, 29, 29, 29, 29, 29, 29, 29, 29, 29, 30, 30, 30, 30, 30, 30, 30, 30, 30, 30, 30, 30, 30, 30, 31, 31, 31, 31, 31, 31, 31, 31, 31, 31, 31, 31, 31, 31, 31, 31 };

__device__ __forceinline__ void transpose_item(const float* W, int K, int N, bf16* WT, int row_off, int il, LAS float* scr, int item, int lane, const float* gk = nullptr, int ldw = 0) {
    if (ldw == 0) ldw = N;
    const int nblk = N / 32, kb = item / nblk, nb = item % nblk, k0 = 64 * kb, n0 = 32 * nb;
#pragma unroll 8
    for (int i = 0; i < 32; ++i) { const int kk = 2 * i + (lane >> 5); scr[kk * 33 + (lane & 31)] = __builtin_nontemporal_load(W + (size_t)(k0 + kk) * ldw + n0 + (lane & 31)) * (gk ? gk[k0 + kk] : 1.0f); }
    LDS_WAIT(); asm volatile("" ::: "memory"); __builtin_amdgcn_wave_barrier();
    const int c = lane & 7;
    const int r0 = il ? ((n0 >> 7) * 256 + row_off + (n0 & 127)) : (row_off + n0);
#pragma unroll
    for (int j = 0; j < 4; ++j) { const int n = (lane >> 3) + 8 * j; const LAS float* s = scr + (8 * c) * 33 + n;
        v4u o; o.x = pk2(s[0 * 33], s[1 * 33]); o.y = pk2(s[2 * 33], s[3 * 33]); o.z = pk2(s[4 * 33], s[5 * 33]); o.w = pk2(s[6 * 33], s[7 * 33]);
        *(GAS v4u*)(WT + (size_t)(r0 + n) * K + k0 + 8 * c) = o; }
    LDS_WAIT(); asm volatile("" ::: "memory"); __builtin_amdgcn_wave_barrier();
}


__device__ __forceinline__ int fresh_tid_w(int wave) { int lane; asm volatile("v_mbcnt_lo_u32_b32 %0, -1, 0\n\tv_mbcnt_hi_u32_b32 %0, -1, %0" : "=v"(lane)); return wave * 64 + lane; }
#define fresh_tid() fresh_tid_w(wave0)

__device__ __forceinline__ unsigned moba_mask(const bf16* u, const LAS float* kmb, int bl, int h, int qc, int lane) {
    const int t = qc * 32 + (lane & 31), own = qc >> 3;
    if (own <= 3) return (1u << own) - 1u;
    const bf16* qp = u + ((size_t)bl * SEQ + t) * UST + C_QA + h * 64;
    v4u xq[8];
#pragma unroll
    for (int i = 0; i < 8; ++i) xq[i] = *(const GAS v4u*)(qp + 8 * i);
    float gs[7];
#pragma unroll
    for (int blk = 0; blk < 7; ++blk) gs[blk] = 0.f;
#pragma unroll
    for (int i = 0; i < 8; ++i) { const v4u x = xq[i];
        const float qv[8] = {bflo(x.x), bfhi(x.x), bflo(x.y), bfhi(x.y), bflo(x.z), bfhi(x.z), bflo(x.w), bfhi(x.w)};
#pragma unroll
        for (int blk = 0; blk < 7; ++blk) { const f32x4 k0 = *(const LAS f32x4*)(kmb + blk * 64 + 8 * i), k1 = *(const LAS f32x4*)(kmb + blk * 64 + 8 * i + 4);
            gs[blk] += (qv[0] * k0.x + qv[1] * k0.y) + (qv[2] * k0.z + qv[3] * k0.w) + (qv[4] * k1.x + qv[5] * k1.y) + (qv[6] * k1.z + qv[7] * k1.w); } }
    unsigned mask = 0u;
#pragma unroll
    for (int k = 0; k < 3; ++k) { float bv = -3.3e38f; int best = 0;
#pragma unroll
        for (int blk = 0; blk < 7; ++blk) { const bool ok = (blk < own) && (((mask >> blk) & 1u) == 0u); if (ok && gs[blk] > bv) { bv = gs[blk]; best = blk; } }
        mask |= 1u << best; }
    return mask;
}

typedef short bf16x8v __attribute__((ext_vector_type(8)));
typedef float f32x16 __attribute__((ext_vector_type(16)));
constexpr int AT_KP = 144, AT_VP = 136, AT_KB = 64 * AT_KP, AT_BUF = AT_KB + 64 * AT_VP;

typedef float f32x2c __attribute__((ext_vector_type(2)));
typedef __bf16 bf16x2c __attribute__((ext_vector_type(2)));
__device__ __forceinline__ unsigned pk2c(float lo, float hi) { const f32x2c f = {lo, hi}; const bf16x2c b = __builtin_convertvector(f, bf16x2c); return __builtin_bit_cast(unsigned, b); }

__device__ __forceinline__ void softmax_step(f32x16 (&e)[2], float& m, float& l, f32x16 (&o)[2], bf16x8v (&pb)[2][2], bool first, int xaddr) {
    float pm = -1.0e30f;
#pragma unroll
    for (int st = 0; st < 2; ++st)
#pragma unroll
        for (int i = 0; i < 16; ++i) pm = fmaxf(pm, e[st][i]);
    pm = fmaxf(pm, __int_as_float(__builtin_amdgcn_ds_bpermute(xaddr, __float_as_int(pm))));
    if (first || __ballot(pm > 8.0f) != 0ull) {
        const float delta = first ? pm : fmaxf(pm, 0.f);
        const float f = __builtin_amdgcn_exp2f(-delta);
        m += delta; l *= f;
#pragma unroll
        for (int mb = 0; mb < 2; ++mb)
#pragma unroll
            for (int i = 0; i < 16; ++i) o[mb][i] *= f;
#pragma unroll
        for (int st = 0; st < 2; ++st)
#pragma unroll
            for (int i = 0; i < 16; ++i) e[st][i] -= delta;
    }
#pragma unroll
    for (int st = 0; st < 2; ++st)
#pragma unroll
        for (int sp = 0; sp < 2; ++sp) { float pv[8];
#pragma unroll
            for (int j = 0; j < 8; ++j) { pv[j] = __builtin_amdgcn_exp2f(e[st][8 * sp + j]); l += pv[j]; }
            union { v4u u; bf16x8v b; } cv; cv.u.x = pk2c(pv[0], pv[1]); cv.u.y = pk2c(pv[2], pv[3]); cv.u.z = pk2c(pv[4], pv[5]); cv.u.w = pk2c(pv[6], pv[7]); pb[st][sp] = cv.b; }
}

template <bool DIFF>
__device__ __forceinline__ void attn_unit(const bf16* U, const float* kmean, bf16* Y, const LAS float* lut, LAS unsigned char* lds, int bl, int h, int qb, const int wave0, float lam, float outscale, const float* subg) {
    const int tid = fresh_tid(), lane = tid & 63, w = wave0, c = lane & 31, hh = lane >> 5;
    const int qcol = (DIFF ? C_QD : C_QA) + h * 64, kcol = (DIFF ? C_KD : C_KA) + h * 64, vcol = (DIFF ? C_VD : C_VA) + h * 64;
    const int q0w = qb * 256 + 32 * w, tq = q0w + c;
    const size_t qrow = (size_t)bl * SEQ + tq;
    bf16x8v qf[4];
#pragma unroll
    for (int s = 0; s < 4; ++s) qf[s] = *(const GAS bf16x8v*)(U + qrow * UST + qcol + 16 * s + 8 * hh);
    unsigned mask = 0xffu;
    if (!DIFF) {
        LAS float* kmb = (LAS float*)(lds + 2 * AT_BUF);
        if (qb >= 4) {
            if (tid < 7 * 64) { const float* km = kmean + ((size_t)(bl * 8 + (tid >> 6))) * 512 + h * 64 + (tid & 63); kmb[tid] = km[0] + km[256]; }
            __syncthreads();
        }
        mask = moba_mask(U, kmb, bl, h, qb * 8 + w, lane);
    }
    const LAS float* lh = lut + (DIFF ? 4 + h : h) * LUT_N;
    const float cfar = lh[LUT_NEG + 128];
    const float qs2 = (DIFF ? 0.17677669529663687f : 0.125f) * 1.4426950408889634f;
    f32x16 o1[2], o2[2];
#pragma unroll
    for (int mb = 0; mb < 2; ++mb)
#pragma unroll
        for (int i = 0; i < 16; ++i) { o1[mb][i] = 0.f; o2[mb][i] = 0.f; }
    float m1 = 0.f, l1 = 0.f, m2 = 0.f, l2 = 0.f;
    const int ntiles = 4 * (qb + 1), my_last = qb * 4 + (w >> 1);
    const int xaddr = (lane ^ 32) << 2;
#define AT_KT(it) ((it) < 4 ? 4 * qb + (it) : (it) - 4)
    const bf16* kg = U + ((size_t)bl * SEQ + (tid >> 3)) * UST + kcol + 8 * (tid & 7);
    const bf16* vg = U + ((size_t)bl * SEQ + (tid & 63)) * UST + vcol + 8 * (tid >> 6);
    const int kst = (tid >> 3) * AT_KP + (tid & 7) * 16;
    const int vst = AT_KB + (8 * (tid >> 6)) * AT_VP + (tid & 63) * 2;
    v4u kreg = *(const GAS v4u*)(kg + (size_t)AT_KT(0) * 64 * UST), vreg = *(const GAS v4u*)(vg + (size_t)AT_KT(0) * 64 * UST);
#define AT_WRITE(bufb) do { LAS unsigned char* b_ = lds + (bufb) * AT_BUF; *(LAS v4u*)(b_ + kst) = kreg; \
        LAS unsigned short* v_ = (LAS unsigned short*)(b_ + vst); \
        v_[0 * (AT_VP / 2)] = (unsigned short)(vreg.x & 0xffffu); v_[1 * (AT_VP / 2)] = (unsigned short)(vreg.x >> 16); v_[2 * (AT_VP / 2)] = (unsigned short)(vreg.y & 0xffffu); v_[3 * (AT_VP / 2)] = (unsigned short)(vreg.y >> 16); \
        v_[4 * (AT_VP / 2)] = (unsigned short)(vreg.z & 0xffffu); v_[5 * (AT_VP / 2)] = (unsigned short)(vreg.z >> 16); v_[6 * (AT_VP / 2)] = (unsigned short)(vreg.w & 0xffffu); v_[7 * (AT_VP / 2)] = (unsigned short)(vreg.w >> 16); } while (0)
    AT_WRITE(0);
    __syncthreads();
    for (int it = 0; it < ntiles; ++it) {
        const bool more = (it + 1 < ntiles);
        if (more) { const int ktn = AT_KT(it + 1); kreg = *(const GAS v4u*)(kg + (size_t)ktn * 64 * UST); vreg = *(const GAS v4u*)(vg + (size_t)ktn * 64 * UST); }
        const int kt = AT_KT(it);
        const int blk = kt >> 2; const bool past = blk < qb;
        const bool lane_on = past ? (((mask >> blk) & 1u) != 0u) : true;
        if (kt <= my_last && (DIFF || !past || __ballot(lane_on) != 0ull)) {
            const LAS unsigned char* kb = lds + (it & 1) * AT_BUF; const LAS unsigned char* vb = kb + AT_KB;
            const int key0 = kt * 64;
            f32x16 s1[2], s2[2];
#pragma unroll
            for (int st = 0; st < 2; ++st) {
#pragma unroll
                for (int i = 0; i < 16; ++i) { s1[st][i] = 0.f; s2[st][i] = 0.f; }
#pragma unroll
                for (int s = 0; s < 4; ++s) { const bf16x8v a = *(const LAS bf16x8v*)(kb + (32 * st + c) * AT_KP + (16 * s + 8 * hh) * 2);
                    if (DIFF && s >= 2) s2[st] = __builtin_amdgcn_mfma_f32_32x32x16_bf16(a, qf[s], s2[st], 0, 0, 0);
                    else s1[st] = __builtin_amdgcn_mfma_f32_32x32x16_bf16(a, qf[s], s1[st], 0, 0, 0); }
            }
            const float off1 = lane_on ? -m1 : -1.0e30f, off2 = -m2;
            if (key0 + 63 + 128 <= q0w) {
                const float x1 = cfar + off1, x2 = cfar + off2;
#pragma unroll
                for (int st = 0; st < 2; ++st)
#pragma unroll
                    for (int i = 0; i < 16; ++i) { s1[st][i] = s1[st][i] * qs2 + x1; if (DIFF) s2[st][i] = s2[st][i] * qs2 + x2; }
            } else {
                const LAS float* lp = lh + (LUT_NEG + tq - key0 - 4 * hh);
#pragma unroll
                for (int st = 0; st < 2; ++st)
#pragma unroll
                    for (int i = 0; i < 16; ++i) { const float b = lp[-(32 * st + (i & 3) + 8 * (i >> 2))]; s1[st][i] = s1[st][i] * qs2 + (b + off1); if (DIFF) s2[st][i] = s2[st][i] * qs2 + (b + off2); }
            }
            bf16x8v p1[2][2], p2[2][2];
            softmax_step(s1, m1, l1, o1, p1, it == 0, xaddr);
            if (DIFF) softmax_step(s2, m2, l2, o2, p2, it == 0, xaddr);
#pragma unroll
            for (int mb = 0; mb < 2; ++mb)
#pragma unroll
                for (int s = 0; s < 4; ++s) { const LAS unsigned char* vr = vb + (32 * mb + c) * AT_VP + (16 * s + 4 * hh) * 2;
                    const v2u lo = *(const LAS v2u*)vr, hi = *(const LAS v2u*)(vr + 16);
                    union { v4u u; bf16x8v b; } cv; cv.u.x = lo.x; cv.u.y = lo.y; cv.u.z = hi.x; cv.u.w = hi.y;
                    o1[mb] = __builtin_amdgcn_mfma_f32_32x32x16_bf16(cv.b, p1[s >> 1][s & 1], o1[mb], 0, 0, 0);
                    if (DIFF) o2[mb] = __builtin_amdgcn_mfma_f32_32x32x16_bf16(cv.b, p2[s >> 1][s & 1], o2[mb], 0, 0, 0); }
        }
        if (more) AT_WRITE((it + 1) & 1);
        __syncthreads();
    }
#undef AT_WRITE
#undef AT_KT
    l1 += __int_as_float(__builtin_amdgcn_ds_bpermute(xaddr, __float_as_int(l1)));
    const float i1 = 1.0f / l1;
    bf16* yp = Y + qrow * 1024 + (DIFF ? 768 : 0) + h * 64;
    if (!DIFF) {
#pragma unroll
        for (int mb = 0; mb < 2; ++mb)
#pragma unroll
            for (int g = 0; g < 4; ++g) { v2u wv; wv.x = pk2c(o1[mb][4 * g] * i1, o1[mb][4 * g + 1] * i1); wv.y = pk2c(o1[mb][4 * g + 2] * i1, o1[mb][4 * g + 3] * i1);
                *(GAS v2u*)(yp + 32 * mb + 8 * g + 4 * hh) = wv; }
    } else {
        l2 += __int_as_float(__builtin_amdgcn_ds_bpermute(xaddr, __float_as_int(l2)));
        const float i2 = lam / l2; float ss = 0.f;
#pragma unroll
        for (int mb = 0; mb < 2; ++mb)
#pragma unroll
            for (int i = 0; i < 16; ++i) { const float v = o1[mb][i] * i1 - o2[mb][i] * i2; o1[mb][i] = v; ss += v * v; }
        ss += __int_as_float(__builtin_amdgcn_ds_bpermute(xaddr, __float_as_int(ss)));
        const float r = outscale / sqrtf(ss * (1.0f / 64.0f) + SUBLN_EPS);
#pragma unroll
        for (int mb = 0; mb < 2; ++mb)
#pragma unroll
            for (int g = 0; g < 4; ++g) { const int d = 32 * mb + 8 * g + 4 * hh; const f32x4 sg = *(const f32x4*)(subg + d);
                v2u wv; wv.x = pk2c(o1[mb][4 * g] * r * sg.x, o1[mb][4 * g + 1] * r * sg.y); wv.y = pk2c(o1[mb][4 * g + 2] * r * sg.z, o1[mb][4 * g + 3] * r * sg.w);
                *(GAS v2u*)(yp + d) = wv; }
    }
}

__device__ __forceinline__ unsigned cvt4_fp8g(float a, float b, float c, float d) { int w = 0; w = __builtin_amdgcn_cvt_pk_fp8_f32(a, b, w, false); w = __builtin_amdgcn_cvt_pk_fp8_f32(c, d, w, true); return (unsigned)w; }
__device__ __forceinline__ void transpose_item8(const float* W, int K, int N, unsigned char* WT, int row_off, int il, LAS float* scr, int item, int lane, const float* gk = nullptr, int ldw = 0) {
    if (ldw == 0) ldw = N;
    const int nblk = N / 32, kb = item / nblk, nb = item % nblk, k0 = 64 * kb, n0 = 32 * nb;
#pragma unroll 8
    for (int i = 0; i < 32; ++i) { const int kk = 2 * i + (lane >> 5); scr[kk * 33 + (lane & 31)] = __builtin_nontemporal_load(W + (size_t)(k0 + kk) * ldw + n0 + (lane & 31)) * (gk ? gk[k0 + kk] : 1.0f); }
    LDS_WAIT(); asm volatile("" ::: "memory"); __builtin_amdgcn_wave_barrier();
    const int c = lane & 7;
    const int r0 = il ? ((n0 >> 7) * 256 + row_off + (n0 & 127)) : (row_off + n0);
#pragma unroll
    for (int j = 0; j < 4; ++j) { const int n = (lane >> 3) + 8 * j; const LAS float* sp = scr + (8 * c) * 33 + n;
        v2u o; o.x = cvt4_fp8g(32.f * sp[0 * 33], 32.f * sp[1 * 33], 32.f * sp[2 * 33], 32.f * sp[3 * 33]); o.y = cvt4_fp8g(32.f * sp[4 * 33], 32.f * sp[5 * 33], 32.f * sp[6 * 33], 32.f * sp[7 * 33]);
        *(GAS v2u*)(WT + (size_t)(r0 + n) * K + k0 + 8 * c) = o; }
    LDS_WAIT(); asm volatile("" ::: "memory"); __builtin_amdgcn_wave_barrier();
}

struct Args {
    const float* in[20]; float* out; unsigned char* ws; int ph_lo, ph_hi, li, pad;
};
typedef const __attribute__((address_space(4))) Args CArgs;

__device__ __forceinline__ float row_rms_load(const float* xrow, const float* g, int lane, f32x4 (&v)[4]) {
    const GAS f32x4* xr = (const GAS f32x4*)xrow + lane; float s = 0.f;
#pragma unroll
    for (int j = 0; j < 4; ++j) { v[j] = __builtin_nontemporal_load(xr + 64 * j); s += (v[j].x * v[j].x + v[j].y * v[j].y) + (v[j].z * v[j].z + v[j].w * v[j].w); }
    const float r = 1.0f / sqrtf(wave_sum(s, lane) * (1.f / D) + RMS_EPS);
    const GAS f32x4* gr = (const GAS f32x4*)g + lane;
#pragma unroll
    for (int j = 0; j < 4; ++j) { const f32x4 gg = gr[64 * j]; v[j] = v[j] * r * gg; }
    return r;
}
__device__ __forceinline__ void row_store_bf16(bf16* orow, int lane, const f32x4 (&v)[4]) {
    GAS unsigned long long* o8 = (GAS unsigned long long*)orow + lane;
#pragma unroll
    for (int j = 0; j < 4; ++j) o8[64 * j] = (unsigned long long)pk2(v[j].x, v[j].y) | ((unsigned long long)pk2(v[j].z, v[j].w) << 32);
}

__device__ __forceinline__ float rowb_rms_load(const bf16* xrow, const float* g, int lane, float (&v)[16]) {
    float s = 0.f;
#pragma unroll
    for (int j = 0; j < 2; ++j) { const v4u x = *(const GAS v4u*)(xrow + 8 * lane + 512 * j);
        v[8 * j + 0] = bflo(x.x); v[8 * j + 1] = bfhi(x.x); v[8 * j + 2] = bflo(x.y); v[8 * j + 3] = bfhi(x.y); v[8 * j + 4] = bflo(x.z); v[8 * j + 5] = bfhi(x.z); v[8 * j + 6] = bflo(x.w); v[8 * j + 7] = bfhi(x.w); }
#pragma unroll
    for (int k = 0; k < 16; ++k) s += v[k] * v[k];
    const float r = 1.0f / sqrtf(wave_sum(s, lane) * (1.f / D) + RMS_EPS);
#pragma unroll
    for (int j = 0; j < 2; ++j) { const f32x4 g0 = *(const GAS f32x4*)(g + 8 * lane + 512 * j), g1 = *(const GAS f32x4*)(g + 8 * lane + 512 * j + 4);
        v[8 * j + 0] *= r * g0.x; v[8 * j + 1] *= r * g0.y; v[8 * j + 2] *= r * g0.z; v[8 * j + 3] *= r * g0.w; v[8 * j + 4] *= r * g1.x; v[8 * j + 5] *= r * g1.y; v[8 * j + 6] *= r * g1.z; v[8 * j + 7] *= r * g1.w; }
    return r;
}
__device__ __forceinline__ float rowb_rms_from(const v4u (&x)[2], const float* g, int lane, float (&v)[16]) {
    float s = 0.f;
#pragma unroll
    for (int j = 0; j < 2; ++j) { v[8 * j + 0] = bflo(x[j].x); v[8 * j + 1] = bfhi(x[j].x); v[8 * j + 2] = bflo(x[j].y); v[8 * j + 3] = bfhi(x[j].y); v[8 * j + 4] = bflo(x[j].z); v[8 * j + 5] = bfhi(x[j].z); v[8 * j + 6] = bflo(x[j].w); v[8 * j + 7] = bfhi(x[j].w); }
#pragma unroll
    for (int k = 0; k < 16; ++k) s += v[k] * v[k];
    const float r = 1.0f / sqrtf(wave_sum(s, lane) * (1.f / D) + RMS_EPS);
#pragma unroll
    for (int j = 0; j < 2; ++j) { const f32x4 g0 = *(const GAS f32x4*)(g + 8 * lane + 512 * j), g1 = *(const GAS f32x4*)(g + 8 * lane + 512 * j + 4);
        v[8 * j + 0] *= r * g0.x; v[8 * j + 1] *= r * g0.y; v[8 * j + 2] *= r * g0.z; v[8 * j + 3] *= r * g0.w; v[8 * j + 4] *= r * g1.x; v[8 * j + 5] *= r * g1.y; v[8 * j + 6] *= r * g1.z; v[8 * j + 7] *= r * g1.w; }
    return r;
}
__device__ __forceinline__ void rowb_store_bf16(bf16* orow, int lane, const float (&v)[16]) {
#pragma unroll
    for (int j = 0; j < 2; ++j) { v4u w; w.x = pk2(v[8 * j], v[8 * j + 1]); w.y = pk2(v[8 * j + 2], v[8 * j + 3]); w.z = pk2(v[8 * j + 4], v[8 * j + 5]); w.w = pk2(v[8 * j + 6], v[8 * j + 7]);
        *(GAS v4u*)(orow + 8 * lane + 512 * j) = w; }
}
__device__ __forceinline__ void rowb_store_fp8(unsigned char* orow, int lane, const float (&v)[16]) {
#pragma unroll
    for (int j = 0; j < 2; ++j) { v2u w; w.x = cvt4_fp8g(v[8 * j], v[8 * j + 1], v[8 * j + 2], v[8 * j + 3]); w.y = cvt4_fp8g(v[8 * j + 4], v[8 * j + 5], v[8 * j + 6], v[8 * j + 7]);
        *(GAS v2u*)(orow + 8 * lane + 512 * j) = w; }
}
__device__ __forceinline__ void row_store_fp8(unsigned char* orow, int lane, const f32x4 (&v)[4]) {
    GAS unsigned* o4 = (GAS unsigned*)orow + lane;
#pragma unroll
    for (int j = 0; j < 4; ++j) o4[64 * j] = cvt4_fp8g(v[j].x, v[j].y, v[j].z, v[j].w);
}
__device__ __forceinline__ void ph_prologue(CArgs& args, LAS unsigned char* lds, const int wave0) {
    const int tid = fresh_tid(), lane = tid & 63, wave = __builtin_amdgcn_readfirstlane(tid >> 6), gw = blockIdx.x * NWAVES + wave, NGW = gridDim.x * NWAVES;
    unsigned char* ws = args.ws;
    LAS float* scr = (LAS float*)(lds + wave * 16384);
    constexpr int I_WIN = 16 * (GCOL0 / 32), I_WG = 16 * ((WIN - GCOL0) / 32), I_BP = 4 * 32, I_WO = 16 * 32, I_D1 = 16 * (FF0 / 32), I_D2 = (FF0 / 64) * 32, I_E1 = 16 * (FFE / 32), I_E2 = (FFE / 64) * 32;
    constexpr int NIT = 2 * I_WIN + 2 * I_WG + 8 * I_BP + 2 * I_WO + 2 * I_D1 + I_D2 + 16 * I_E1 + 8 * I_E2;
    for (int it = gw; it < NIT; it += NGW) {
        int r = it;
        if (r < 2 * I_WIN) { const int l = r / I_WIN; transpose_item(args.in[3] + (size_t)l * D * WIN, D, GCOL0, (bf16*)(ws + WS_WIN) + (size_t)l * GCOL0 * D, 0, 0, scr, r % I_WIN, lane, l ? args.in[2] + D : nullptr, WIN); continue; } r -= 2 * I_WIN;
        if (r < 2 * I_WG) { const int l = r / I_WG; transpose_item8(args.in[3] + (size_t)l * D * WIN + GCOL0, D, WIN - GCOL0, ws + WS_WG8 + (size_t)l * (WIN - GCOL0) * D, 0, 0, scr, r % I_WG, lane, l ? args.in[2] + D : nullptr, WIN); continue; } r -= 2 * I_WG;
        if (r < 8 * I_BP) { const int q = r / I_BP;
            if ((q & 3) != 2) { transpose_item(args.in[9] + (size_t)q * 256 * D, 256, D, (bf16*)(ws + WS_BP) + (size_t)q * D * 256, 0, 0, scr, r % I_BP, lane); continue; }
            const int it2 = r % I_BP; if (it2 < 64) { const int l = q >> 2, g = it2 >> 4, n = (it2 & 15) * 64 + lane;
                const float* pw = args.in[5] + ((size_t)l * 4 + g) * 64 * 64; const float* psc = args.in[6] + (size_t)l * 256 + g * 64; const float* b2 = args.in[9] + ((size_t)q * 256 + g * 64) * D + n;
                bf16* dst = (bf16*)(ws + WS_BP) + (size_t)q * D * 256 + (size_t)n * 256 + g * 64;
#pragma unroll 1
                for (int ch = 0; ch < 4; ++ch) {
                    float accw[16];
#pragma unroll
                    for (int c = 0; c < 16; ++c) accw[c] = 0.f;
#pragma unroll 4
                    for (int d = 0; d < 64; ++d) { const float bv = b2[(size_t)d * D] * psc[d];
#pragma unroll
                        for (int c = 0; c < 16; ++c) accw[c] += pw[(ch * 16 + c) * 64 + d] * bv; }
#pragma unroll
                    for (int c8 = 0; c8 < 2; ++c8) { v4u w; w.x = pk2(accw[8 * c8], accw[8 * c8 + 1]); w.y = pk2(accw[8 * c8 + 2], accw[8 * c8 + 3]); w.z = pk2(accw[8 * c8 + 4], accw[8 * c8 + 5]); w.w = pk2(accw[8 * c8 + 6], accw[8 * c8 + 7]);
                        *(GAS v4u*)(dst + ch * 16 + 8 * c8) = w; } } }
            continue; } r -= 8 * I_BP;
        if (r < 2 * I_WO) { const int l = r / I_WO; transpose_item(args.in[10] + (size_t)l * D * D, D, D, (bf16*)(ws + WS_WOUT) + (size_t)l * D * D, 0, 0, scr, r % I_WO, lane); continue; } r -= 2 * I_WO;
        if (r < I_D1) { transpose_item(args.in[12], D, FF0, (bf16*)(ws + WS_W13D), 0, 1, scr, r, lane, args.in[11]); continue; } r -= I_D1;
        if (r < I_D1) { transpose_item(args.in[13], D, FF0, (bf16*)(ws + WS_W13D), 128, 1, scr, r, lane, args.in[11]); continue; } r -= I_D1;
        if (r < I_D2) { transpose_item8(args.in[14], FF0, D, ws + WS_W2D, 0, 0, scr, r, lane); continue; } r -= I_D2;
        if (r < 8 * I_E1) { const int e = r / I_E1; transpose_item8(args.in[16] + (size_t)e * D * FFE, D, FFE, ws + WS_W13E + (size_t)e * 2 * FFE * D, 0, 1, scr, r % I_E1, lane); continue; } r -= 8 * I_E1;
        if (r < 8 * I_E1) { const int e = r / I_E1; transpose_item8(args.in[17] + (size_t)e * D * FFE, D, FFE, ws + WS_W13E + (size_t)e * 2 * FFE * D, 128, 1, scr, r % I_E1, lane); continue; } r -= 8 * I_E1;
        { const int e = r / I_E2; transpose_item8(args.in[18] + (size_t)e * FFE * D, FFE, D, ws + WS_W2E + (size_t)e * D * FFE, 0, 0, scr, r % I_E2, lane); }
    }
}

__device__ __forceinline__ void ph_norm_rb(const bf16* src, const float* g, bf16* dst, const int wave0) {
    const int tid = fresh_tid(), lane = tid & 63, wave = __builtin_amdgcn_readfirstlane(tid >> 6), gw = blockIdx.x * NWAVES + wave, NGW = gridDim.x * NWAVES;
    for (int m = gw; m < M; m += NGW) { float v[16]; (void)rowb_rms_load(src + (size_t)m * D, g, lane, v); rowb_store_bf16(dst + (size_t)m * D, lane, v); }
}
__device__ __forceinline__ void ph_norm_bf16(const float* src, const float* g, bf16* dst, unsigned char* dst8, const int wave0) {
    const int tid = fresh_tid(), lane = tid & 63, wave = __builtin_amdgcn_readfirstlane(tid >> 6), gw = blockIdx.x * NWAVES + wave, NGW = gridDim.x * NWAVES;
    for (int m = gw; m < M; m += NGW) { f32x4 v[4]; (void)row_rms_load(src + (size_t)m * D, g, lane, v); row_store_bf16(dst + (size_t)m * D, lane, v); row_store_fp8(dst8 + (size_t)m * D, lane, v); }
}
__device__ __forceinline__ void ph_final_norm(const bf16* R, const float* g, float* out, const int wave0) {
    const int tid = fresh_tid(), lane = tid & 63, wave = __builtin_amdgcn_readfirstlane(tid >> 6), gw = blockIdx.x * NWAVES + wave, NGW = gridDim.x * NWAVES;
    f32x4 gg[4];
#pragma unroll
    for (int j = 0; j < 2; ++j) { gg[2 * j] = *(const GAS f32x4*)(g + 8 * lane + 512 * j); gg[2 * j + 1] = *(const GAS f32x4*)(g + 8 * lane + 512 * j + 4); }
    for (int m0 = gw; m0 < M; m0 += 2 * NGW) {
        v4u x[2][2], z[2][2], z0[2][2];
#pragma unroll
        for (int q = 0; q < 2; ++q)
#pragma unroll
            for (int j = 0; j < 2; ++j) { x[q][j] = *(const GAS v4u*)(R + (size_t)(m0 + q * NGW) * D + 8 * lane + 512 * j);
                z[q][j] = *(const GAS v4u*)((const bf16*)(out + (size_t)(m0 + q * NGW) * D + 512) + 8 * lane + 512 * j);
                z0[q][j] = *(const GAS v4u*)((const bf16*)(out + (size_t)(m0 + q * NGW) * D) + 8 * lane + 512 * j); }
#pragma unroll
        for (int q = 0; q < 2; ++q) { float v[16];
#pragma unroll
            for (int j = 0; j < 2; ++j) { const v4u w = x[q][j], y = z[q][j], y0 = z0[q][j];
                v[8 * j + 0] = bflo(w.x) + (bflo(y0.x) + bflo(y.x)); v[8 * j + 1] = bfhi(w.x) + (bfhi(y0.x) + bfhi(y.x)); v[8 * j + 2] = bflo(w.y) + (bflo(y0.y) + bflo(y.y)); v[8 * j + 3] = bfhi(w.y) + (bfhi(y0.y) + bfhi(y.y));
                v[8 * j + 4] = bflo(w.z) + (bflo(y0.z) + bflo(y.z)); v[8 * j + 5] = bfhi(w.z) + (bfhi(y0.z) + bfhi(y.z)); v[8 * j + 6] = bflo(w.w) + (bflo(y0.w) + bflo(y.w)); v[8 * j + 7] = bfhi(w.w) + (bfhi(y0.w) + bfhi(y.w)); }
            float s = 0.f;
#pragma unroll
            for (int k = 0; k < 16; ++k) s += v[k] * v[k];
            const float r = 1.0f / sqrtf(wave_sum(s, lane) * (1.f / D) + RMS_EPS);
            float* o = out + (size_t)(m0 + q * NGW) * D + 8 * lane;
#pragma unroll
            for (int j = 0; j < 2; ++j) { const f32x4 a = gg[2 * j], b = gg[2 * j + 1];
                *(GAS f32x4*)(o + 512 * j) = (f32x4){v[8 * j] * r * a.x, v[8 * j + 1] * r * a.y, v[8 * j + 2] * r * a.z, v[8 * j + 3] * r * a.w};
                *(GAS f32x4*)(o + 512 * j + 4) = (f32x4){v[8 * j + 4] * r * b.x, v[8 * j + 5] * r * b.y, v[8 * j + 6] * r * b.z, v[8 * j + 7] * r * b.w}; } }
    }
}

__device__ __forceinline__ void ph_kmean(const bf16* U, float* kmean, LAS unsigned char* lds, const int wave0) {
    const int tid = fresh_tid();
    LAS float* red = (LAS float*)lds;
    for (int task = blockIdx.x; task < HB * 8; task += gridDim.x) {
        const int bl = task >> 3, blk = task & 7, cg = tid & 31, rq = tid >> 5;
        const bf16* kp = U + ((size_t)bl * SEQ + blk * 256 + rq * 16) * UST + C_KA + 8 * cg;
        v4u x[16];
#pragma unroll
        for (int i = 0; i < 16; ++i) x[i] = *(const GAS v4u*)(kp + (size_t)i * UST);
        float sm[8];
#pragma unroll
        for (int k = 0; k < 8; ++k) sm[k] = 0.f;
#pragma unroll
        for (int i = 0; i < 16; ++i) { sm[0] += bflo(x[i].x); sm[1] += bfhi(x[i].x); sm[2] += bflo(x[i].y); sm[3] += bfhi(x[i].y); sm[4] += bflo(x[i].z); sm[5] += bfhi(x[i].z); sm[6] += bflo(x[i].w); sm[7] += bfhi(x[i].w); }
#pragma unroll
        for (int k = 0; k < 8; ++k) red[rq * 256 + 8 * cg + k] = sm[k];
        __syncthreads();
        if (tid < 256) { float t = 0.f;
#pragma unroll
            for (int q = 0; q < 16; ++q) t += red[q * 256 + tid];
            kmean[(size_t)task * 256 + tid] = t * (1.0f / 256.0f); }
        __syncthreads();
    }
}

__device__ __forceinline__ void ph_conv_pool(CArgs& args, int l, const bf16* U, bf16* Y, LAS unsigned char* lds, const int wave0) {
    const int tid = fresh_tid(), lane = tid & 63, wave = __builtin_amdgcn_readfirstlane(tid >> 6), gw = blockIdx.x * NWAVES + wave, NGW = gridDim.x * NWAVES;
    {
        const float* cw = args.in[4] + (size_t)l * 3 * 256; const int c0 = (lane & 31) * 8;
        float w0[8], w1[8], w2[8];
#pragma unroll
        for (int k = 0; k < 8; ++k) { w0[k] = cw[c0 + k]; w1[k] = cw[256 + c0 + k]; w2[k] = cw[512 + c0 + k]; }
        for (int ch = gw; ch < HROWS / 8; ch += NGW) {
            const int rl0 = ch * 8 + (lane >> 5) * 4, t = rl0 & (SEQ - 1);
            const bf16* up = U + (size_t)rl0 * UST; const int back = t > 0 ? 1 : 0; const float mb = t > 0 ? 1.f : 0.f;
            v4u xv[6], gv[6], bv[4];
#pragma unroll
            for (int k = 0; k < 6; ++k) { const long ro = (k < 2) ? (long)(k - 2) * back : (long)(k - 2); xv[k] = *(const GAS v4u*)(up + ro * UST + C_XB + c0); gv[k] = *(const GAS v4u*)(up + ro * UST + C_CB + c0); }
#pragma unroll
            for (int i = 0; i < 4; ++i) bv[i] = *(const GAS v4u*)(up + (size_t)i * UST + C_BB + c0);
            float uu[6][8];
#pragma unroll
            for (int k = 0; k < 6; ++k) { const float mk = (k < 2) ? mb : 1.f;
                uu[k][0] = mk * bflo(xv[k].x) * bflo(gv[k].x); uu[k][1] = mk * bfhi(xv[k].x) * bfhi(gv[k].x); uu[k][2] = mk * bflo(xv[k].y) * bflo(gv[k].y); uu[k][3] = mk * bfhi(xv[k].y) * bfhi(gv[k].y);
                uu[k][4] = mk * bflo(xv[k].z) * bflo(gv[k].z); uu[k][5] = mk * bfhi(xv[k].z) * bfhi(gv[k].z); uu[k][6] = mk * bflo(xv[k].w) * bflo(gv[k].w); uu[k][7] = mk * bfhi(xv[k].w) * bfhi(gv[k].w); }
#pragma unroll
            for (int i = 0; i < 4; ++i) { float cv[8];
#pragma unroll
                for (int k = 0; k < 8; ++k) cv[k] = w2[k] * uu[i + 2][k] + w1[k] * uu[i + 1][k] + w0[k] * uu[i][k];
                v4u w; w.x = pk2(cv[0] * bflo(bv[i].x), cv[1] * bfhi(bv[i].x)); w.y = pk2(cv[2] * bflo(bv[i].y), cv[3] * bfhi(bv[i].y)); w.z = pk2(cv[4] * bflo(bv[i].z), cv[5] * bfhi(bv[i].z)); w.w = pk2(cv[6] * bflo(bv[i].w), cv[7] * bfhi(bv[i].w));
                *(GAS v4u*)(Y + (size_t)(rl0 + i) * 1024 + 256 + c0) = w; }
        }
    }
    {
        const int gq = lane >> 4, c4 = (lane & 15) * 4, wlen = 2 << gq;
        for (int ch = gw; ch < HROWS / 8; ch += NGW) {
            const int rl0 = ch * 8, t0 = rl0 & (SEQ - 1); const bf16* pp = U + (size_t)rl0 * UST + C_PC + gq * 64 + c4;
            v2u xr[23];
#pragma unroll
            for (int i = 0; i < 23; ++i) { const int d = i - 15; const long ro = (t0 + d >= 0) ? (long)d : 0; xr[i] = *(const GAS v2u*)(pp + ro * UST); }
            float xf[23][4];
#pragma unroll
            for (int i = 0; i < 23; ++i) { const float mk = (t0 + i - 15 >= 0) ? 1.f : 0.f; xf[i][0] = mk * bflo(xr[i].x); xf[i][1] = mk * bfhi(xr[i].x); xf[i][2] = mk * bflo(xr[i].y); xf[i][3] = mk * bfhi(xr[i].y); }
#pragma unroll
            for (int tk = 0; tk < 8; ++tk) { float s0 = 0.f, s1 = 0.f, s2 = 0.f, s3 = 0.f;
#pragma unroll
                for (int j = 0; j < 16; ++j) { const float mk = j < wlen ? 1.f : 0.f; s0 += mk * xf[15 + tk - j][0]; s1 += mk * xf[15 + tk - j][1]; s2 += mk * xf[15 + tk - j][2]; s3 += mk * xf[15 + tk - j][3]; }
                const int t = t0 + tk; const int cnt = (t + 1) < wlen ? (t + 1) : wlen; const float ic = 1.0f / (float)cnt;
                v2u w; w.x = pk2(s0 * ic - xf[15 + tk][0], s1 * ic - xf[15 + tk][1]); w.y = pk2(s2 * ic - xf[15 + tk][2], s3 * ic - xf[15 + tk][3]);
                *(GAS v2u*)(Y + (size_t)(rl0 + tk) * 1024 + 512 + gq * 64 + c4) = w; }
        }
    }
    __syncthreads();
}

__device__ __forceinline__ void ph_attn(CArgs& args, int l, const bf16* U, const float* kmean, bf16* Y, LAS unsigned char* lds, const int wave0) {
    const float* dl = args.in[7] + (size_t)l * 128; const float* subg = args.in[8] + (size_t)l * 64;
    float a = 0.f, b = 0.f;
    for (int i = 0; i < 32; ++i) { a += dl[i] * dl[32 + i]; b += dl[64 + i] * dl[96 + i]; }
    int l_s = l; asm volatile("" : "+s"(l_s));
    const float lam_init = (l_s == 0) ? 0.2f : 0.35550906759096926f;
    const float lam = __expf(a) - __expf(b) + lam_init, outscale = 1.0f - lam_init;
    const LAS float* lut = (const LAS float*)(lds + LUT_OFF);
    for (int cu0 = blockIdx.x; cu0 < HB * 4 * 4; cu0 += gridDim.x) {
        const int cu = (gridDim.x == 256) ? ((cu0 & 7) * 32 + (cu0 >> 3)) : cu0;
        const int bh = cu >> 2, pr = cu & 3, bl = bh >> 2, h = bh & 3;
#pragma unroll 1
        for (int k = 0; k < 2; ++k) attn_unit<false>(U, kmean, Y, lut, lds, bl, h, k ? 7 - pr : pr, wave0, 0.f, 0.f, subg);
#pragma unroll 1
        for (int k = 0; k < 2; ++k) attn_unit<true>(U, kmean, Y, lut, lds, bl, h, k ? 7 - pr : pr, wave0, lam, outscale, subg);
    }
}

__device__ __forceinline__ void ph_route(CArgs& args, int l, const bf16* R, unsigned* route, int* tokp, gu32* ctl, LAS unsigned char* lds, const int wave0) {
    const int tid = fresh_tid(), lane = tid & 63, wave = __builtin_amdgcn_readfirstlane(tid >> 6), gw = blockIdx.x * NWAVES + wave, NGW = gridDim.x * NWAVES;
    const float* g = args.in[11] + (size_t)l * D;
    LAS float* rl = (LAS float*)lds;
    { const float* rw = args.in[15]; for (int i = tid; i < D * 8; i += NWAVES * 64) rl[i] = rw[i] * g[i >> 3]; }
    for (int i = blockIdx.x * NWAVES * 64 + tid; i < 2 * CAPROWS; i += gridDim.x * NWAVES * 64) tokp[i] = -1;
    __syncthreads();
    for (int m0 = gw; m0 < M; m0 += 4 * NGW) {
        v4u xr[4][2];
#pragma unroll
        for (int q = 0; q < 4; ++q)
#pragma unroll
            for (int j = 0; j < 2; ++j) xr[q][j] = *(const GAS v4u*)(R + (size_t)(m0 + q * NGW) * D + 8 * lane + 512 * j);
        int i0q[4], i1q[4]; float w0q[4], w1q[4], rq[4];
#pragma unroll
        for (int q = 0; q < 4; ++q) {
            float v[16], ss = 0.f;
#pragma unroll
            for (int j = 0; j < 2; ++j) { v[8 * j + 0] = bflo(xr[q][j].x); v[8 * j + 1] = bfhi(xr[q][j].x); v[8 * j + 2] = bflo(xr[q][j].y); v[8 * j + 3] = bfhi(xr[q][j].y); v[8 * j + 4] = bflo(xr[q][j].z); v[8 * j + 5] = bfhi(xr[q][j].z); v[8 * j + 6] = bflo(xr[q][j].w); v[8 * j + 7] = bfhi(xr[q][j].w); }
#pragma unroll
            for (int k = 0; k < 16; ++k) ss += v[k] * v[k];
            float lg[8];
#pragma unroll
            for (int e = 0; e < 8; ++e) lg[e] = 0.f;
#pragma unroll
            for (int j = 0; j < 2; ++j)
#pragma unroll
                for (int k = 0; k < 8; ++k) { const int c = 8 * lane + 512 * j + k; const f32x4 ra = *(const LAS f32x4*)(rl + c * 8), rb = *(const LAS f32x4*)(rl + c * 8 + 4); const float xv = v[8 * j + k];
                    lg[0] += xv * ra.x; lg[1] += xv * ra.y; lg[2] += xv * ra.z; lg[3] += xv * ra.w; lg[4] += xv * rb.x; lg[5] += xv * rb.y; lg[6] += xv * rb.z; lg[7] += xv * rb.w; }
#define RT_X(k_, val_) __int_as_float(__builtin_amdgcn_ds_bpermute((lane ^ (k_)) << 2, __float_as_int(val_)))
            { const bool b1 = (lane & 1) != 0, b2 = (lane & 2) != 0, b3 = (lane & 4) != 0;
              float a4[4], c2[2], d1;
#pragma unroll
              for (int i = 0; i < 4; ++i) { const float snd = b1 ? lg[i] : lg[4 + i], kp = b1 ? lg[4 + i] : lg[i]; a4[i] = kp + RT_X(1, snd); }
#pragma unroll
              for (int i = 0; i < 2; ++i) { const float snd = b2 ? a4[i] : a4[2 + i], kp = b2 ? a4[2 + i] : a4[i]; c2[i] = kp + RT_X(2, snd); }
              { const float snd = b3 ? c2[0] : c2[1], kp = b3 ? c2[1] : c2[0]; d1 = kp + RT_X(4, snd); }
              d1 += RT_X(8, d1); d1 += RT_X(16, d1); d1 += RT_X(32, d1);
              const float r = 1.0f / sqrtf(wave_sum(ss, lane) * (1.f / D) + RMS_EPS); rq[q] = r;
#pragma unroll
              for (int e = 0; e < 8; ++e) lg[e] = r * __int_as_float(__builtin_amdgcn_readlane(__float_as_int(d1), ((e >> 2) & 1) | (((e >> 1) & 1) << 1) | ((e & 1) << 2))); }
#undef RT_X
            int i0 = 0; float v0 = lg[0];
#pragma unroll
            for (int e = 1; e < 8; ++e) if (lg[e] > v0) { v0 = lg[e]; i0 = e; }
            int i1 = 0; float v1 = -3.0e38f;
#pragma unroll
            for (int e = 0; e < 8; ++e) if (e != i0 && lg[e] > v1) { v1 = lg[e]; i1 = e; }
            const float e1 = __expf(v1 - v0); w0q[q] = 1.0f / (1.0f + e1); w1q[q] = e1 * w0q[q]; i0q[q] = i0; i1q[q] = i1;
        }
        if (lane == 0) {
            unsigned s0[4], s1[4];
#pragma unroll
            for (int q = 0; q < 4; ++q) { s0[q] = atomicAdd((unsigned*)(ctl + CW_CNT + (0 * 8 + i0q[q]) * 64), 1u); s1[q] = atomicAdd((unsigned*)(ctl + CW_CNT + (1 * 8 + i1q[q]) * 64), 1u); }
#pragma unroll
            for (int q = 0; q < 4; ++q) { unsigned* rec = route + (size_t)(m0 + q * NGW) * 8; rec[0] = (unsigned)i0q[q] | ((unsigned)i1q[q] << 8); rec[1] = s0[q]; rec[2] = s1[q]; rec[3] = __float_as_uint(w0q[q]); rec[4] = __float_as_uint(w1q[q]); rec[5] = __float_as_uint(rq[q]); }
        }
    }
}

__device__ __forceinline__ void ph_gather(CArgs& args, int l, const bf16* R, const unsigned* route, int* tokp, float* gatep, int* tile_e, int* n_rt, unsigned char* hperm, gu32* ctl, LAS unsigned char* lds, const int wave0) {
    const int tid = fresh_tid(), lane = tid & 63, wave = __builtin_amdgcn_readfirstlane(tid >> 6), gw = blockIdx.x * NWAVES + wave, NGW = gridDim.x * NWAVES;
    const float* g = args.in[11] + (size_t)l * D;
    LAS int* base = (LAS int*)lds;
    if (tid < 2) { int acc = 0;
        for (int e = 0; e < 8; ++e) { base[tid * 8 + e] = acc; const int c = (int)__hip_atomic_load((unsigned*)(ctl + CW_CNT + (tid * 8 + e) * 64), RLX_AGENT); acc += (c + 255) & ~255; }
        base[16 + tid] = acc; }
    __syncthreads();
    if (blockIdx.x == 0 && tid < 2) { const int p = tid, nt = base[16 + p] >> 8; n_rt[p] = nt;
        for (int rt = 0; rt < nt; ++rt) { int e = 0; for (int k = 1; k < 8; ++k) if (rt * 256 >= base[p * 8 + k]) e = k; tile_e[p * 512 + rt] = e; } }
    for (int m0 = gw; m0 < M; m0 += 4 * NGW) {
        v4u xr[4][2]; unsigned ee[4], sl0[4], sl1[4], gw0[4], gw1[4], rs5[4];
#pragma unroll
        for (int q = 0; q < 4; ++q) { const size_t m = (size_t)(m0 + q * NGW);
#pragma unroll
            for (int j = 0; j < 2; ++j) xr[q][j] = *(const GAS v4u*)(R + m * D + 8 * lane + 512 * j);
            const unsigned* rec = route + m * 8; ee[q] = rec[0]; sl0[q] = rec[1]; sl1[q] = rec[2]; gw0[q] = rec[3]; gw1[q] = rec[4]; rs5[q] = rec[5]; }
#pragma unroll
        for (int q = 0; q < 4; ++q) { const int m = m0 + q * NGW;
            float v[16]; const float r = __uint_as_float(rs5[q]);
#pragma unroll
            for (int j = 0; j < 2; ++j) { const f32x4 g0 = *(const GAS f32x4*)(g + 8 * lane + 512 * j), g1 = *(const GAS f32x4*)(g + 8 * lane + 512 * j + 4); const v4u x = xr[q][j];
                v[8 * j + 0] = bflo(x.x) * (r * g0.x); v[8 * j + 1] = bfhi(x.x) * (r * g0.y); v[8 * j + 2] = bflo(x.y) * (r * g0.z); v[8 * j + 3] = bfhi(x.y) * (r * g0.w);
                v[8 * j + 4] = bflo(x.z) * (r * g1.x); v[8 * j + 5] = bfhi(x.z) * (r * g1.y); v[8 * j + 6] = bflo(x.w) * (r * g1.z); v[8 * j + 7] = bfhi(x.w) * (r * g1.w); }
            const int e0 = ee[q] & 255, e1 = (ee[q] >> 8) & 255;
            const int pos0 = base[e0] + (int)sl0[q], pos1 = base[8 + e1] + (int)sl1[q];
            rowb_store_fp8(hperm + (size_t)pos0 * D, lane, v); rowb_store_fp8(hperm + ((size_t)CAPROWS + pos1) * D, lane, v);
            if (lane == 0) { tokp[pos0] = m; tokp[CAPROWS + pos1] = m; gatep[pos0] = __uint_as_float(gw0[q]); gatep[CAPROWS + pos1] = __uint_as_float(gw1[q]); } }
    }
    __syncthreads();
}

__global__ void __launch_bounds__(NWAVES * 64, 2) mega_fwd(Args args0) {
    extern __shared__ __attribute__((aligned(16))) unsigned char lds_raw[];
    LAS unsigned char* lds = (LAS unsigned char*)lds_raw;
    volatile LAS unsigned* MISC = (volatile LAS unsigned*)(lds + MISC_OFF);
    const int G = gridDim.x;
    const int wave0 = __builtin_amdgcn_readfirstlane((int)(threadIdx.x >> 6));
    gu32* ctl = (gu32*)(args0.ws + WS_CTL);
    { const int tid = threadIdx.x;
      for (int i = tid; i < (LDS_BYTES - LDSCTL_OFF) / 4; i += NWAVES * 64) ((LAS unsigned*)(lds + LDSCTL_OFF))[i] = 0u;
      LAS float* lut = (LAS float*)(lds + LUT_OFF); const float* bt = args0.in[1];
      for (int i = tid; i < 8 * LUT_N; i += NWAVES * 64) { const int hd = i / LUT_N, n = i % LUT_N - LUT_NEG; lut[i] = (n < 0) ? -1.0e30f : 1.4426950408889634f * bt[(int)BKT[n > 128 ? 128 : n] * 8 + hd]; }
      if (tid < 256) { const float gv = __builtin_amdgcn_cvt_f32_fp8(tid, 0); ((LAS float*)(lds + SLUT_OFF))[tid] = 1.0f / (1.0f + __expf(-gv)); } }
    __syncthreads();
    XcdBarrier bar; bar.bar = (unsigned*)(ctl + CW_BAR) + args0.li * XCD_BAR_WORDS; bar.x = 0; bar.st = nullptr;
#if MK_ONE_LAUNCH
    bar = xcd_barrier_post((unsigned*)(ctl + CW_BAR) + args0.li * XCD_BAR_WORDS, MISC + 8);
#define GRID_BAR() xcd_barrier(bar)
#else
    (void)MISC;
#define GRID_BAR() do { } while (0)
#endif
    const int lo = args0.ph_lo, hi = args0.ph_hi;
#define IN(k) (lo <= (k) && (k) < hi)
#define BOTH(k) (IN(k) && IN((k) + 1))

#define OPQ_PTRS CArgs* ka_ = (CArgs*)__builtin_amdgcn_kernarg_segment_ptr(); asm volatile("" : "+s"(ka_)); CArgs& args = *ka_; unsigned char* ws = args.ws; bf16* R = (bf16*)(ws + WS_R); \
        bf16* Hn = (bf16*)(ws + WS_H); bf16* U = (bf16*)(ws + WS_U); bf16* Y = (bf16*)(ws + WS_Y); bf16* MG = (bf16*)(ws + WS_MG); float* kmean = (float*)(ws + WS_KMEAN); \
        unsigned* route = (unsigned*)(ws + WS_ROUTE); int* tokp = (int*)(ws + WS_TOK); float* gatep = (float*)(ws + WS_GATE); int* tile_e = (int*)(ws + WS_TILEE); int* n_rt = (int*)(ws + WS_TILEE + 4096); \
        (void)Hn; (void)U; (void)Y; (void)MG; (void)kmean; (void)route; (void)tokp; (void)gatep; (void)tile_e; (void)n_rt; (void)R
#define OPQ_I(name, v) int name = (v); asm volatile("" : "+s"(name))

    if (IN(0)) { OPQ_PTRS; ph_prologue(args, lds, wave0); ph_norm_bf16(args.in[0], args.in[2], Hn, ws + WS_A8, wave0); if (BOTH(0)) GRID_BAR(); }

    for (int l_ = 0; l_ < 2; ++l_) {
        const int pb = 1 + 17 * l_;
        for (int hf_ = 0; hf_ < 2; ++hf_) {
            const int p2 = pb + 1 + 5 * hf_;
            if (IN(p2)) {
                OPQ_PTRS; OPQ_I(l, l_); OPQ_I(hf, hf_); const size_t r0 = (size_t)hf * HROWS;
                const float* ssq1 = l == 0 ? (const float*)nullptr : (const float*)(ws + SSQ1_OFF) + r0 * 16;
                {
                    pg8::Gemm g{(const bf16*)(ws + WS_A8 + r0 * D), (const bf16*)(ws + WS_WG8 + (size_t)l * (WIN - GCOL0) * D), D / 2, D / 2, D / 2};
                    pg8::Order S; S.init(HROWS / 256, (WIN - GCOL0) / 256, G, (int)blockIdx.x, 0, D / 2, D / 2, nullptr, 0);
                    pg8::EpiGate8 E{(unsigned char*)U, 2 * UST, 2 * GCOL0, ssq1};
                    pg8::gemm_phase<pg8::EpiGate8, pg8::Order, true, true>(lds, fresh_tid(), g, S, E);
                }
                {
                    pg8::Gemm g{(l == 0 ? Hn : R) + r0 * D, (const bf16*)(ws + WS_WIN) + (size_t)l * GCOL0 * D, D, D, D};
                    pg8::Order S; S.init(HROWS / 256, GCOL0 / 256, G, (int)blockIdx.x, 0, D, D, nullptr, 0);
                    pg8::EpiWin E{U, UST, ssq1, 1 << 20, kmean, C_KA / 256};
                    pg8::gemm_phase<pg8::EpiWin, pg8::Order, true>(lds, fresh_tid(), g, S, E);
                }
                if (BOTH(p2)) GRID_BAR();
            }
            if (IN(p2 + 2)) {
                OPQ_PTRS; OPQ_I(l, l_);
                ph_conv_pool(args, l, U, Y, lds, wave0);
                ph_attn(args, l, U, kmean, Y, lds, wave0);
                if (BOTH(p2 + 2)) GRID_BAR();
            }
            if (IN(p2 + 3)) {
                OPQ_PTRS; OPQ_I(l, l_);
                pg8::Gemm g{Y, (const bf16*)(ws + WS_BP) + (size_t)l * 4 * D * 256, 1024, 256, 256};
                pg8::Order S; S.init(HROWS / 256, 4, G, (int)blockIdx.x, 1, 1024, 256, nullptr, (size_t)D * 256 * 2);
                pg8::EpiMerge E{U, UST, GCOL0, MG, 1024, (const LAS float*)(lds + SLUT_OFF)};
                pg8::gemm_phase<pg8::EpiMerge, pg8::Order, true>(lds, fresh_tid(), g, S, E);
                if (BOTH(p2 + 3)) GRID_BAR();
            }
            if (IN(p2 + 4)) {
                OPQ_PTRS; OPQ_I(l, l_); OPQ_I(hf, hf_); const size_t r0 = (size_t)hf * HROWS;
                pg8::Gemm g{MG, (const bf16*)(ws + WS_WOUT) + (size_t)l * D * D, D, D, D};
                pg8::Order S; S.init(HROWS / 256, 4, G, (int)blockIdx.x, 0, D, D, nullptr, 0);
                pg8::EpiRes E{args.in[0] + r0 * D, (l == 0) ? (const bf16*)nullptr : (const bf16*)(R + r0 * D), R + r0 * D, D, (l == 0) ? (float*)(ws + SSQ0_OFF) + r0 * 16 : (float*)nullptr};
                pg8::gemm_phase<pg8::EpiRes, pg8::Order, true>(lds, fresh_tid(), g, S, E);
                if (hf == 1 && BOTH(p2 + 4)) GRID_BAR();
            }
        }
        if (IN(pb + 11)) {
            OPQ_PTRS; OPQ_I(l, l_);
            if (l == 1) { ph_route(args, l, R, route, tokp, ctl, lds, wave0); if (BOTH(pb + 11)) GRID_BAR(); }
        }
        if (IN(pb + 12)) {
            OPQ_PTRS; OPQ_I(l, l_);
            if (l == 1) { ph_gather(args, l, R, route, tokp, gatep, tile_e, n_rt, ws + WS_HPERM, ctl, lds, wave0); if (BOTH(pb + 12)) GRID_BAR(); }
        }
        for (int ps_ = 0; ps_ < 2; ++ps_) {
            const int p3 = pb + 13 + 2 * ps_;
            if (IN(p3)) {
                OPQ_PTRS; OPQ_I(l, l_); OPQ_I(ps, ps_);
                if (l == 1) {
                    if (ps == 0) {
                        const int n0 = __builtin_amdgcn_readfirstlane(n_rt[0]), n1 = __builtin_amdgcn_readfirstlane(n_rt[1]);
                        pg8::Gemm g{(const bf16*)(ws + WS_HPERM), (const bf16*)(ws + WS_W13E), D / 2, D / 2, D / 2};
                        pg8::Order S; S.init(n0 + n1, 2 * FFE / 256, G, (int)blockIdx.x, 0, D / 2, D / 2, tile_e, (size_t)2 * FFE * D, n0, CAPT);
                        pg8::EpiSwiGLU8 E{ws + WS_TE, FFE, 256.0f, 8.0f};
                        pg8::gemm_phase<pg8::EpiSwiGLU8, pg8::Order, true, true>(lds, fresh_tid(), g, S, E);
                        if (BOTH(p3)) GRID_BAR();
                    }
                } else if (ps == 0) {
                    pg8::Gemm g{R, (const bf16*)(ws + WS_W13D), D, D, D};
                    pg8::Order S; S.init(M / 256, 2 * FF0 / 256, G, (int)blockIdx.x, 0, D, D, nullptr, 0);
                    pg8::EpiSwiGLU E{U, FF0, (const float*)(ws + SSQ0_OFF), 1};
                    pg8::gemm_phase<pg8::EpiSwiGLU, pg8::Order, true>(lds, fresh_tid(), g, S, E);
                    if (BOTH(p3)) GRID_BAR();
                }
            }
            if (IN(p3 + 1)) {
                OPQ_PTRS; OPQ_I(l, l_); OPQ_I(ps, ps_);
                if (l == 1) {
                    if (ps == 0) {
                        const int n0 = __builtin_amdgcn_readfirstlane(n_rt[0]), n1 = __builtin_amdgcn_readfirstlane(n_rt[1]);
                        pg8::Gemm g{(const bf16*)(ws + WS_TE), (const bf16*)(ws + WS_W2E), FFE / 2, FFE / 2, FFE / 2};
                        pg8::Order S; S.init(n0 + n1, 4, G, (int)blockIdx.x, 0, FFE / 2, FFE / 2, tile_e, (size_t)D * FFE, n0, CAPT);
                        pg8::EpiScatter E{R, D, tokp, gatep, 1.0f / 128.0f, nullptr, nullptr, (bf16*)args.out, 2048};
                        pg8::gemm_phase<pg8::EpiScatter, pg8::Order, true, true>(lds, fresh_tid(), g, S, E);
                        if (BOTH(p3 + 1)) GRID_BAR();
                    }
                } else if (ps == 0) {
                    pg8::Gemm g{U, (const bf16*)(ws + WS_W2D), FF0 / 2, FF0 / 2, FF0 / 2};
                    pg8::Order S; S.init(M / 256, 4, G, (int)blockIdx.x, 0, FF0 / 2, FF0 / 2, nullptr, 0);
                    pg8::EpiScatter E{R, D, nullptr, nullptr, 1.0f / 128.0f, (float*)(ws + SSQ1_OFF), ws + WS_A8, nullptr, 0};
                    pg8::gemm_phase<pg8::EpiScatter, pg8::Order, true, true>(lds, fresh_tid(), g, S, E);
                    if (BOTH(p3 + 1)) GRID_BAR();
                }
            }
        }
    }
    if (IN(35)) { OPQ_PTRS; ph_final_norm(R, args.in[19], args.out, wave0); }
#undef IN
#undef BOTH
}

extern "C" void kernel_launch(void* const* d_in, const int* in_sizes, int n_in, void* d_out, int out_size, void* d_ws, size_t ws_size, hipStream_t stream) {
    static int grid = 0;
    if (grid == 0) {
        if (n_in != 20 || in_sizes[0] != M * D || out_size != M * D || ws_size < WS_END) { fprintf(stderr, "kernel_launch: unexpected shapes / workspace (n_in %d, ws %zu); nothing launched\n", n_in, ws_size); grid = -1; return; }
        int dev = 0, cus = 0, per_cu = 0;
        if (hipGetDevice(&dev) != hipSuccess || hipDeviceGetAttribute(&cus, hipDeviceAttributeMultiprocessorCount, dev) != hipSuccess) { grid = -1; return; }
        if (hipFuncSetAttribute((const void*)mega_fwd, hipFuncAttributeMaxDynamicSharedMemorySize, LDS_BYTES) != hipSuccess) { fprintf(stderr, "kernel_launch: hipFuncSetAttribute failed\n"); grid = -1; return; }
        if (hipOccupancyMaxActiveBlocksPerMultiprocessor(&per_cu, (const void*)mega_fwd, NWAVES * 64, LDS_BYTES) != hipSuccess || per_cu < 1) { fprintf(stderr, "kernel_launch: occupancy query reports %d\n", per_cu); }
        (void)hipGetLastError();
        grid = cus;
    }
    if (grid < 0) return;
    if (hipMemsetAsync((char*)d_ws + WS_CTL, 0, CTL_ZERO_BYTES, stream) != hipSuccess) return;
    Args a{};
    for (int i = 0; i < 20; ++i) a.in[i] = (const float*)d_in[i];
    a.out = (float*)d_out; a.ws = (unsigned char*)d_ws;
#if MK_ONE_LAUNCH
#ifdef PROBE_DUP
    { const int dup[] = {PROBE_DUP}; const int nd = (int)(sizeof(dup) / sizeof(int)); int lo = 0;
      for (int i = 0; i <= nd; ++i) { a.ph_lo = lo; a.ph_hi = (i < nd) ? dup[i] + 1 : 36; a.li = i; hipLaunchKernelGGL(mega_fwd, dim3(grid), dim3(NWAVES * 64), LDS_BYTES, stream, a); if (i < nd) lo = dup[i]; } }
#else
    a.ph_lo = 0; a.ph_hi = 36;
    hipLaunchKernelGGL(mega_fwd, dim3(grid), dim3(NWAVES * 64), LDS_BYTES, stream, a);
#endif
#else
    for (int p = 0; p < 36; ++p) {
        if (p == 1 + 12 || p == 1 + 15 || p == 1 + 16) continue;
        a.ph_lo = p; a.ph_hi = p + 1;
        hipLaunchKernelGGL(mega_fwd, dim3(grid), dim3(NWAVES * 64), LDS_BYTES, stream, a);
    }
#endif
}
```

```cpp
#include <hip/hip_runtime.h>
#include <cstdio>
#include <cstdint>

#ifndef MK_ONE_LAUNCH
#define MK_ONE_LAUNCH 1
#endif

namespace pg8 {
#define PG8_LAS __attribute__((address_space(3)))
typedef unsigned short bf16_t;
typedef short bf16x8 __attribute__((ext_vector_type(8)));
typedef float f32x4 __attribute__((ext_vector_type(4)));
typedef unsigned u32x4 __attribute__((ext_vector_type(4)));
typedef unsigned u32x2 __attribute__((ext_vector_type(2)));
typedef int i32x4 __attribute__((ext_vector_type(4)));
typedef int i32x8 __attribute__((ext_vector_type(8)));
constexpr int BM = 256, BK = 64, HALF = 128, HTB = HALF * BK * 2  , STAGE_BYTES = 8 * HTB, NXCD = 8, WGM = 8;

__host__ __device__ __forceinline__ int lds_byte(int r, int c) { const int st = (r >> 4) * 2 + (c >> 5), rr = r & 15, cc = c & 31, ob = rr * 64 + cc * 2; return st * 1024 + (ob ^ (((ob >> 9) & 1) << 5)); }
__host__ __device__ __forceinline__ void stage_rc(int b, int& R, int& C) { const int st = b / 1024, sb = b % 1024, swz = sb ^ (((sb >> 9) & 1) << 5); R = (st >> 1) * 16 + swz / 64; C = (st & 1) * 32 + (swz % 64) / 2; }
__host__ __device__ __forceinline__ int perm32(int rho) { const int n = rho >> 4, i = rho & 15; return 8 * (i >> 2) + 4 * n + (i & 3); }

struct Unit { int pm, pn, e, prow, second; size_t aoff, boff; };
struct Gemm { const bf16_t* A; const bf16_t* Bt; int lda, ldb, K; };

struct Order {
    int nM, nN, nwg, G, c, mode, n0, skip; size_t arow  , brow  , estride; const int* tile_e;
    __device__ __forceinline__ void init(int nM_, int nN_, int G_, int c_, int mode_, int lda, int ldb, const int* te, size_t es, int n0_ = 1 << 30, int skip_ = 0) {
        nM = nM_; nN = nN_; nwg = nM * nN; G = G_; c = c_; mode = mode_; arow = (size_t)BM * lda * 2; brow = (size_t)BM * ldb * 2; tile_e = te; estride = es; n0 = n0_; skip = skip_; }
    __device__ __forceinline__ bool base(int i, Unit& u) const {
        const long L = (long)i * G + c; if (L >= nwg) return false;
        int wgid = (int)L; { const int q = nwg / NXCD, r = nwg % NXCD, xcd = wgid % NXCD, off = wgid / NXCD; wgid = (xcd < r ? xcd * (q + 1) : r * (q + 1) + (xcd - r) * q) + off; }
        const int nig = WGM * nN, gid = wgid / nig, fm = gid * WGM, gsz = (nM - fm) < WGM ? (nM - fm) : WGM;
        u.pm = fm + ((wgid % nig) % gsz); u.pn = (wgid % nig) / gsz; return true;
    }
    __device__ __forceinline__ bool next(int i, Unit& u) const {
        if (mode == 1) { if (!base(i >> 2, u)) return false; u.e = i & 3; u.prow = u.pm; u.second = 0; u.aoff = (size_t)u.pm * arow + (size_t)u.e * 512; u.boff = (size_t)u.e * estride + (size_t)u.pn * brow; return true; }
        if (!base(i, u)) return false;
        const bool second = u.pm >= n0; u.prow = second ? skip + (u.pm - n0) : u.pm; u.second = second ? 1 : 0;
        u.e = tile_e ? __builtin_amdgcn_readfirstlane(tile_e[second ? 512 + (u.pm - n0) : u.pm]) : 0; u.aoff = (size_t)u.prow * arow; u.boff = (size_t)u.e * estride + (size_t)u.pn * brow; return true;
    }
    __device__ __forceinline__ void a_ready(const Unit&) const {}
    __device__ __forceinline__ void done(const Unit&) const {}
};

__device__ __forceinline__ int fresh_lane() { int lane; asm volatile("v_mbcnt_lo_u32_b32 %0, -1, 0\n\tv_mbcnt_hi_u32_b32 %0, -1, %0" : "=v"(lane)); return lane; }
typedef float f32x2p __attribute__((ext_vector_type(2)));
typedef __bf16 bf16x2p __attribute__((ext_vector_type(2)));
__device__ __forceinline__ unsigned cvt_pk_bf16(float lo, float hi) { const f32x2p f = {lo, hi}; const bf16x2p b = __builtin_convertvector(f, bf16x2p); return __builtin_bit_cast(unsigned, b); }
__device__ __forceinline__ float bflo(unsigned w) { return __uint_as_float(w << 16); }
__device__ __forceinline__ float bfhi(unsigned w) { return __uint_as_float(w & 0xffff0000u); }
__device__ __forceinline__ float sigmoidf_(float x) { return __builtin_amdgcn_rcpf(1.0f + __expf(-x)); }

__device__ __forceinline__ void ssq_put(float* ssq, int row, int slot, float part, int lane_) {
    part += __int_as_float(__builtin_amdgcn_ds_bpermute((lane_ ^ 16) << 2, __float_as_int(part)));
    part += __int_as_float(__builtin_amdgcn_ds_bpermute((lane_ ^ 32) << 2, __float_as_int(part)));
    if (lane_ < 16) ssq[(size_t)row * 16 + slot] = part;
}
__device__ __forceinline__ float ssq_total(const float* ssq, int row, int lane_) {
    const f32x4 q = *((const f32x4*)(ssq + (size_t)row * 16) + (lane_ >> 4));
    float t = (q[0] + q[1]) + (q[2] + q[3]);
    t += __int_as_float(__builtin_amdgcn_ds_bpermute((lane_ ^ 16) << 2, __float_as_int(t)));
    t += __int_as_float(__builtin_amdgcn_ds_bpermute((lane_ ^ 32) << 2, __float_as_int(t)));
    return t;
}
__device__ __forceinline__ float ssq_rs(const float* ssq, int row, int lane_) { return __builtin_amdgcn_rsqf(ssq_total(ssq, row, lane_) * (1.0f / 1024.0f) + 1e-6f); }
__device__ __forceinline__ float ssq_ms(const float* ssq, int row, int lane_) { return ssq_total(ssq, row, lane_) * (1.0f / 1024.0f) + 1e-6f; }
__device__ __forceinline__ void ssq_totals8(const float* ssq, int row0, int lane_, float (&t)[2][4]) {
    f32x4 q[2][4];
#pragma unroll
    for (int ai = 0; ai < 2; ++ai)
#pragma unroll
        for (int m = 0; m < 4; ++m) q[ai][m] = *((const f32x4*)(ssq + (size_t)(row0 + ai * HALF + m * 16) * 16) + (lane_ >> 4));
#pragma unroll
    for (int ai = 0; ai < 2; ++ai)
#pragma unroll
        for (int m = 0; m < 4; ++m) t[ai][m] = (q[ai][m][0] + q[ai][m][1]) + (q[ai][m][2] + q[ai][m][3]);
#pragma unroll
    for (int ai = 0; ai < 2; ++ai)
#pragma unroll
        for (int m = 0; m < 4; ++m) t[ai][m] += __int_as_float(__builtin_amdgcn_ds_bpermute((lane_ ^ 16) << 2, __float_as_int(t[ai][m])));
#pragma unroll
    for (int ai = 0; ai < 2; ++ai)
#pragma unroll
        for (int m = 0; m < 4; ++m) t[ai][m] += __int_as_float(__builtin_amdgcn_ds_bpermute((lane_ ^ 32) << 2, __float_as_int(t[ai][m])));
}
struct EpiWin {
    static constexpr bool PERM = true, AFTER_DRAIN = false, BJADJ = false;
    bf16_t* O; int ldc; const float* ssq; int gate_pn; float* kmp; int kpn;
    __device__ __forceinline__ void operator()(const f32x4 (&acc)[2][2][4][2], const Unit& u, int wr, int wc, int, int) const {
        const int lane_ = fresh_lane(), fr = lane_ & 15, fq = lane_ >> 4;
        const int row0 = u.pm * BM + wr * 64 + fr, col0 = u.pn * BM + wc * 32 + 8 * fq; const bool gt = u.pn >= gate_pn;
        float tt[2][4]; if (ssq) ssq_totals8(ssq, row0, lane_, tt);
        const bool km = (u.pn == kpn); float cs[2][8];
#pragma unroll
        for (int b_ = 0; b_ < 2; ++b_)
#pragma unroll
            for (int k_ = 0; k_ < 8; ++k_) cs[b_][k_] = 0.f;
#pragma unroll
        for (int ai = 0; ai < 2; ++ai)
#pragma unroll
            for (int m = 0; m < 4; ++m) { const int r = row0 + ai * HALF + m * 16; bf16_t* rowp = O + (size_t)r * ldc;
                const float rs = ssq ? __builtin_amdgcn_rsqf(tt[ai][m] * (1.0f / 1024.0f) + 1e-6f) : 1.0f;
#pragma unroll
                for (int bj = 0; bj < 2; ++bj) { const f32x4 v0 = acc[ai][bj][m][0] * rs, v1 = acc[ai][bj][m][1] * rs;
                    if (km) { cs[bj][0] += v0[0]; cs[bj][1] += v0[1]; cs[bj][2] += v0[2]; cs[bj][3] += v0[3]; cs[bj][4] += v1[0]; cs[bj][5] += v1[1]; cs[bj][6] += v1[2]; cs[bj][7] += v1[3]; }
                    if (gt) { u32x2 w; { int t_ = 0; t_ = __builtin_amdgcn_cvt_pk_fp8_f32(v0[0], v0[1], t_, false); t_ = __builtin_amdgcn_cvt_pk_fp8_f32(v0[2], v0[3], t_, true); w.x = (unsigned)t_; }
                        { int t_ = 0; t_ = __builtin_amdgcn_cvt_pk_fp8_f32(v1[0], v1[1], t_, false); t_ = __builtin_amdgcn_cvt_pk_fp8_f32(v1[2], v1[3], t_, true); w.y = (unsigned)t_; }
                        *(u32x2*)((unsigned char*)rowp + 512 * gate_pn + (col0 - BM * gate_pn) + bj * HALF) = w; }
                    else { u32x4 w; w.x = cvt_pk_bf16(v0[0], v0[1]); w.y = cvt_pk_bf16(v0[2], v0[3]); w.z = cvt_pk_bf16(v1[0], v1[1]); w.w = cvt_pk_bf16(v1[2], v1[3]);
                        *(u32x4*)(rowp + col0 + bj * HALF) = w; } } }
        if (km) {
#pragma unroll
            for (int b_ = 0; b_ < 2; ++b_)
#pragma unroll
                for (int k_ = 0; k_ < 8; ++k_) { float x = cs[b_][k_];
#pragma unroll
                    for (int o_ = 1; o_ < 16; o_ <<= 1) x += __int_as_float(__builtin_amdgcn_ds_bpermute((lane_ ^ o_) << 2, __float_as_int(x)));
                    cs[b_][k_] = x; }
            if (fr == 0) { float* kp = kmp + ((size_t)u.pm * 2 + wr) * 256 + wc * 32 + 8 * fq;
#pragma unroll
                for (int b_ = 0; b_ < 2; ++b_) { *(f32x4*)(kp + b_ * HALF) = (f32x4){cs[b_][0], cs[b_][1], cs[b_][2], cs[b_][3]}; *(f32x4*)(kp + b_ * HALF + 4) = (f32x4){cs[b_][4], cs[b_][5], cs[b_][6], cs[b_][7]}; } }
        }
    }
};
struct EpiMerge {
    static constexpr bool PERM = true, AFTER_DRAIN = false, BJADJ = false;
    const bf16_t* U; int ldu, gcol0; bf16_t* O; int ldc; const PG8_LAS float* slut;
    __device__ __forceinline__ void operator()(const f32x4 (&acc)[2][2][4][2], const Unit& u, int wr, int wc, int, int) const {
        const int lane_ = fresh_lane(), fr = lane_ & 15, fq = lane_ >> 4;
        const int row0 = u.pm * BM + wr * 64 + fr, col0 = u.pn * BM + wc * 32 + 8 * fq;
        typedef float f32x2g __attribute__((ext_vector_type(2)));
        const __amdgpu_buffer_rsrc_t rsrc = __builtin_amdgcn_make_buffer_rsrc((void*)O, 0, 0x7fffffff, 0x00020000);
        u32x2 gqa[2][4][2];
#pragma unroll
        for (int ai = 0; ai < 2; ++ai)
#pragma unroll
            for (int m = 0; m < 4; ++m) { const size_t r = (size_t)(row0 + ai * HALF + m * 16);
                const u32x4 g16 = *(const u32x4*)((const unsigned char*)(U + r * ldu) + 2 * gcol0 + u.e * 1024 + u.pn * BM + (fq & 1) * HALF + wc * 32 + 8 * (fq & 2));
                typedef unsigned u2_ __attribute__((ext_vector_type(2)));
                const u2_ s0 = __builtin_amdgcn_permlane16_swap(g16.x, g16.z, false, false), s1 = __builtin_amdgcn_permlane16_swap(g16.y, g16.w, false, false);
                gqa[ai][m][0] = (u32x2){s0.x, s1.x}; gqa[ai][m][1] = (u32x2){s0.y, s1.y}; }
#pragma unroll
        for (int ai = 0; ai < 2; ++ai) {
            u32x2 gq[4][2]; u32x4 pq[4][2];
#pragma unroll
            for (int m = 0; m < 4; ++m) { const size_t r = (size_t)(row0 + ai * HALF + m * 16); const bf16_t* rowp = O + r * ldc + col0;
                gq[m][0] = gqa[ai][m][0]; gq[m][1] = gqa[ai][m][1];
#pragma unroll
                for (int bj = 0; bj < 2; ++bj) { if (u.e != 0) pq[m][bj] = __builtin_bit_cast(u32x4, __builtin_amdgcn_raw_buffer_load_b128(rsrc, (int)((r * ldc + col0 + bj * HALF) * 2), 0, 16  )); else pq[m][bj] = (u32x4){0u, 0u, 0u, 0u}; } }
#pragma unroll
            for (int m = 0; m < 4; ++m) { const size_t r = (size_t)(row0 + ai * HALF + m * 16); bf16_t* rowp = O + r * ldc + col0;
#pragma unroll
                for (int bj = 0; bj < 2; ++bj) { const f32x4 a0 = acc[ai][bj][m][0], a1 = acc[ai][bj][m][1]; const u32x2 g = gq[m][bj]; const u32x4 p = pq[m][bj];
                    const float s0 = slut[g.x & 0xffu], s1 = slut[(g.x >> 8) & 0xffu], s2 = slut[(g.x >> 16) & 0xffu], s3 = slut[g.x >> 24], s4 = slut[g.y & 0xffu], s5 = slut[(g.y >> 8) & 0xffu], s6 = slut[(g.y >> 16) & 0xffu], s7 = slut[g.y >> 24];
                    const float v0 = a0[0] * s0 + bflo(p.x), v1 = a0[1] * s1 + bfhi(p.x), v2 = a0[2] * s2 + bflo(p.y), v3 = a0[3] * s3 + bfhi(p.y);
                    const float v4 = a1[0] * s4 + bflo(p.z), v5 = a1[1] * s5 + bfhi(p.z), v6 = a1[2] * s6 + bflo(p.w), v7 = a1[3] * s7 + bfhi(p.w);
                    u32x4 w; w.x = cvt_pk_bf16(v0, v1); w.y = cvt_pk_bf16(v2, v3); w.z = cvt_pk_bf16(v4, v5); w.w = cvt_pk_bf16(v6, v7);
                    *(u32x4*)(rowp + bj * HALF) = w; } }
        }
    }
};
struct EpiRes {
    static constexpr bool PERM = true, AFTER_DRAIN = false, BJADJ = false;
    const float* base; const bf16_t* bb; bf16_t* out; int ldc; float* ssq;
    __device__ __forceinline__ void operator()(const f32x4 (&acc)[2][2][4][2], const Unit& u, int wr, int wc, int, int) const {
        const int lane_ = fresh_lane(), fr = lane_ & 15, fq = lane_ >> 4;
        const int row0 = u.pm * BM + wr * 64 + fr, col0 = u.pn * BM + wc * 32 + 8 * fq;
        const __amdgpu_buffer_rsrc_t rsrc = __builtin_amdgcn_make_buffer_rsrc((void*)bb, 0, 0x7fffffff, 0x00020000);
        u32x4 pq[2][4][2];
#pragma unroll
        for (int ai = 0; ai < 2; ++ai)
#pragma unroll
            for (int m = 0; m < 4; ++m) { const size_t off = (size_t)(row0 + ai * HALF + m * 16) * ldc + col0;
#pragma unroll
                for (int bj = 0; bj < 2; ++bj) pq[ai][m][bj] = __builtin_bit_cast(u32x4, __builtin_amdgcn_raw_buffer_load_b128(rsrc, (int)((off + bj * HALF) * 2), 0, 16  )); }
#pragma unroll
        for (int ai = 0; ai < 2; ++ai)
#pragma unroll
            for (int m = 0; m < 4; ++m) { const size_t off = (size_t)(row0 + ai * HALF + m * 16) * ldc + col0; float sq = 0.f;
#pragma unroll
                for (int bj = 0; bj < 2; ++bj) { const u32x4 p = pq[ai][m][bj];
                    const f32x4 v0 = acc[ai][bj][m][0] + (f32x4){bflo(p.x), bfhi(p.x), bflo(p.y), bfhi(p.y)}, v1 = acc[ai][bj][m][1] + (f32x4){bflo(p.z), bfhi(p.z), bflo(p.w), bfhi(p.w)};
                    sq += (v0[0] * v0[0] + v0[1] * v0[1]) + (v0[2] * v0[2] + v0[3] * v0[3]) + (v1[0] * v1[0] + v1[1] * v1[1]) + (v1[2] * v1[2] + v1[3] * v1[3]);
                    u32x4 w; w.x = cvt_pk_bf16(v0[0], v0[1]); w.y = cvt_pk_bf16(v0[2], v0[3]); w.z = cvt_pk_bf16(v1[0], v1[1]); w.w = cvt_pk_bf16(v1[2], v1[3]);
                    *(u32x4*)(out + off + bj * HALF) = w; }
                if (ssq) ssq_put(ssq, row0 + ai * HALF + m * 16, u.pn * 4 + wc, sq, lane_); }
    }
};
__device__ __forceinline__ unsigned cvt4_fp8(float a, float b, float c, float d) { int w = 0; w = __builtin_amdgcn_cvt_pk_fp8_f32(a, b, w, false); w = __builtin_amdgcn_cvt_pk_fp8_f32(c, d, w, true); return (unsigned)w; }
__device__ __forceinline__ u32x4 pair16(u32x2 wa, u32x2 wb) {
    typedef unsigned u2_ __attribute__((ext_vector_type(2)));
    const u2_ s0 = __builtin_amdgcn_permlane16_swap(wa.x, wb.x, false, false), s1 = __builtin_amdgcn_permlane16_swap(wa.y, wb.y, false, false);
    return (u32x4){s0.x, s1.x, s0.y, s1.y};
}
struct EpiSwiGLU {
    static constexpr bool PERM = true, AFTER_DRAIN = false, BJADJ = false;
    bf16_t* T; int ldt; const float* ssq; int f8;
    __device__ __forceinline__ void calc(const f32x4 (&acc)[2][2][4][2], int ai, int m, float tot, float (&v)[8]) const {
        const float q = ssq ? tot * (1.0f / 1024.0f) + 1e-6f : 1.0f; const float nk = -1.44269504f * __builtin_amdgcn_rsqf(q);
        const float qd = f8 ? 0.25f * q : q; const f32x2p nk2 = {nk, nk}, q2 = {qd, qd};
#pragma unroll
        for (int n = 0; n < 2; ++n)
#pragma unroll
            for (int h = 0; h < 2; ++h) { const f32x2p a2 = {acc[ai][0][m][n][2 * h], acc[ai][0][m][n][2 * h + 1]}, b2 = {acc[ai][1][m][n][2 * h], acc[ai][1][m][n][2 * h + 1]};
                const f32x2p x2 = a2 * nk2; const f32x2p e2 = {__builtin_amdgcn_exp2f(x2[0]), __builtin_amdgcn_exp2f(x2[1])};
                const f32x2p d2 = e2 * q2 + q2; const f32x2p r2 = {__builtin_amdgcn_rcpf(d2[0]), __builtin_amdgcn_rcpf(d2[1])};
                const f32x2p v2 = (a2 * b2) * r2; v[n * 4 + 2 * h] = v2[0]; v[n * 4 + 2 * h + 1] = v2[1]; }
    }
    __device__ __forceinline__ void operator()(const f32x4 (&acc)[2][2][4][2], const Unit& u, int wr, int wc, int, int) const {
        const int lane_ = fresh_lane(), fr = lane_ & 15, fq = lane_ >> 4;
        const int row0 = u.pm * BM + wr * 64 + fr, col0 = u.pn * HALF + wc * 32 + 8 * fq;
        float tt[2][4] = {{0.f, 0.f, 0.f, 0.f}, {0.f, 0.f, 0.f, 0.f}}; if (ssq) ssq_totals8(ssq, row0, lane_, tt);
#pragma unroll
        for (int ai = 0; ai < 2; ++ai)
#pragma unroll
            for (int mp = 0; mp < 2; ++mp) { const int ra = row0 + ai * HALF + (2 * mp) * 16, rb = ra + 16; float va[8], vb[8];
                calc(acc, ai, 2 * mp, tt[ai][2 * mp], va); calc(acc, ai, 2 * mp + 1, tt[ai][2 * mp + 1], vb);
                if (f8) {
                    u32x2 wa, wb; wa.x = cvt4_fp8(va[0], va[1], va[2], va[3]); wa.y = cvt4_fp8(va[4], va[5], va[6], va[7]); wb.x = cvt4_fp8(vb[0], vb[1], vb[2], vb[3]); wb.y = cvt4_fp8(vb[4], vb[5], vb[6], vb[7]);
                    const u32x4 w16 = pair16(wa, wb);
                    *(u32x4*)((unsigned char*)T + (size_t)((fq & 1) ? rb : ra) * ldt + u.pn * HALF + wc * 32 + 8 * (fq & 2)) = w16; }
                else { u32x4 w; w.x = cvt_pk_bf16(va[0], va[1]); w.y = cvt_pk_bf16(va[2], va[3]); w.z = cvt_pk_bf16(va[4], va[5]); w.w = cvt_pk_bf16(va[6], va[7]); *(u32x4*)(T + (size_t)ra * ldt + col0) = w;
                    w.x = cvt_pk_bf16(vb[0], vb[1]); w.y = cvt_pk_bf16(vb[2], vb[3]); w.z = cvt_pk_bf16(vb[4], vb[5]); w.w = cvt_pk_bf16(vb[6], vb[7]); *(u32x4*)(T + (size_t)rb * ldt + col0) = w; } }
    }
};
struct EpiSwiGLU8 {
    static constexpr bool PERM = true, AFTER_DRAIN = false, BJADJ = false;
    unsigned char* T; int ldt; float cc, lc;
    __device__ __forceinline__ u32x2 calc(const f32x4 (&acc)[2][2][4][2], int ai, int m) const {
        float v[8];
        const f32x2p nk2 = {-1.44269504f * 0.03125f, -1.44269504f * 0.03125f}, l2 = {lc, lc}, c2 = {cc, cc};
#pragma unroll
        for (int n = 0; n < 2; ++n)
#pragma unroll
            for (int h = 0; h < 2; ++h) { const f32x2p a2 = {acc[ai][0][m][n][2 * h], acc[ai][0][m][n][2 * h + 1]}, b2 = {acc[ai][1][m][n][2 * h], acc[ai][1][m][n][2 * h + 1]};
                const f32x2p x2 = a2 * nk2 + l2; const f32x2p e2 = {__builtin_amdgcn_exp2f(x2[0]), __builtin_amdgcn_exp2f(x2[1])};
                const f32x2p d2 = e2 + c2; const f32x2p r2 = {__builtin_amdgcn_rcpf(d2[0]), __builtin_amdgcn_rcpf(d2[1])};
                const f32x2p v2 = (a2 * b2) * r2; v[n * 4 + 2 * h] = v2[0]; v[n * 4 + 2 * h + 1] = v2[1]; }
        u32x2 w; w.x = cvt4_fp8(v[0], v[1], v[2], v[3]); w.y = cvt4_fp8(v[4], v[5], v[6], v[7]); return w;
    }
    __device__ __forceinline__ void operator()(const f32x4 (&acc)[2][2][4][2], const Unit& u, int wr, int wc, int, int) const {
        const int lane_ = fresh_lane(), fr = lane_ & 15, fq = lane_ >> 4;
        const int row0 = u.prow * BM + wr * 64 + fr;
#pragma unroll
        for (int ai = 0; ai < 2; ++ai)
#pragma unroll
            for (int mp = 0; mp < 2; ++mp) {
                const u32x4 w16 = pair16(calc(acc, ai, 2 * mp), calc(acc, ai, 2 * mp + 1));
                *(u32x4*)(T + (size_t)(row0 + ai * HALF + (2 * mp + (fq & 1)) * 16) * ldt + u.pn * HALF + wc * 32 + 8 * (fq & 2)) = w16; }
    }
};
struct EpiGate8 {
    static constexpr bool PERM = true, AFTER_DRAIN = false, BJADJ = true;
    unsigned char* O; int ldo, goff; const float* ssq;
    __device__ __forceinline__ void operator()(const f32x4 (&acc)[2][2][4][2], const Unit& u, int wr, int wc, int, int) const {
        const int lane_ = fresh_lane(), fr = lane_ & 15, fq = lane_ >> 4;
        const int row0 = u.pm * BM + wr * 64 + fr;
        float tt[2][4]; if (ssq) ssq_totals8(ssq, row0, lane_, tt);
#pragma unroll
        for (int ai = 0; ai < 2; ++ai)
#pragma unroll
            for (int m = 0; m < 4; ++m) { const int r = row0 + ai * HALF + m * 16;
                const float rs = (ssq ? __builtin_amdgcn_rsqf(tt[ai][m] * (1.0f / 1024.0f) + 1e-6f) : 1.0f) * 0.03125f;
                u32x2 w[2];
#pragma unroll
                for (int bj = 0; bj < 2; ++bj) { const f32x4 v0 = acc[ai][bj][m][0] * rs, v1 = acc[ai][bj][m][1] * rs; w[bj].x = cvt4_fp8(v0[0], v0[1], v0[2], v0[3]); w[bj].y = cvt4_fp8(v1[0], v1[1], v1[2], v1[3]); }
                *(u32x4*)(O + (size_t)r * ldo + goff + u.pn * BM + wc * 64 + (fq & 1) * 32 + 8 * (fq & 2)) = pair16(w[0], w[1]); }
    }
};
struct EpiScatter {
    static constexpr bool PERM = true, AFTER_DRAIN = false, BJADJ = false;
    bf16_t* R; int ldc; const int* tok; const float* gate; float scale; float* ssq; unsigned char* r8; bf16_t* Z; int ldz;
    __device__ __forceinline__ void operator()(const f32x4 (&acc)[2][2][4][2], const Unit& u, int wr, int wc, int, int) const {
        const int lane_ = fresh_lane(), fr = lane_ & 15, fq = lane_ >> 4;
        const int row0 = u.prow * BM + wr * 64 + fr, col0 = u.pn * BM + wc * 32 + 8 * fq;
        if (Z) {
            int tkz[2][4]; float ggz[2][4];
#pragma unroll
            for (int ai = 0; ai < 2; ++ai)
#pragma unroll
                for (int m = 0; m < 4; ++m) { const int r = row0 + ai * HALF + m * 16; tkz[ai][m] = tok[r]; ggz[ai][m] = gate[r] * scale; }
            asm volatile("" ::: "memory");
#pragma unroll
            for (int ai = 0; ai < 2; ++ai)
#pragma unroll
                for (int m = 0; m < 4; ++m) { const int t = tkz[ai][m]; const float g = ggz[ai][m];
                    if (t >= 0) { bf16_t* zp = Z + (size_t)t * ldz + u.second * 1024 + col0;
#pragma unroll
                        for (int bj = 0; bj < 2; ++bj) { const f32x4 a0 = acc[ai][bj][m][0] * g, a1 = acc[ai][bj][m][1] * g;
                            u32x4 w; w.x = cvt_pk_bf16(a0[0], a0[1]); w.y = cvt_pk_bf16(a0[2], a0[3]); w.z = cvt_pk_bf16(a1[0], a1[1]); w.w = cvt_pk_bf16(a1[2], a1[3]);
                            *(u32x4*)(zp + bj * HALF) = w; } } }
            return; }
        const __amdgpu_buffer_rsrc_t rsrc = __builtin_amdgcn_make_buffer_rsrc((void*)R, 0, 0x7fffffff, 0x00020000);
        int tk[2][4]; float gg[2][4];
#pragma unroll
        for (int ai = 0; ai < 2; ++ai)
#pragma unroll
            for (int m = 0; m < 4; ++m) { const int r = row0 + ai * HALF + m * 16; tk[ai][m] = tok ? tok[r] : r; gg[ai][m] = tok ? gate[r] * scale : scale; }
#pragma unroll
        for (int ai = 0; ai < 2; ++ai) {
            u32x4 pq[4][2];
#pragma unroll
            for (int m = 0; m < 4; ++m) { const int t = tk[ai][m] < 0 ? 0 : tk[ai][m]; const bf16_t* rp = R + (size_t)t * ldc + col0;
#pragma unroll
                for (int bj = 0; bj < 2; ++bj) pq[m][bj] = __builtin_bit_cast(u32x4, __builtin_amdgcn_raw_buffer_load_b128(rsrc, (int)(((size_t)t * ldc + col0 + bj * HALF) * 2), 0, 16  )); (void)rp; }
#pragma unroll
            for (int m = 0; m < 4; ++m) { const int t = tk[ai][m]; const float g = gg[ai][m];
                if (t >= 0) { bf16_t* rp = R + (size_t)t * ldc + col0; float sq = 0.f;
#pragma unroll
                    for (int bj = 0; bj < 2; ++bj) { const u32x4 p = pq[m][bj]; const f32x4 a0 = acc[ai][bj][m][0] * g, a1 = acc[ai][bj][m][1] * g;
                        const float e0 = bflo(p.x) + a0[0], e1 = bfhi(p.x) + a0[1], e2 = bflo(p.y) + a0[2], e3 = bfhi(p.y) + a0[3], e4 = bflo(p.z) + a1[0], e5 = bfhi(p.z) + a1[1], e6 = bflo(p.w) + a1[2], e7 = bfhi(p.w) + a1[3];
                        sq += (e0 * e0 + e1 * e1) + (e2 * e2 + e3 * e3) + (e4 * e4 + e5 * e5) + (e6 * e6 + e7 * e7);
                        u32x4 w; w.x = cvt_pk_bf16(e0, e1); w.y = cvt_pk_bf16(e2, e3); w.z = cvt_pk_bf16(e4, e5); w.w = cvt_pk_bf16(e6, e7);
                        *(u32x4*)(rp + bj * HALF) = w;
                        if (r8) { u32x2 w8; w8.x = cvt4_fp8(e0, e1, e2, e3); w8.y = cvt4_fp8(e4, e5, e6, e7); *(u32x2*)(r8 + (size_t)t * 1024 + col0 + bj * HALF) = w8; } }
                    if (ssq) ssq_put(ssq, row0 + ai * HALF + m * 16, u.pn * 4 + wc, sq, lane_); } }
        }
    }
};

template <class Epi, class Sched, bool ALIGN_EPI = false, bool FP8 = false>
__device__ __forceinline__ void gemm_phase(PG8_LAS unsigned char* lds, const int tid, const Gemm g, const Sched& S, const Epi& E) {
    const int wid = __builtin_amdgcn_readfirstlane(tid >> 6), lane = tid & 63, wr = wid >> 2, wc = wid & 3, fr = lane & 15, fq = lane >> 4;
    const int K = g.K, nt = K / BK;
    unsigned voffA, voffB;
    { int R, C; stage_rc(tid * 16, R, C); const int Rb = Epi::PERM ? ((Epi::BJADJ ? (R >> 5) * 64 : (R & ~31)) + perm32(R & 31)) : R;
      voffA = (unsigned)(R * g.lda + C) * 2u; voffB = (unsigned)(Rb * g.ldb + C) * 2u; }
    const size_t rstepA = (size_t)64 * g.lda * 2, rstepB = (size_t)(Epi::BJADJ ? 128 : 64) * g.ldb * 2;
    const size_t kstep = (size_t)(BK * 2);
    const size_t hstepA = (size_t)HALF * g.lda * 2, hstepB = (size_t)(Epi::BJADJ ? 32 : HALF) * g.ldb * 2;
    const unsigned ldsw = (unsigned)wid * 1024u;
    const int aoff = lds_byte(wr * 64 + fr, fq * 8), boff = lds_byte(wc * 32 + fr, fq * 8);
#define PG8_SA(b, h) (((b) * 2 + (h)) * HTB)
#define PG8_SB(b, h) ((4 + (b) * 2 + (h)) * HTB)
#define PG8_STAGE(bufoff, gbase, voff) do { _Pragma("unroll") for (int _i = 0; _i < 2; ++_i) { const char* gb_ = (const char*)(gbase) + (size_t)_i * rstep##voff; asm volatile("" : "+s"(gb_));     \
        __builtin_amdgcn_global_load_lds((const unsigned*)(gb_ + (voff)), (PG8_LAS unsigned*)(lds + (bufoff) + ldsw + _i * 8192), 16, 0, 0); } } while (0)
#define rstepvoffA rstepA
#define rstepvoffB rstepB
#define PG8_LDA(dst, b, h) do { if constexpr (FP8) { _Pragma("unroll") for (int m = 0; m < 4; ++m) dst##8[m] = __builtin_shufflevector(*(const PG8_LAS i32x4*)(lds + PG8_SA(b, h) + aoff + m * 2048), *(const PG8_LAS i32x4*)(lds + PG8_SA(b, h) + aoff + m * 2048 + 1024), 0, 1, 2, 3, 4, 5, 6, 7); } \
        else { _Pragma("unroll") for (int m = 0; m < 4; ++m) _Pragma("unroll") for (int k = 0; k < 2; ++k) dst[m][k] = *(const PG8_LAS bf16x8*)(lds + PG8_SA(b, h) + aoff + m * 2048 + k * 1024); } } while (0)
#define PG8_LDB(dst, b, h) do { if constexpr (FP8) { _Pragma("unroll") for (int n = 0; n < 2; ++n) dst##8[n] = __builtin_shufflevector(*(const PG8_LAS i32x4*)(lds + PG8_SB(b, h) + boff + n * 2048), *(const PG8_LAS i32x4*)(lds + PG8_SB(b, h) + boff + n * 2048 + 1024), 0, 1, 2, 3, 4, 5, 6, 7); } \
        else { _Pragma("unroll") for (int n = 0; n < 2; ++n) _Pragma("unroll") for (int k = 0; k < 2; ++k) dst[n][k] = *(const PG8_LAS bf16x8*)(lds + PG8_SB(b, h) + boff + n * 2048 + k * 1024); } } while (0)
#define PG8_MMA(ai, bj, At, Bt) do { __builtin_amdgcn_s_setprio(1); \
        if constexpr (FP8) { _Pragma("unroll") for (int m = 0; m < 4; ++m) _Pragma("unroll") for (int n = 0; n < 2; ++n) \
            acc[ai][bj][m][n] = __builtin_amdgcn_mfma_scale_f32_16x16x128_f8f6f4(Bt##8[n], At##8[m], acc[ai][bj][m][n], 0, 0, 0, 0x7f7f7f7f, 0, 0x7f7f7f7f); }   \
        else { _Pragma("unroll") for (int m = 0; m < 4; ++m) _Pragma("unroll") for (int n = 0; n < 2; ++n) _Pragma("unroll") for (int k = 0; k < 2; ++k) \
            acc[ai][bj][m][n] = __builtin_amdgcn_mfma_f32_16x16x32_bf16(Bt[n][k], At[m][k], acc[ai][bj][m][n], 0, 0, 0); } \
        __builtin_amdgcn_s_setprio(0); } while (0)
#define PG8_MMA0(ai, bj, At, Bt) do { __builtin_amdgcn_s_setprio(1);     \
        if constexpr (FP8) { _Pragma("unroll") for (int m = 0; m < 4; ++m) _Pragma("unroll") for (int n = 0; n < 2; ++n) \
            acc[ai][bj][m][n] = __builtin_amdgcn_mfma_scale_f32_16x16x128_f8f6f4(Bt##8[n], At##8[m], (f32x4){0.f, 0.f, 0.f, 0.f}, 0, 0, 0, 0x7f7f7f7f, 0, 0x7f7f7f7f); } \
        else { _Pragma("unroll") for (int m = 0; m < 4; ++m) _Pragma("unroll") for (int n = 0; n < 2; ++n) { \
            acc[ai][bj][m][n] = __builtin_amdgcn_mfma_f32_16x16x32_bf16(Bt[n][0], At[m][0], (f32x4){0.f, 0.f, 0.f, 0.f}, 0, 0, 0); \
            acc[ai][bj][m][n] = __builtin_amdgcn_mfma_f32_16x16x32_bf16(Bt[n][1], At[m][1], acc[ai][bj][m][n], 0, 0, 0); } } \
        __builtin_amdgcn_s_setprio(0); } while (0)
#define PG8_WAIT_V(n) asm volatile("s_waitcnt vmcnt(" #n ")" ::: "memory")
#define PG8_WAIT_L(n) asm volatile("s_waitcnt lgkmcnt(" #n ")" ::: "memory")
#define PG8_BAR __builtin_amdgcn_s_barrier()
#define PG8_SCHED __builtin_amdgcn_sched_barrier(0)
    Unit cur, nxt; int ui = 0;
    if (!S.next(0, cur)) return;
    f32x4 acc[2][2][4][2];
    bf16x8 At[4][2], B0[2][2], B1[2][2]; i32x8 At8[4], B08[2], B18[2];
    const char* cA = (const char*)g.A + cur.aoff; const char* cB = (const char*)g.Bt + cur.boff;
    S.a_ready(cur);
    PG8_STAGE(PG8_SB(0, 0), cB, voffB); PG8_STAGE(PG8_SB(0, 1), cB + hstepB, voffB); PG8_STAGE(PG8_SA(0, 0), cA, voffA); PG8_STAGE(PG8_SA(0, 1), cA + hstepA, voffA);
    if (wr == 1) PG8_BAR;
    PG8_WAIT_V(2); PG8_BAR;
    PG8_STAGE(PG8_SB(1, 0), cB + kstep, voffB); PG8_STAGE(PG8_SA(1, 0), cA + kstep, voffA); PG8_STAGE(PG8_SB(1, 1), cB + hstepB + kstep, voffB);
    PG8_WAIT_V(6); PG8_BAR;
    for (;;) {
        const bool has_next = S.next(ui + 1, nxt);
        const char* nA = has_next ? (const char*)g.A + nxt.aoff : cA; const char* nB = has_next ? (const char*)g.Bt + nxt.boff : cB;
#define PG8_KITER(MMAX) \
            const bool last = (t == nt - 2); \
            const char* a1 = cA + (size_t)(t + 1) * kstep; \
            const char* a2 = last ? nA : cA + (size_t)(t + 2) * kstep; const char* b2 = last ? nB : cB + (size_t)(t + 2) * kstep; \
            const char* a3 = a2 + kstep; const char* b3 = b2 + kstep; \
            if (last && has_next) S.a_ready(nxt); \
            PG8_LDB(B0, 0, 0); PG8_LDB(B1, 0, 1); PG8_SCHED; PG8_LDA(At, 0, 0); PG8_STAGE(PG8_SA(1, 1), a1 + hstepA, voffA); \
            PG8_WAIT_V(8); PG8_WAIT_L(0); PG8_BAR; MMAX(0, 0, At, B0); MMAX(0, 1, At, B1); PG8_BAR; PG8_SCHED; \
            PG8_LDA(At, 0, 1); PG8_STAGE(PG8_SB(0, 0), b2, voffB); PG8_STAGE(PG8_SB(0, 1), b2 + hstepB, voffB); PG8_STAGE(PG8_SA(0, 0), a2, voffA); \
            PG8_WAIT_V(8); PG8_WAIT_L(0); PG8_BAR; MMAX(1, 0, At, B0); MMAX(1, 1, At, B1); PG8_BAR; PG8_SCHED; \
            PG8_LDB(B0, 1, 0); PG8_LDB(B1, 1, 1); PG8_SCHED; PG8_LDA(At, 1, 0); PG8_STAGE(PG8_SA(0, 1), a2 + hstepA, voffA); \
            PG8_WAIT_V(8); PG8_WAIT_L(0); PG8_BAR; PG8_MMA(0, 0, At, B0); PG8_MMA(0, 1, At, B1); PG8_BAR; PG8_SCHED; \
            PG8_LDA(At, 1, 1); PG8_STAGE(PG8_SB(1, 0), b3, voffB); PG8_STAGE(PG8_SB(1, 1), b3 + hstepB, voffB); PG8_STAGE(PG8_SA(1, 0), a3, voffA); \
            PG8_WAIT_V(8); PG8_WAIT_L(0); PG8_BAR; PG8_MMA(1, 0, At, B0); PG8_MMA(1, 1, At, B1); PG8_BAR; PG8_SCHED;
        { const int t = 0; PG8_KITER(PG8_MMA0) }
#pragma unroll 1
        for (int t = 2; t < nt; t += 2) { PG8_KITER(PG8_MMA) }
#undef PG8_KITER
        if constexpr (ALIGN_EPI) { if (wr == 0) PG8_BAR; }
        E(acc, cur, wr, wc, fr, fq); S.done(cur);
        if (!has_next) break;
        cur = nxt; cA = nA; cB = nB; ++ui;
        if constexpr (ALIGN_EPI) { if (wr == 1) PG8_BAR; }
    }
    PG8_WAIT_V(0);
    if constexpr (!ALIGN_EPI) { if (wr == 0) PG8_BAR; }
    PG8_BAR;
#undef PG8_SA
#undef PG8_SB
#undef PG8_STAGE
#undef rstepvoffA
#undef rstepvoffB
#undef PG8_LDA
#undef PG8_LDB
#undef PG8_MMA
#undef PG8_MMA0
#undef PG8_WAIT_V
#undef PG8_WAIT_L
#undef PG8_BAR
#undef PG8_SCHED
}
}

constexpr int NB = 32, SEQ = 2048, D = 1024, M = NB * SEQ;
constexpr int WIN = 6656, GCOL0 = 2560;
constexpr int UST = 4608;
constexpr int FF0 = 2816, FFE = 3584, NEXP = 8;
constexpr int HROWS = M / 2, HB = NB / 2;
constexpr int CAPROWS = M + NEXP * 256, CAPT = CAPROWS / 256;
constexpr float RMS_EPS = 1e-6f, SUBLN_EPS = 1e-5f;
constexpr int NWAVES = 8;
constexpr int C_QA = 0, C_KA = 256, C_VA = 512, C_XB = 768, C_BB = 1024, C_CB = 1280, C_PC = 1536, C_QD = 1792, C_KD = 2048, C_VD = 2304;

constexpr size_t MiB = 1u << 20;
constexpr size_t WS_CTL = 0, CTL_ZERO_BYTES = 1 * MiB;
constexpr size_t WS_ROUTE = 2 * MiB;
constexpr size_t WS_TOK = 4 * MiB;
constexpr size_t WS_GATE = 5 * MiB;
constexpr size_t WS_TILEE = 6 * MiB;
constexpr size_t WS_KMEAN = 7 * MiB;
constexpr size_t WS_WIN = 8 * MiB;
constexpr size_t WS_WG8 = 24 * MiB;
constexpr size_t WS_BP = 34 * MiB;
constexpr size_t WS_WOUT = 38 * MiB;
constexpr size_t WS_W13D = 42 * MiB;
constexpr size_t WS_W2D = 53 * MiB;
constexpr size_t WS_W13E = 60 * MiB;
constexpr size_t WS_W2E = 116 * MiB;
constexpr size_t WS_R = 144 * MiB;
constexpr size_t WS_H = 272 * MiB;
constexpr size_t WS_U = 400 * MiB;
constexpr size_t WS_A8 = 752 * MiB;
constexpr size_t WS_Y = 816 * MiB;
constexpr size_t WS_MG = 880 * MiB;
constexpr size_t WS_HPERM = 272 * MiB;
constexpr size_t WS_TE = 404 * MiB;
constexpr size_t SSQX_OFF = 952 * MiB;
constexpr size_t WS_END = 956 * MiB;
static_assert(WS_W13E + (size_t)8 * 2 * FFE * D <= WS_W2E && WS_W2E + (size_t)8 * D * FFE <= WS_R && WS_U + (size_t)HROWS * UST * 2 <= WS_A8 && WS_A8 + (size_t)M * D <= WS_Y && WS_HPERM + 2 * (size_t)CAPROWS * D <= WS_TE && WS_TE + 2 * (size_t)CAPROWS * FFE <= WS_END - 8 * MiB && WS_U + (size_t)M * FF0 * 2 <= WS_A8 && WS_MG + (size_t)HROWS * D * 2 <= WS_END, "d_ws map");
constexpr int CW_BAR = 4096;
constexpr int CW_QUEUE = 16384;
constexpr int CW_CNT = 20480;
constexpr size_t SSQ0_OFF = 944 * MiB, SSQ1_OFF = 948 * MiB;

constexpr int RING_BYTES = 131072;
constexpr int LUT_OFF = RING_BYTES;
constexpr int LUT_N = 320, LUT_NEG = 96;
constexpr int SLUT_OFF = LUT_OFF + 8 * LUT_N * 4;
constexpr int LDSCTL_OFF = RING_BYTES + 12288, MISC_OFF = LDSCTL_OFF + 320;
constexpr int LDS_BYTES = 147456;

#define GAS __attribute__((address_space(1)))
#define LAS __attribute__((address_space(3)))
typedef unsigned short bf16;
typedef unsigned v4u __attribute__((ext_vector_type(4)));
typedef unsigned v2u __attribute__((ext_vector_type(2)));
typedef float f32x4 __attribute__((ext_vector_type(4)));
typedef GAS unsigned gu32;
#define RLX_AGENT __ATOMIC_RELAXED, __HIP_MEMORY_SCOPE_AGENT
#define LDS_WAIT() asm volatile("s_waitcnt lgkmcnt(0)" ::: "memory")
#define VM_WAIT() asm volatile("s_waitcnt vmcnt(0)" ::: "memory")
__device__ __forceinline__ unsigned f2bf(float f) { unsigned u = __builtin_bit_cast(unsigned, f); return (u + 0x7fffu + ((u >> 16) & 1u)) >> 16; }
__device__ __forceinline__ unsigned pk2(float lo, float hi) { return f2bf(lo) | (f2bf(hi) << 16); }
__device__ __forceinline__ float bflo(unsigned w) { return __uint_as_float(w << 16); }
__device__ __forceinline__ float bfhi(unsigned w) { return __uint_as_float(w & 0xffff0000u); }

#define XB_TMO      128
#define XB_XCNT(j)  (256  + 64 * (j))
#define XB_XSUB(j)  (1280 + 64 * (j))
#define XB_XGEN(j)  (2304 + 64 * (j))
#define XB_TOP      3328
#define XB_TOPGEN   3392
#define XCD_BAR_WORDS 3456
#define XB_SPIN_CAP (1u << 22)

__device__ __forceinline__ unsigned xb_ld(unsigned* p)              { return __hip_atomic_load(p, __ATOMIC_RELAXED, __HIP_MEMORY_SCOPE_AGENT); }
__device__ __forceinline__ unsigned xb_add(unsigned* p, unsigned v) { return __hip_atomic_fetch_add(p, v, __ATOMIC_RELAXED, __HIP_MEMORY_SCOPE_AGENT); }
__device__ __forceinline__ unsigned xb_xcc_id() { return (unsigned)__builtin_amdgcn_s_getreg((3 << 11) | 20) & 0xFu; }
#define XB_SPIN(cond, bar) do { unsigned _sp = 0; while (cond) { __builtin_amdgcn_s_sleep(1); \
    if ((++_sp & 255u) == 0u) { if (xb_ld(&(bar)[XB_TMO])) break; if (_sp > XB_SPIN_CAP) { atomicAdd(&(bar)[XB_TMO], 1u); break; } } } } while (0)

struct XcdBarrier { unsigned* bar; unsigned x; volatile LAS unsigned* st; };

__device__ __forceinline__ XcdBarrier xcd_barrier_post(unsigned* bar, volatile LAS unsigned* st) {
    XcdBarrier b; b.bar = bar; b.x = xb_xcc_id(); b.st = st;
    if (threadIdx.x == 0) (void)xb_add(&bar[XB_XCNT(b.x)], 1u);
    return b;
}
__device__ __forceinline__ void xcd_barrier_complete(unsigned* bar, unsigned x, unsigned& nloc, unsigned& nx) {
    const unsigned G = gridDim.x * gridDim.y * gridDim.z;
    unsigned sum, cnt, mine, sp = 0u;
    for (;;) {
        sum = 0u; cnt = 0u; mine = 0u;
#pragma unroll
        for (unsigned j = 0; j < 16; ++j) { const unsigned c = xb_ld(&bar[XB_XCNT(j)]); sum += c; cnt += (c > 0u) ? 1u : 0u; mine = (j == x) ? c : mine; }
        if (sum == G) break;
        __builtin_amdgcn_s_sleep(1);
        if ((++sp & 255u) == 0u) { if (xb_ld(&bar[XB_TMO])) break; if (sp > XB_SPIN_CAP) { atomicAdd(&bar[XB_TMO], 1u); break; } }
    }
    nloc = mine > 0u ? mine : 1u; nx = cnt > 0u ? cnt : 1u;
}
__device__ __forceinline__ void xcd_barrier(const XcdBarrier& b) {
    asm volatile("s_waitcnt vmcnt(0)" ::: "memory");
    __syncthreads();
    if (threadIdx.x == 0) {
        unsigned* bar = b.bar;
        __builtin_amdgcn_s_waitcnt(0);
        unsigned nloc = b.st[0], nx = b.st[1];
        if (nloc == 0u) { xcd_barrier_complete(bar, b.x, nloc, nx); b.st[0] = nloc; b.st[1] = nx; }
        const unsigned old = xb_add(&bar[XB_XSUB(b.x)], 1u);
        const unsigned gen = old / nloc;
        if (old + 1u == (gen + 1u) * nloc) {
            __builtin_amdgcn_fence(__ATOMIC_RELEASE, "agent");
            asm volatile("s_waitcnt vmcnt(0)" ::: "memory");
            const unsigned og = xb_add(&bar[XB_TOP], 1u);
            const unsigned tg = og / nx;
            if (og + 1u == (tg + 1u) * nx) xb_add(&bar[XB_TOPGEN], 1u);
            else XB_SPIN(xb_ld(&bar[XB_TOPGEN]) == tg, bar);
            __builtin_amdgcn_fence(__ATOMIC_ACQUIRE, "agent");
            xb_add(&bar[XB_XGEN(b.x)], 1u);
            asm volatile("s_waitcnt vmcnt(0)" ::: "memory");
        } else {
            XB_SPIN(xb_ld(&bar[XB_XGEN(b.x)]) == gen, bar);
            __builtin_amdgcn_fence(__ATOMIC_ACQUIRE, "agent");
            asm volatile("s_waitcnt vmcnt(0)" ::: "memory");
        }
    }
    __syncthreads();
}

__device__ __forceinline__ float wave_sum(float v, int lane) {
#pragma unroll
    for (int o = 1; o < 64; o <<= 1) v += __int_as_float(__builtin_amdgcn_ds_bpermute((lane ^ o) << 2, __float_as_int(v)));
    return v;
}
__device__ __forceinline__ void wave_sync() { asm volatile("s_waitcnt lgkmcnt(0)" ::: "memory"); __builtin_amdgcn_wave_barrier(); }

__device__ const unsigned char BKT[129] = {
    0, 1, 2, 3, 4, 5, 6, 7, 8, 9, 10, 11, 12, 13, 14, 15, 16, 16, 16, 17, 17, 18, 18, 18, 19, 19, 19, 20, 20, 20, 20, 21, 21, 21, 21, 22, 22, 22, 22, 22, 23, 23, 23, 23, 23, 23,
    24, 24, 24, 24, 24, 24, 25, 25, 25, 25, 25, 25, 25, 26, 26, 26, 26, 26, 26, 26, 26, 27, 27, 27, 27, 27, 27, 27, 27, 27, 27, 28, 28, 28, 28, 28, 28, 28, 28, 28, 28,
    29, 29, 29, 29, 29, 29, 29, 29, 29, 29, 29, 29, 30, 30, 30, 30, 30, 30, 30, 30, 30, 30, 30, 30, 30, 30, 31, 31, 31, 31, 31, 31, 31, 31, 31, 31, 31, 31, 31, 31, 31, 31 };

__device__ __forceinline__ void transpose_item(const float* W, int K, int N, bf16* WT, int row_off, int il, LAS float* scr, int item, int lane, const float* gk = nullptr, int ldw = 0) {
    if (ldw == 0) ldw = N;
    const int nblk = N / 32, kb = item / nblk, nb = item % nblk, k0 = 64 * kb, n0 = 32 * nb;
#pragma unroll 8
    for (int i = 0; i < 32; ++i) { const int kk = 2 * i + (lane >> 5); scr[kk * 33 + (lane & 31)] = __builtin_nontemporal_load(W + (size_t)(k0 + kk) * ldw + n0 + (lane & 31)) * (gk ? gk[k0 + kk] : 1.0f); }
    LDS_WAIT(); asm volatile("" ::: "memory"); __builtin_amdgcn_wave_barrier();
    const int c = lane & 7;
    const int r0 = il ? ((n0 >> 7) * 256 + row_off + (n0 & 127)) : (row_off + n0);
#pragma unroll
    for (int j = 0; j < 4; ++j) { const int n = (lane >> 3) + 8 * j; const LAS float* s = scr + (8 * c) * 33 + n;
        v4u o; o.x = pk2(s[0 * 33], s[1 * 33]); o.y = pk2(s[2 * 33], s[3 * 33]); o.z = pk2(s[4 * 33], s[5 * 33]); o.w = pk2(s[6 * 33], s[7 * 33]);
        *(GAS v4u*)(WT + (size_t)(r0 + n) * K + k0 + 8 * c) = o; }
    LDS_WAIT(); asm volatile("" ::: "memory"); __builtin_amdgcn_wave_barrier();
}


__device__ __forceinline__ int fresh_tid_w(int wave) { int lane; asm volatile("v_mbcnt_lo_u32_b32 %0, -1, 0\n\tv_mbcnt_hi_u32_b32 %0, -1, %0" : "=v"(lane)); return wave * 64 + lane; }
#define fresh_tid() fresh_tid_w(wave0)

__device__ __forceinline__ unsigned moba_mask(const bf16* u, const LAS float* kmb, int bl, int h, int qc, int lane) {
    const int t = qc * 32 + (lane & 31), own = qc >> 3;
    if (own <= 3) return (1u << own) - 1u;
    const bf16* qp = u + ((size_t)bl * SEQ + t) * UST + C_QA + h * 64;
    v4u xq[8];
#pragma unroll
    for (int i = 0; i < 8; ++i) xq[i] = *(const GAS v4u*)(qp + 8 * i);
    float gs[7];
#pragma unroll
    for (int blk = 0; blk < 7; ++blk) gs[blk] = 0.f;
#pragma unroll
    for (int i = 0; i < 8; ++i) { const v4u x = xq[i];
        const float qv[8] = {bflo(x.x), bfhi(x.x), bflo(x.y), bfhi(x.y), bflo(x.z), bfhi(x.z), bflo(x.w), bfhi(x.w)};
#pragma unroll
        for (int blk = 0; blk < 7; ++blk) { const f32x4 k0 = *(const LAS f32x4*)(kmb + blk * 64 + 8 * i), k1 = *(const LAS f32x4*)(kmb + blk * 64 + 8 * i + 4);
            gs[blk] += (qv[0] * k0.x + qv[1] * k0.y) + (qv[2] * k0.z + qv[3] * k0.w) + (qv[4] * k1.x + qv[5] * k1.y) + (qv[6] * k1.z + qv[7] * k1.w); } }
    unsigned mask = 0u;
#pragma unroll
    for (int k = 0; k < 3; ++k) { float bv = -3.3e38f; int best = 0;
#pragma unroll
        for (int blk = 0; blk < 7; ++blk) { const bool ok = (blk < own) && (((mask >> blk) & 1u) == 0u); if (ok && gs[blk] > bv) { bv = gs[blk]; best = blk; } }
        mask |= 1u << best; }
    return mask;
}

typedef short bf16x8v __attribute__((ext_vector_type(8)));
typedef float f32x16 __attribute__((ext_vector_type(16)));
constexpr int AT_KP = 144, AT_VP = 136, AT_KB = 64 * AT_KP, AT_BUF = AT_KB + 64 * AT_VP;

typedef float f32x2c __attribute__((ext_vector_type(2)));
typedef __bf16 bf16x2c __attribute__((ext_vector_type(2)));
__device__ __forceinline__ unsigned pk2c(float lo, float hi) { const f32x2c f = {lo, hi}; const bf16x2c b = __builtin_convertvector(f, bf16x2c); return __builtin_bit_cast(unsigned, b); }

__device__ __forceinline__ void softmax_step(f32x16 (&e)[2], float& m, float& l, f32x16 (&o)[2], bf16x8v (&pb)[2][2], bool first, int xaddr) {
    float pm = -1.0e30f;
#pragma unroll
    for (int st = 0; st < 2; ++st)
#pragma unroll
        for (int i = 0; i < 16; ++i) pm = fmaxf(pm, e[st][i]);
    pm = fmaxf(pm, __int_as_float(__builtin_amdgcn_ds_bpermute(xaddr, __float_as_int(pm))));
    if (first || __ballot(pm > 8.0f) != 0ull) {
        const float delta = first ? pm : fmaxf(pm, 0.f);
        const float f = __builtin_amdgcn_exp2f(-delta);
        m += delta; l *= f;
#pragma unroll
        for (int mb = 0; mb < 2; ++mb)
#pragma unroll
            for (int i = 0; i < 16; ++i) o[mb][i] *= f;
#pragma unroll
        for (int st = 0; st < 2; ++st)
#pragma unroll
            for (int i = 0; i < 16; ++i) e[st][i] -= delta;
    }
#pragma unroll
    for (int st = 0; st < 2; ++st)
#pragma unroll
        for (int sp = 0; sp < 2; ++sp) { float pv[8];
#pragma unroll
            for (int j = 0; j < 8; ++j) { pv[j] = __builtin_amdgcn_exp2f(e[st][8 * sp + j]); l += pv[j]; }
            union { v4u u; bf16x8v b; } cv; cv.u.x = pk2c(pv[0], pv[1]); cv.u.y = pk2c(pv[2], pv[3]); cv.u.z = pk2c(pv[4], pv[5]); cv.u.w = pk2c(pv[6], pv[7]); pb[st][sp] = cv.b; }
}

template <bool DIFF>
__device__ __forceinline__ void attn_unit(const bf16* U, const float* kmean, bf16* Y, const LAS float* lut, LAS unsigned char* lds, int bl, int h, int qb, const int wave0, float lam, float outscale, const float* subg) {
    const int tid = fresh_tid(), lane = tid & 63, w = wave0, c = lane & 31, hh = lane >> 5;
    const int qcol = (DIFF ? C_QD : C_QA) + h * 64, kcol = (DIFF ? C_KD : C_KA) + h * 64, vcol = (DIFF ? C_VD : C_VA) + h * 64;
    const int q0w = qb * 256 + 32 * w, tq = q0w + c;
    const size_t qrow = (size_t)bl * SEQ + tq;
    bf16x8v qf[4];
#pragma unroll
    for (int s = 0; s < 4; ++s) qf[s] = *(const GAS bf16x8v*)(U + qrow * UST + qcol + 16 * s + 8 * hh);
    unsigned mask = 0xffu;
    if (!DIFF) {
        LAS float* kmb = (LAS float*)(lds + 2 * AT_BUF);
        if (qb >= 4) {
            if (tid < 7 * 64) { const float* km = kmean + ((size_t)(bl * 8 + (tid >> 6))) * 512 + h * 64 + (tid & 63); kmb[tid] = km[0] + km[256]; }
            __syncthreads();
        }
        mask = moba_mask(U, kmb, bl, h, qb * 8 + w, lane);
    }
    const LAS float* lh = lut + (DIFF ? 4 + h : h) * LUT_N;
    const float cfar = lh[LUT_NEG + 128];
    const float qs2 = (DIFF ? 0.17677669529663687f : 0.125f) * 1.4426950408889634f;
    f32x16 o1[2], o2[2];
#pragma unroll
    for (int mb = 0; mb < 2; ++mb)
#pragma unroll
        for (int i = 0; i < 16; ++i) { o1[mb][i] = 0.f; o2[mb][i] = 0.f; }
    float m1 = 0.f, l1 = 0.f, m2 = 0.f, l2 = 0.f;
    const int ntiles = 4 * (qb + 1), my_last = qb * 4 + (w >> 1);
    const int xaddr = (lane ^ 32) << 2;
#define AT_KT(it) ((it) < 4 ? 4 * qb + (it) : (it) - 4)
    const bf16* kg = U + ((size_t)bl * SEQ + (tid >> 3)) * UST + kcol + 8 * (tid & 7);
    const bf16* vg = U + ((size_t)bl * SEQ + (tid & 63)) * UST + vcol + 8 * (tid >> 6);
    const int kst = (tid >> 3) * AT_KP + (tid & 7) * 16;
    const int vst = AT_KB + (8 * (tid >> 6)) * AT_VP + (tid & 63) * 2;
    v4u kreg = *(const GAS v4u*)(kg + (size_t)AT_KT(0) * 64 * UST), vreg = *(const GAS v4u*)(vg + (size_t)AT_KT(0) * 64 * UST);
#define AT_WRITE(bufb) do { LAS unsigned char* b_ = lds + (bufb) * AT_BUF; *(LAS v4u*)(b_ + kst) = kreg; \
        LAS unsigned short* v_ = (LAS unsigned short*)(b_ + vst); \
        v_[0 * (AT_VP / 2)] = (unsigned short)(vreg.x & 0xffffu); v_[1 * (AT_VP / 2)] = (unsigned short)(vreg.x >> 16); v_[2 * (AT_VP / 2)] = (unsigned short)(vreg.y & 0xffffu); v_[3 * (AT_VP / 2)] = (unsigned short)(vreg.y >> 16); \
        v_[4 * (AT_VP / 2)] = (unsigned short)(vreg.z & 0xffffu); v_[5 * (AT_VP / 2)] = (unsigned short)(vreg.z >> 16); v_[6 * (AT_VP / 2)] = (unsigned short)(vreg.w & 0xffffu); v_[7 * (AT_VP / 2)] = (unsigned short)(vreg.w >> 16); } while (0)
    AT_WRITE(0);
    __syncthreads();
    for (int it = 0; it < ntiles; ++it) {
        const bool more = (it + 1 < ntiles);
        if (more) { const int ktn = AT_KT(it + 1); kreg = *(const GAS v4u*)(kg + (size_t)ktn * 64 * UST); vreg = *(const GAS v4u*)(vg + (size_t)ktn * 64 * UST); }
        const int kt = AT_KT(it);
        const int blk = kt >> 2; const bool past = blk < qb;
        const bool lane_on = past ? (((mask >> blk) & 1u) != 0u) : true;
        if (kt <= my_last && (DIFF || !past || __ballot(lane_on) != 0ull)) {
            const LAS unsigned char* kb = lds + (it & 1) * AT_BUF; const LAS unsigned char* vb = kb + AT_KB;
            const int key0 = kt * 64;
            f32x16 s1[2], s2[2];
#pragma unroll
            for (int st = 0; st < 2; ++st) {
#pragma unroll
                for (int i = 0; i < 16; ++i) { s1[st][i] = 0.f; s2[st][i] = 0.f; }
#pragma unroll
                for (int s = 0; s < 4; ++s) { const bf16x8v a = *(const LAS bf16x8v*)(kb + (32 * st + c) * AT_KP + (16 * s + 8 * hh) * 2);
                    if (DIFF && s >= 2) s2[st] = __builtin_amdgcn_mfma_f32_32x32x16_bf16(a, qf[s], s2[st], 0, 0, 0);
                    else s1[st] = __builtin_amdgcn_mfma_f32_32x32x16_bf16(a, qf[s], s1[st], 0, 0, 0); }
            }
            const float off1 = lane_on ? -m1 : -1.0e30f, off2 = -m2;
            if (key0 + 63 + 128 <= q0w) {
                const float x1 = cfar + off1, x2 = cfar + off2;
#pragma unroll
                for (int st = 0; st < 2; ++st)
#pragma unroll
                    for (int i = 0; i < 16; ++i) { s1[st][i] = s1[st][i] * qs2 + x1; if (DIFF) s2[st][i] = s2[st][i] * qs2 + x2; }
            } else {
                const LAS float* lp = lh + (LUT_NEG + tq - key0 - 4 * hh);
#pragma unroll
                for (int st = 0; st < 2; ++st)
#pragma unroll
                    for (int i = 0; i < 16; ++i) { const float b = lp[-(32 * st + (i & 3) + 8 * (i >> 2))]; s1[st][i] = s1[st][i] * qs2 + (b + off1); if (DIFF) s2[st][i] = s2[st][i] * qs2 + (b + off2); }
            }
            bf16x8v p1[2][2], p2[2][2];
            softmax_step(s1, m1, l1, o1, p1, it == 0, xaddr);
            if (DIFF) softmax_step(s2, m2, l2, o2, p2, it == 0, xaddr);
#pragma unroll
            for (int mb = 0; mb < 2; ++mb)
#pragma unroll
                for (int s = 0; s < 4; ++s) { const LAS unsigned char* vr = vb + (32 * mb + c) * AT_VP + (16 * s + 4 * hh) * 2;
                    const v2u lo = *(const LAS v2u*)vr, hi = *(const LAS v2u*)(vr + 16);
                    union { v4u u; bf16x8v b; } cv; cv.u.x = lo.x; cv.u.y = lo.y; cv.u.z = hi.x; cv.u.w = hi.y;
                    o1[mb] = __builtin_amdgcn_mfma_f32_32x32x16_bf16(cv.b, p1[s >> 1][s & 1], o1[mb], 0, 0, 0);
                    if (DIFF) o2[mb] = __builtin_amdgcn_mfma_f32_32x32x16_bf16(cv.b, p2[s >> 1][s & 1], o2[mb], 0, 0, 0); }
        }
        if (more) AT_WRITE((it + 1) & 1);
        __syncthreads();
    }
#undef AT_WRITE
#undef AT_KT
    l1 += __int_as_float(__builtin_amdgcn_ds_bpermute(xaddr, __float_as_int(l1)));
    const float i1 = 1.0f / l1;
    bf16* yp = Y + qrow * 1024 + (DIFF ? 768 : 0) + h * 64;
    if (!DIFF) {
#pragma unroll
        for (int mb = 0; mb < 2; ++mb)
#pragma unroll
            for (int g = 0; g < 4; ++g) { v2u wv; wv.x = pk2c(o1[mb][4 * g] * i1, o1[mb][4 * g + 1] * i1); wv.y = pk2c(o1[mb][4 * g + 2] * i1, o1[mb][4 * g + 3] * i1);
                *(GAS v2u*)(yp + 32 * mb + 8 * g + 4 * hh) = wv; }
    } else {
        l2 += __int_as_float(__builtin_amdgcn_ds_bpermute(xaddr, __float_as_int(l2)));
        const float i2 = lam / l2; float ss = 0.f;
#pragma unroll
        for (int mb = 0; mb < 2; ++mb)
#pragma unroll
            for (int i = 0; i < 16; ++i) { const float v = o1[mb][i] * i1 - o2[mb][i] * i2; o1[mb][i] = v; ss += v * v; }
        ss += __int_as_float(__builtin_amdgcn_ds_bpermute(xaddr, __float_as_int(ss)));
        const float r = outscale / sqrtf(ss * (1.0f / 64.0f) + SUBLN_EPS);
#pragma unroll
        for (int mb = 0; mb < 2; ++mb)
#pragma unroll
            for (int g = 0; g < 4; ++g) { const int d = 32 * mb + 8 * g + 4 * hh; const f32x4 sg = *(const f32x4*)(subg + d);
                v2u wv; wv.x = pk2c(o1[mb][4 * g] * r * sg.x, o1[mb][4 * g + 1] * r * sg.y); wv.y = pk2c(o1[mb][4 * g + 2] * r * sg.z, o1[mb][4 * g + 3] * r * sg.w);
                *(GAS v2u*)(yp + d) = wv; }
    }
}

__device__ __forceinline__ unsigned cvt4_fp8g(float a, float b, float c, float d) { int w = 0; w = __builtin_amdgcn_cvt_pk_fp8_f32(a, b, w, false); w = __builtin_amdgcn_cvt_pk_fp8_f32(c, d, w, true); return (unsigned)w; }
__device__ __forceinline__ void transpose_item8(const float* W, int K, int N, unsigned char* WT, int row_off, int il, LAS float* scr, int item, int lane, const float* gk = nullptr, int ldw = 0) {
    if (ldw == 0) ldw = N;
    const int nblk = N / 32, kb = item / nblk, nb = item % nblk, k0 = 64 * kb, n0 = 32 * nb;
#pragma unroll 8
    for (int i = 0; i < 32; ++i) { const int kk = 2 * i + (lane >> 5); scr[kk * 33 + (lane & 31)] = __builtin_nontemporal_load(W + (size_t)(k0 + kk) * ldw + n0 + (lane & 31)) * (gk ? gk[k0 + kk] : 1.0f); }
    LDS_WAIT(); asm volatile("" ::: "memory"); __builtin_amdgcn_wave_barrier();
    const int c = lane & 7;
    const int r0 = il ? ((n0 >> 7) * 256 + row_off + (n0 & 127)) : (row_off + n0);
#pragma unroll
    for (int j = 0; j < 4; ++j) { const int n = (lane >> 3) + 8 * j; const LAS float* sp = scr + (8 * c) * 33 + n;
        v2u o; o.x = cvt4_fp8g(32.f * sp[0 * 33], 32.f * sp[1 * 33], 32.f * sp[2 * 33], 32.f * sp[3 * 33]); o.y = cvt4_fp8g(32.f * sp[4 * 33], 32.f * sp[5 * 33], 32.f * sp[6 * 33], 32.f * sp[7 * 33]);
        *(GAS v2u*)(WT + (size_t)(r0 + n) * K + k0 + 8 * c) = o; }
    LDS_WAIT(); asm volatile("" ::: "memory"); __builtin_amdgcn_wave_barrier();
}

struct Args {
    const float* in[20]; float* out; unsigned char* ws; int ph_lo, ph_hi, li, pad;
};
typedef const __attribute__((address_space(4))) Args CArgs;

__device__ __forceinline__ float row_rms_load(const float* xrow, const float* g, int lane, f32x4 (&v)[4]) {
    const GAS f32x4* xr = (const GAS f32x4*)xrow + lane; float s = 0.f;
#pragma unroll
    for (int j = 0; j < 4; ++j) { v[j] = __builtin_nontemporal_load(xr + 64 * j); s += (v[j].x * v[j].x + v[j].y * v[j].y) + (v[j].z * v[j].z + v[j].w * v[j].w); }
    const float r = 1.0f / sqrtf(wave_sum(s, lane) * (1.f / D) + RMS_EPS);
    const GAS f32x4* gr = (const GAS f32x4*)g + lane;
#pragma unroll
    for (int j = 0; j < 4; ++j) { const f32x4 gg = gr[64 * j]; v[j] = v[j] * r * gg; }
    return r;
}
__device__ __forceinline__ void row_store_bf16(bf16* orow, int lane, const f32x4 (&v)[4]) {
    GAS unsigned long long* o8 = (GAS unsigned long long*)orow + lane;
#pragma unroll
    for (int j = 0; j < 4; ++j) o8[64 * j] = (unsigned long long)pk2(v[j].x, v[j].y) | ((unsigned long long)pk2(v[j].z, v[j].w) << 32);
}

__device__ __forceinline__ float rowb_rms_load(const bf16* xrow, const float* g, int lane, float (&v)[16]) {
    float s = 0.f;
#pragma unroll
    for (int j = 0; j < 2; ++j) { const v4u x = *(const GAS v4u*)(xrow + 8 * lane + 512 * j);
        v[8 * j + 0] = bflo(x.x); v[8 * j + 1] = bfhi(x.x); v[8 * j + 2] = bflo(x.y); v[8 * j + 3] = bfhi(x.y); v[8 * j + 4] = bflo(x.z); v[8 * j + 5] = bfhi(x.z); v[8 * j + 6] = bflo(x.w); v[8 * j + 7] = bfhi(x.w); }
#pragma unroll
    for (int k = 0; k < 16; ++k) s += v[k] * v[k];
    const float r = 1.0f / sqrtf(wave_sum(s, lane) * (1.f / D) + RMS_EPS);
#pragma unroll
    for (int j = 0; j < 2; ++j) { const f32x4 g0 = *(const GAS f32x4*)(g + 8 * lane + 512 * j), g1 = *(const GAS f32x4*)(g + 8 * lane + 512 * j + 4);
        v[8 * j + 0] *= r * g0.x; v[8 * j + 1] *= r * g0.y; v[8 * j + 2] *= r * g0.z; v[8 * j + 3] *= r * g0.w; v[8 * j + 4] *= r * g1.x; v[8 * j + 5] *= r * g1.y; v[8 * j + 6] *= r * g1.z; v[8 * j + 7] *= r * g1.w; }
    return r;
}
__device__ __forceinline__ float rowb_rms_from(const v4u (&x)[2], const float* g, int lane, float (&v)[16]) {
    float s = 0.f;
#pragma unroll
    for (int j = 0; j < 2; ++j) { v[8 * j + 0] = bflo(x[j].x); v[8 * j + 1] = bfhi(x[j].x); v[8 * j + 2] = bflo(x[j].y); v[8 * j + 3] = bfhi(x[j].y); v[8 * j + 4] = bflo(x[j].z); v[8 * j + 5] = bfhi(x[j].z); v[8 * j + 6] = bflo(x[j].w); v[8 * j + 7] = bfhi(x[j].w); }
#pragma unroll
    for (int k = 0; k < 16; ++k) s += v[k] * v[k];
    const float r = 1.0f / sqrtf(wave_sum(s, lane) * (1.f / D) + RMS_EPS);
#pragma unroll
    for (int j = 0; j < 2; ++j) { const f32x4 g0 = *(const GAS f32x4*)(g + 8 * lane + 512 * j), g1 = *(const GAS f32x4*)(g + 8 * lane + 512 * j + 4);
        v[8 * j + 0] *= r * g0.x; v[8 * j + 1] *= r * g0.y; v[8 * j + 2] *= r * g0.z; v[8 * j + 3] *= r * g0.w; v[8 * j + 4] *= r * g1.x; v[8 * j + 5] *= r * g1.y; v[8 * j + 6] *= r * g1.z; v[8 * j + 7] *= r * g1.w; }
    return r;
}
__device__ __forceinline__ void rowb_store_bf16(bf16* orow, int lane, const float (&v)[16]) {
#pragma unroll
    for (int j = 0; j < 2; ++j) { v4u w; w.x = pk2(v[8 * j], v[8 * j + 1]); w.y = pk2(v[8 * j + 2], v[8 * j + 3]); w.z = pk2(v[8 * j + 4], v[8 * j + 5]); w.w = pk2(v[8 * j + 6], v[8 * j + 7]);
        *(GAS v4u*)(orow + 8 * lane + 512 * j) = w; }
}
__device__ __forceinline__ void rowb_store_fp8(unsigned char* orow, int lane, const float (&v)[16]) {
#pragma unroll
    for (int j = 0; j < 2; ++j) { v2u w; w.x = cvt4_fp8g(v[8 * j], v[8 * j + 1], v[8 * j + 2], v[8 * j + 3]); w.y = cvt4_fp8g(v[8 * j + 4], v[8 * j + 5], v[8 * j + 6], v[8 * j + 7]);
        *(GAS v2u*)(orow + 8 * lane + 512 * j) = w; }
}
__device__ __forceinline__ void row_store_fp8(unsigned char* orow, int lane, const f32x4 (&v)[4]) {
    GAS unsigned* o4 = (GAS unsigned*)orow + lane;
#pragma unroll
    for (int j = 0; j < 4; ++j) o4[64 * j] = cvt4_fp8g(v[j].x, v[j].y, v[j].z, v[j].w);
}
__device__ __forceinline__ void ph_prologue(CArgs& args, LAS unsigned char* lds, const int wave0) {
    const int tid = fresh_tid(), lane = tid & 63, wave = __builtin_amdgcn_readfirstlane(tid >> 6), gw = blockIdx.x * NWAVES + wave, NGW = gridDim.x * NWAVES;
    unsigned char* ws = args.ws;
    LAS float* scr = (LAS float*)(lds + wave * 16384);
    constexpr int I_WIN = 16 * (GCOL0 / 32), I_WG = 16 * ((WIN - GCOL0) / 32), I_BP = 4 * 32, I_WO = 16 * 32, I_D1 = 16 * (FF0 / 32), I_D2 = (FF0 / 64) * 32, I_E1 = 16 * (FFE / 32), I_E2 = (FFE / 64) * 32;
    constexpr int NIT = 2 * I_WIN + 2 * I_WG + 8 * I_BP + 2 * I_WO + 2 * I_D1 + I_D2 + 16 * I_E1 + 8 * I_E2;
    for (int it = gw; it < NIT; it += NGW) {
        int r = it;
        if (r < 2 * I_WIN) { const int l = r / I_WIN; transpose_item(args.in[3] + (size_t)l * D * WIN, D, GCOL0, (bf16*)(ws + WS_WIN) + (size_t)l * GCOL0 * D, 0, 0, scr, r % I_WIN, lane, args.in[2] + (size_t)l * D, WIN); continue; } r -= 2 * I_WIN;
        if (r < 2 * I_WG) { const int l = r / I_WG; transpose_item8(args.in[3] + (size_t)l * D * WIN + GCOL0, D, WIN - GCOL0, ws + WS_WG8 + (size_t)l * (WIN - GCOL0) * D, 0, 0, scr, r % I_WG, lane, args.in[2] + (size_t)l * D, WIN); continue; } r -= 2 * I_WG;
        if (r < 8 * I_BP) { const int q = r / I_BP;
            if ((q & 3) != 2) { transpose_item(args.in[9] + (size_t)q * 256 * D, 256, D, (bf16*)(ws + WS_BP) + (size_t)q * D * 256, 0, 0, scr, r % I_BP, lane); continue; }
            const int it2 = r % I_BP; if (it2 < 64) { const int l = q >> 2, g = it2 >> 4, n = (it2 & 15) * 64 + lane;
                const float* pw = args.in[5] + ((size_t)l * 4 + g) * 64 * 64; const float* psc = args.in[6] + (size_t)l * 256 + g * 64; const float* b2 = args.in[9] + ((size_t)q * 256 + g * 64) * D + n;
                bf16* dst = (bf16*)(ws + WS_BP) + (size_t)q * D * 256 + (size_t)n * 256 + g * 64;
#pragma unroll 1
                for (int ch = 0; ch < 4; ++ch) {
                    float accw[16];
#pragma unroll
                    for (int c = 0; c < 16; ++c) accw[c] = 0.f;
#pragma unroll 4
                    for (int d = 0; d < 64; ++d) { const float bv = b2[(size_t)d * D] * psc[d];
#pragma unroll
                        for (int c = 0; c < 16; ++c) accw[c] += pw[(ch * 16 + c) * 64 + d] * bv; }
#pragma unroll
                    for (int c8 = 0; c8 < 2; ++c8) { v4u w; w.x = pk2(accw[8 * c8], accw[8 * c8 + 1]); w.y = pk2(accw[8 * c8 + 2], accw[8 * c8 + 3]); w.z = pk2(accw[8 * c8 + 4], accw[8 * c8 + 5]); w.w = pk2(accw[8 * c8 + 6], accw[8 * c8 + 7]);
                        *(GAS v4u*)(dst + ch * 16 + 8 * c8) = w; } } }
            continue; } r -= 8 * I_BP;
        if (r < 2 * I_WO) { const int l = r / I_WO; transpose_item(args.in[10] + (size_t)l * D * D, D, D, (bf16*)(ws + WS_WOUT) + (size_t)l * D * D, 0, 0, scr, r % I_WO, lane); continue; } r -= 2 * I_WO;
        if (r < I_D1) { transpose_item(args.in[12], D, FF0, (bf16*)(ws + WS_W13D), 0, 1, scr, r, lane, args.in[11]); continue; } r -= I_D1;
        if (r < I_D1) { transpose_item(args.in[13], D, FF0, (bf16*)(ws + WS_W13D), 128, 1, scr, r, lane, args.in[11]); continue; } r -= I_D1;
        if (r < I_D2) { transpose_item8(args.in[14], FF0, D, ws + WS_W2D, 0, 0, scr, r, lane); continue; } r -= I_D2;
        if (r < 8 * I_E1) { const int e = r / I_E1; transpose_item8(args.in[16] + (size_t)e * D * FFE, D, FFE, ws + WS_W13E + (size_t)e * 2 * FFE * D, 0, 1, scr, r % I_E1, lane); continue; } r -= 8 * I_E1;
        if (r < 8 * I_E1) { const int e = r / I_E1; transpose_item8(args.in[17] + (size_t)e * D * FFE, D, FFE, ws + WS_W13E + (size_t)e * 2 * FFE * D, 128, 1, scr, r % I_E1, lane); continue; } r -= 8 * I_E1;
        { const int e = r / I_E2; transpose_item8(args.in[18] + (size_t)e * FFE * D, FFE, D, ws + WS_W2E + (size_t)e * D * FFE, 0, 0, scr, r % I_E2, lane); }
    }
}

__device__ __forceinline__ void ph_norm_rb(const bf16* src, const float* g, bf16* dst, const int wave0) {
    const int tid = fresh_tid(), lane = tid & 63, wave = __builtin_amdgcn_readfirstlane(tid >> 6), gw = blockIdx.x * NWAVES + wave, NGW = gridDim.x * NWAVES;
    for (int m = gw; m < M; m += NGW) { float v[16]; (void)rowb_rms_load(src + (size_t)m * D, g, lane, v); rowb_store_bf16(dst + (size_t)m * D, lane, v); }
}
__device__ __forceinline__ void ph_norm_bf16(const float* src, const float* g, bf16* dst, unsigned char* dst8, const int wave0) {
    const int tid = fresh_tid(), lane = tid & 63, wave = __builtin_amdgcn_readfirstlane(tid >> 6), gw = blockIdx.x * NWAVES + wave, NGW = gridDim.x * NWAVES;
    for (int m = gw; m < M; m += NGW) { f32x4 v[4]; (void)row_rms_load(src + (size_t)m * D, g, lane, v); row_store_bf16(dst + (size_t)m * D, lane, v); row_store_fp8(dst8 + (size_t)m * D, lane, v); }
}
__device__ __forceinline__ void ph_x_to_residual(const float* src, bf16* dst, unsigned char* dst8, float* ssq, const int wave0) {
    const int tid = fresh_tid(), lane = tid & 63, wave = __builtin_amdgcn_readfirstlane(tid >> 6), gw = blockIdx.x * NWAVES + wave, NGW = gridDim.x * NWAVES;
    for (int m = gw; m < M; m += NGW) { f32x4 v[4]; const GAS f32x4* xr = (const GAS f32x4*)(src + (size_t)m * D) + lane; float s = 0.f;
#pragma unroll
        for (int j = 0; j < 4; ++j) { v[j] = __builtin_nontemporal_load(xr + 64 * j); s += (v[j].x * v[j].x + v[j].y * v[j].y) + (v[j].z * v[j].z + v[j].w * v[j].w); }
        const float tot = wave_sum(s, lane);
        row_store_bf16(dst + (size_t)m * D, lane, v); row_store_fp8(dst8 + (size_t)m * D, lane, v);
        if (lane < 16) ssq[(size_t)m * 16 + lane] = (lane == 0) ? tot : 0.f; }
}
__device__ __forceinline__ void ph_final_norm(const bf16* R, const float* g, float* out, const int wave0) {
    const int tid = fresh_tid(), lane = tid & 63, wave = __builtin_amdgcn_readfirstlane(tid >> 6), gw = blockIdx.x * NWAVES + wave, NGW = gridDim.x * NWAVES;
    f32x4 gg[4];
#pragma unroll
    for (int j = 0; j < 2; ++j) { gg[2 * j] = *(const GAS f32x4*)(g + 8 * lane + 512 * j); gg[2 * j + 1] = *(const GAS f32x4*)(g + 8 * lane + 512 * j + 4); }
    for (int m0 = gw; m0 < M; m0 += 2 * NGW) {
        v4u x[2][2], z[2][2], z0[2][2];
#pragma unroll
        for (int q = 0; q < 2; ++q)
#pragma unroll
            for (int j = 0; j < 2; ++j) { x[q][j] = *(const GAS v4u*)(R + (size_t)(m0 + q * NGW) * D + 8 * lane + 512 * j);
                z[q][j] = *(const GAS v4u*)((const bf16*)(out + (size_t)(m0 + q * NGW) * D + 512) + 8 * lane + 512 * j);
                z0[q][j] = *(const GAS v4u*)((const bf16*)(out + (size_t)(m0 + q * NGW) * D) + 8 * lane + 512 * j); }
#pragma unroll
        for (int q = 0; q < 2; ++q) { float v[16];
#pragma unroll
            for (int j = 0; j < 2; ++j) { const v4u w = x[q][j], y = z[q][j], y0 = z0[q][j];
                v[8 * j + 0] = bflo(w.x) + (bflo(y0.x) + bflo(y.x)); v[8 * j + 1] = bfhi(w.x) + (bfhi(y0.x) + bfhi(y.x)); v[8 * j + 2] = bflo(w.y) + (bflo(y0.y) + bflo(y.y)); v[8 * j + 3] = bfhi(w.y) + (bfhi(y0.y) + bfhi(y.y));
                v[8 * j + 4] = bflo(w.z) + (bflo(y0.z) + bflo(y.z)); v[8 * j + 5] = bfhi(w.z) + (bfhi(y0.z) + bfhi(y.z)); v[8 * j + 6] = bflo(w.w) + (bflo(y0.w) + bflo(y.w)); v[8 * j + 7] = bfhi(w.w) + (bfhi(y0.w) + bfhi(y.w)); }
            float s = 0.f;
#pragma unroll
            for (int k = 0; k < 16; ++k) s += v[k] * v[k];
            const float r = 1.0f / sqrtf(wave_sum(s, lane) * (1.f / D) + RMS_EPS);
            float* o = out + (size_t)(m0 + q * NGW) * D + 8 * lane;
#pragma unroll
            for (int j = 0; j < 2; ++j) { const f32x4 a = gg[2 * j], b = gg[2 * j + 1];
                *(GAS f32x4*)(o + 512 * j) = (f32x4){v[8 * j] * r * a.x, v[8 * j + 1] * r * a.y, v[8 * j + 2] * r * a.z, v[8 * j + 3] * r * a.w};
                *(GAS f32x4*)(o + 512 * j + 4) = (f32x4){v[8 * j + 4] * r * b.x, v[8 * j + 5] * r * b.y, v[8 * j + 6] * r * b.z, v[8 * j + 7] * r * b.w}; } }
    }
}

__device__ __forceinline__ void ph_kmean(const bf16* U, float* kmean, LAS unsigned char* lds, const int wave0) {
    const int tid = fresh_tid();
    LAS float* red = (LAS float*)lds;
    for (int task = blockIdx.x; task < HB * 8; task += gridDim.x) {
        const int bl = task >> 3, blk = task & 7, cg = tid & 31, rq = tid >> 5;
        const bf16* kp = U + ((size_t)bl * SEQ + blk * 256 + rq * 16) * UST + C_KA + 8 * cg;
        v4u x[16];
#pragma unroll
        for (int i = 0; i < 16; ++i) x[i] = *(const GAS v4u*)(kp + (size_t)i * UST);
        float sm[8];
#pragma unroll
        for (int k = 0; k < 8; ++k) sm[k] = 0.f;
#pragma unroll
        for (int i = 0; i < 16; ++i) { sm[0] += bflo(x[i].x); sm[1] += bfhi(x[i].x); sm[2] += bflo(x[i].y); sm[3] += bfhi(x[i].y); sm[4] += bflo(x[i].z); sm[5] += bfhi(x[i].z); sm[6] += bflo(x[i].w); sm[7] += bfhi(x[i].w); }
#pragma unroll
        for (int k = 0; k < 8; ++k) red[rq * 256 + 8 * cg + k] = sm[k];
        __syncthreads();
        if (tid < 256) { float t = 0.f;
#pragma unroll
            for (int q = 0; q < 16; ++q) t += red[q * 256 + tid];
            kmean[(size_t)task * 256 + tid] = t * (1.0f / 256.0f); }
        __syncthreads();
    }
}

__device__ __forceinline__ void ph_conv_pool(CArgs& args, int l, const bf16* U, bf16* Y, LAS unsigned char* lds, const int wave0) {
    const int tid = fresh_tid(), lane = tid & 63, wave = __builtin_amdgcn_readfirstlane(tid >> 6), gw = blockIdx.x * NWAVES + wave, NGW = gridDim.x * NWAVES;
    {
        const float* cw = args.in[4] + (size_t)l * 3 * 256; const int c0 = (lane & 31) * 8;
        float w0[8], w1[8], w2[8];
#pragma unroll
        for (int k = 0; k < 8; ++k) { w0[k] = cw[c0 + k]; w1[k] = cw[256 + c0 + k]; w2[k] = cw[512 + c0 + k]; }
        for (int ch = gw; ch < HROWS / 8; ch += NGW) {
            const int rl0 = ch * 8 + (lane >> 5) * 4, t = rl0 & (SEQ - 1);
            const bf16* up = U + (size_t)rl0 * UST; const int back = t > 0 ? 1 : 0; const float mb = t > 0 ? 1.f : 0.f;
            v4u xv[6], gv[6], bv[4];
#pragma unroll
            for (int k = 0; k < 6; ++k) { const long ro = (k < 2) ? (long)(k - 2) * back : (long)(k - 2); xv[k] = *(const GAS v4u*)(up + ro * UST + C_XB + c0); gv[k] = *(const GAS v4u*)(up + ro * UST + C_CB + c0); }
#pragma unroll
            for (int i = 0; i < 4; ++i) bv[i] = *(const GAS v4u*)(up + (size_t)i * UST + C_BB + c0);
            float uu[6][8];
#pragma unroll
            for (int k = 0; k < 6; ++k) { const float mk = (k < 2) ? mb : 1.f;
                uu[k][0] = mk * bflo(xv[k].x) * bflo(gv[k].x); uu[k][1] = mk * bfhi(xv[k].x) * bfhi(gv[k].x); uu[k][2] = mk * bflo(xv[k].y) * bflo(gv[k].y); uu[k][3] = mk * bfhi(xv[k].y) * bfhi(gv[k].y);
                uu[k][4] = mk * bflo(xv[k].z) * bflo(gv[k].z); uu[k][5] = mk * bfhi(xv[k].z) * bfhi(gv[k].z); uu[k][6] = mk * bflo(xv[k].w) * bflo(gv[k].w); uu[k][7] = mk * bfhi(xv[k].w) * bfhi(gv[k].w); }
#pragma unroll
            for (int i = 0; i < 4; ++i) { float cv[8];
#pragma unroll
                for (int k = 0; k < 8; ++k) cv[k] = w2[k] * uu[i + 2][k] + w1[k] * uu[i + 1][k] + w0[k] * uu[i][k];
                v4u w; w.x = pk2(cv[0] * bflo(bv[i].x), cv[1] * bfhi(bv[i].x)); w.y = pk2(cv[2] * bflo(bv[i].y), cv[3] * bfhi(bv[i].y)); w.z = pk2(cv[4] * bflo(bv[i].z), cv[5] * bfhi(bv[i].z)); w.w = pk2(cv[6] * bflo(bv[i].w), cv[7] * bfhi(bv[i].w));
                *(GAS v4u*)(Y + (size_t)(rl0 + i) * 1024 + 256 + c0) = w; }
        }
    }
    {
        const int gq = lane >> 4, c4 = (lane & 15) * 4, wlen = 2 << gq;
        for (int ch = gw; ch < HROWS / 8; ch += NGW) {
            const int rl0 = ch * 8, t0 = rl0 & (SEQ - 1); const bf16* pp = U + (size_t)rl0 * UST + C_PC + gq * 64 + c4;
            v2u xr[23];
#pragma unroll
            for (int i = 0; i < 23; ++i) { const int d = i - 15; const long ro = (t0 + d >= 0) ? (long)d : 0; xr[i] = *(const GAS v2u*)(pp + ro * UST); }
            float xf[23][4];
#pragma unroll
            for (int i = 0; i < 23; ++i) { const float mk = (t0 + i - 15 >= 0) ? 1.f : 0.f; xf[i][0] = mk * bflo(xr[i].x); xf[i][1] = mk * bfhi(xr[i].x); xf[i][2] = mk * bflo(xr[i].y); xf[i][3] = mk * bfhi(xr[i].y); }
#pragma unroll
            for (int tk = 0; tk < 8; ++tk) { float s0 = 0.f, s1 = 0.f, s2 = 0.f, s3 = 0.f;
#pragma unroll
                for (int j = 0; j < 16; ++j) { const float mk = j < wlen ? 1.f : 0.f; s0 += mk * xf[15 + tk - j][0]; s1 += mk * xf[15 + tk - j][1]; s2 += mk * xf[15 + tk - j][2]; s3 += mk * xf[15 + tk - j][3]; }
                const int t = t0 + tk; const int cnt = (t + 1) < wlen ? (t + 1) : wlen; const float ic = 1.0f / (float)cnt;
                v2u w; w.x = pk2(s0 * ic - xf[15 + tk][0], s1 * ic - xf[15 + tk][1]); w.y = pk2(s2 * ic - xf[15 + tk][2], s3 * ic - xf[15 + tk][3]);
                *(GAS v2u*)(Y + (size_t)(rl0 + tk) * 1024 + 512 + gq * 64 + c4) = w; }
        }
    }
    __syncthreads();
}

__device__ __forceinline__ void ph_attn(CArgs& args, int l, const bf16* U, const float* kmean, bf16* Y, LAS unsigned char* lds, const int wave0) {
    const float* dl = args.in[7] + (size_t)l * 128; const float* subg = args.in[8] + (size_t)l * 64;
    float a = 0.f, b = 0.f;
    for (int i = 0; i < 32; ++i) { a += dl[i] * dl[32 + i]; b += dl[64 + i] * dl[96 + i]; }
    int l_s = l; asm volatile("" : "+s"(l_s));
    const float lam_init = (l_s == 0) ? 0.2f : 0.35550906759096926f;
    const float lam = __expf(a) - __expf(b) + lam_init, outscale = 1.0f - lam_init;
    const LAS float* lut = (const LAS float*)(lds + LUT_OFF);
    for (int cu0 = blockIdx.x; cu0 < HB * 4 * 4; cu0 += gridDim.x) {
        const int cu = (gridDim.x == 256) ? ((cu0 & 7) * 32 + (cu0 >> 3)) : cu0;
        const int bh = cu >> 2, pr = cu & 3, bl = bh >> 2, h = bh & 3;
#pragma unroll 1
        for (int k = 0; k < 2; ++k) attn_unit<false>(U, kmean, Y, lut, lds, bl, h, k ? 7 - pr : pr, wave0, 0.f, 0.f, subg);
#pragma unroll 1
        for (int k = 0; k < 2; ++k) attn_unit<true>(U, kmean, Y, lut, lds, bl, h, k ? 7 - pr : pr, wave0, lam, outscale, subg);
    }
}

__device__ __forceinline__ void ph_route(CArgs& args, int l, const bf16* R, unsigned* route, int* tokp, gu32* ctl, LAS unsigned char* lds, const int wave0) {
    const int tid = fresh_tid(), lane = tid & 63, wave = __builtin_amdgcn_readfirstlane(tid >> 6), gw = blockIdx.x * NWAVES + wave, NGW = gridDim.x * NWAVES;
    const float* g = args.in[11] + (size_t)l * D;
    LAS float* rl = (LAS float*)lds;
    { const float* rw = args.in[15]; for (int i = tid; i < D * 8; i += NWAVES * 64) rl[i] = rw[i] * g[i >> 3]; }
    for (int i = blockIdx.x * NWAVES * 64 + tid; i < 2 * CAPROWS; i += gridDim.x * NWAVES * 64) tokp[i] = -1;
    __syncthreads();
    v4u xr[4][2];
#pragma unroll
    for (int q = 0; q < 4; ++q)
#pragma unroll
        for (int j = 0; j < 2; ++j) xr[q][j] = *(const GAS v4u*)(R + (size_t)((gw < M ? gw : 0) + q * NGW) * D + 8 * lane + 512 * j);
    for (int m0 = gw; m0 < M; m0 += 4 * NGW) {
        int i0q[4], i1q[4]; float w0q[4], w1q[4], rq[4];
#pragma unroll
        for (int q = 0; q < 4; ++q) {
            float v[16], ss = 0.f;
#pragma unroll
            for (int j = 0; j < 2; ++j) { v[8 * j + 0] = bflo(xr[q][j].x); v[8 * j + 1] = bfhi(xr[q][j].x); v[8 * j + 2] = bflo(xr[q][j].y); v[8 * j + 3] = bfhi(xr[q][j].y); v[8 * j + 4] = bflo(xr[q][j].z); v[8 * j + 5] = bfhi(xr[q][j].z); v[8 * j + 6] = bflo(xr[q][j].w); v[8 * j + 7] = bfhi(xr[q][j].w); }
#pragma unroll
            for (int k = 0; k < 16; ++k) ss += v[k] * v[k];
            float lg[8];
#pragma unroll
            for (int e = 0; e < 8; ++e) lg[e] = 0.f;
#pragma unroll
            for (int j = 0; j < 2; ++j)
#pragma unroll
                for (int k = 0; k < 8; ++k) { const int c = 8 * lane + 512 * j + k; const f32x4 ra = *(const LAS f32x4*)(rl + c * 8), rb = *(const LAS f32x4*)(rl + c * 8 + 4); const float xv = v[8 * j + k];
                    lg[0] += xv * ra.x; lg[1] += xv * ra.y; lg[2] += xv * ra.z; lg[3] += xv * ra.w; lg[4] += xv * rb.x; lg[5] += xv * rb.y; lg[6] += xv * rb.z; lg[7] += xv * rb.w; }
#define RT_X(k_, val_) __int_as_float(__builtin_amdgcn_ds_bpermute((lane ^ (k_)) << 2, __float_as_int(val_)))
            { const bool b1 = (lane & 1) != 0, b2 = (lane & 2) != 0, b3 = (lane & 4) != 0;
              float a4[4], c2[2], d1;
#pragma unroll
              for (int i = 0; i < 4; ++i) { const float snd = b1 ? lg[i] : lg[4 + i], kp = b1 ? lg[4 + i] : lg[i]; a4[i] = kp + RT_X(1, snd); }
#pragma unroll
              for (int i = 0; i < 2; ++i) { const float snd = b2 ? a4[i] : a4[2 + i], kp = b2 ? a4[2 + i] : a4[i]; c2[i] = kp + RT_X(2, snd); }
              { const float snd = b3 ? c2[0] : c2[1], kp = b3 ? c2[1] : c2[0]; d1 = kp + RT_X(4, snd); }
              d1 += RT_X(8, d1); d1 += RT_X(16, d1); d1 += RT_X(32, d1);
              const float r = 1.0f / sqrtf(wave_sum(ss, lane) * (1.f / D) + RMS_EPS); rq[q] = r;
#pragma unroll
              for (int e = 0; e < 8; ++e) lg[e] = r * __int_as_float(__builtin_amdgcn_readlane(__float_as_int(d1), ((e >> 2) & 1) | (((e >> 1) & 1) << 1) | ((e & 1) << 2))); }
#undef RT_X
            int i0 = 0; float v0 = lg[0];
#pragma unroll
            for (int e = 1; e < 8; ++e) if (lg[e] > v0) { v0 = lg[e]; i0 = e; }
            int i1 = 0; float v1 = -3.0e38f;
#pragma unroll
            for (int e = 0; e < 8; ++e) if (e != i0 && lg[e] > v1) { v1 = lg[e]; i1 = e; }
            const float e1 = __expf(v1 - v0); w0q[q] = 1.0f / (1.0f + e1); w1q[q] = e1 * w0q[q]; i0q[q] = i0; i1q[q] = i1;
        }
        { const int mn = m0 + 4 * NGW;
          if (mn < M) {
#pragma unroll
              for (int q = 0; q < 4; ++q)
#pragma unroll
                  for (int j = 0; j < 2; ++j) xr[q][j] = *(const GAS v4u*)(R + (size_t)(mn + q * NGW) * D + 8 * lane + 512 * j); } }
        if (lane == 0) {
            unsigned s0[4], s1[4];
#pragma unroll
            for (int q = 0; q < 4; ++q) { s0[q] = atomicAdd((unsigned*)(ctl + CW_CNT + (0 * 8 + i0q[q]) * 64), 1u); s1[q] = atomicAdd((unsigned*)(ctl + CW_CNT + (1 * 8 + i1q[q]) * 64), 1u); }
#pragma unroll
            for (int q = 0; q < 4; ++q) { unsigned* rec = route + (size_t)(m0 + q * NGW) * 8; rec[0] = (unsigned)i0q[q] | ((unsigned)i1q[q] << 8); rec[1] = s0[q]; rec[2] = s1[q]; rec[3] = __float_as_uint(w0q[q]); rec[4] = __float_as_uint(w1q[q]); rec[5] = __float_as_uint(rq[q]); }
        }
    }
}

__device__ __forceinline__ void ph_gather(CArgs& args, int l, const bf16* R, const unsigned* route, int* tokp, float* gatep, int* tile_e, int* n_rt, unsigned char* hperm, gu32* ctl, LAS unsigned char* lds, const int wave0) {
    const int tid = fresh_tid(), lane = tid & 63, wave = __builtin_amdgcn_readfirstlane(tid >> 6), gw = blockIdx.x * NWAVES + wave, NGW = gridDim.x * NWAVES;
    const float* g = args.in[11] + (size_t)l * D;
    LAS int* base = (LAS int*)lds;
    if (tid < 2) { int acc = 0;
        for (int e = 0; e < 8; ++e) { base[tid * 8 + e] = acc; const int c = (int)__hip_atomic_load((unsigned*)(ctl + CW_CNT + (tid * 8 + e) * 64), RLX_AGENT); acc += (c + 255) & ~255; }
        base[16 + tid] = acc; }
    __syncthreads();
    if (blockIdx.x == 0 && tid < 2) { const int p = tid, nt = base[16 + p] >> 8; n_rt[p] = nt;
        for (int rt = 0; rt < nt; ++rt) { int e = 0; for (int k = 1; k < 8; ++k) if (rt * 256 >= base[p * 8 + k]) e = k; tile_e[p * 512 + rt] = e; } }
    for (int m0 = gw; m0 < M; m0 += 4 * NGW) {
        v4u xr[4][2]; unsigned ee[4], sl0[4], sl1[4], gw0[4], gw1[4], rs5[4];
#pragma unroll
        for (int q = 0; q < 4; ++q) { const size_t m = (size_t)(m0 + q * NGW);
#pragma unroll
            for (int j = 0; j < 2; ++j) xr[q][j] = *(const GAS v4u*)(R + m * D + 8 * lane + 512 * j);
            const unsigned* rec = route + m * 8; ee[q] = rec[0]; sl0[q] = rec[1]; sl1[q] = rec[2]; gw0[q] = rec[3]; gw1[q] = rec[4]; rs5[q] = rec[5]; }
#pragma unroll
        for (int q = 0; q < 4; ++q) { const int m = m0 + q * NGW;
            float v[16]; const float r = __uint_as_float(rs5[q]);
#pragma unroll
            for (int j = 0; j < 2; ++j) { const f32x4 g0 = *(const GAS f32x4*)(g + 8 * lane + 512 * j), g1 = *(const GAS f32x4*)(g + 8 * lane + 512 * j + 4); const v4u x = xr[q][j];
                v[8 * j + 0] = bflo(x.x) * (r * g0.x); v[8 * j + 1] = bfhi(x.x) * (r * g0.y); v[8 * j + 2] = bflo(x.y) * (r * g0.z); v[8 * j + 3] = bfhi(x.y) * (r * g0.w);
                v[8 * j + 4] = bflo(x.z) * (r * g1.x); v[8 * j + 5] = bfhi(x.z) * (r * g1.y); v[8 * j + 6] = bflo(x.w) * (r * g1.z); v[8 * j + 7] = bfhi(x.w) * (r * g1.w); }
            const int e0 = ee[q] & 255, e1 = (ee[q] >> 8) & 255;
            const int pos0 = base[e0] + (int)sl0[q], pos1 = base[8 + e1] + (int)sl1[q];
            rowb_store_fp8(hperm + (size_t)pos0 * D, lane, v); rowb_store_fp8(hperm + ((size_t)CAPROWS + pos1) * D, lane, v);
            if (lane == 0) { tokp[pos0] = m; tokp[CAPROWS + pos1] = m; gatep[pos0] = __uint_as_float(gw0[q]); gatep[CAPROWS + pos1] = __uint_as_float(gw1[q]); } }
    }
    __syncthreads();
}

__global__ void __launch_bounds__(NWAVES * 64, 2) mega_fwd(Args args0) {
    extern __shared__ __attribute__((aligned(16))) unsigned char lds_raw[];
    LAS unsigned char* lds = (LAS unsigned char*)lds_raw;
    volatile LAS unsigned* MISC = (volatile LAS unsigned*)(lds + MISC_OFF);
    const int G = gridDim.x;
    const int wave0 = __builtin_amdgcn_readfirstlane((int)(threadIdx.x >> 6));
    gu32* ctl = (gu32*)(args0.ws + WS_CTL);
    { const int tid = threadIdx.x;
      for (int i = tid; i < (LDS_BYTES - LDSCTL_OFF) / 4; i += NWAVES * 64) ((LAS unsigned*)(lds + LDSCTL_OFF))[i] = 0u;
      LAS float* lut = (LAS float*)(lds + LUT_OFF); const float* bt = args0.in[1];
      for (int i = tid; i < 8 * LUT_N; i += NWAVES * 64) { const int hd = i / LUT_N, n = i % LUT_N - LUT_NEG; lut[i] = (n < 0) ? -1.0e30f : 1.4426950408889634f * bt[(int)BKT[n > 128 ? 128 : n] * 8 + hd]; }
      if (tid < 256) { const float gv = __builtin_amdgcn_cvt_f32_fp8(tid, 0); ((LAS float*)(lds + SLUT_OFF))[tid] = 1.0f / (1.0f + __expf(-gv)); } }
    __syncthreads();
    XcdBarrier bar; bar.bar = (unsigned*)(ctl + CW_BAR) + args0.li * XCD_BAR_WORDS; bar.x = 0; bar.st = nullptr;
#if MK_ONE_LAUNCH
    bar = xcd_barrier_post((unsigned*)(ctl + CW_BAR) + args0.li * XCD_BAR_WORDS, MISC + 8);
#define GRID_BAR() xcd_barrier(bar)
#else
    (void)MISC;
#define GRID_BAR() do { } while (0)
#endif
    const int lo = args0.ph_lo, hi = args0.ph_hi;
#define IN(k) (lo <= (k) && (k) < hi)
#define BOTH(k) (IN(k) && IN((k) + 1))

#define OPQ_PTRS CArgs* ka_ = (CArgs*)__builtin_amdgcn_kernarg_segment_ptr(); asm volatile("" : "+s"(ka_)); CArgs& args = *ka_; unsigned char* ws = args.ws; bf16* R = (bf16*)(ws + WS_R); \
        bf16* Hn = (bf16*)(ws + WS_H); bf16* U = (bf16*)(ws + WS_U); bf16* Y = (bf16*)(ws + WS_Y); bf16* MG = (bf16*)(ws + WS_MG); float* kmean = (float*)(ws + WS_KMEAN); \
        unsigned* route = (unsigned*)(ws + WS_ROUTE); int* tokp = (int*)(ws + WS_TOK); float* gatep = (float*)(ws + WS_GATE); int* tile_e = (int*)(ws + WS_TILEE); int* n_rt = (int*)(ws + WS_TILEE + 4096); \
        (void)Hn; (void)U; (void)Y; (void)MG; (void)kmean; (void)route; (void)tokp; (void)gatep; (void)tile_e; (void)n_rt; (void)R
#define OPQ_I(name, v) int name = (v); asm volatile("" : "+s"(name))

    if (IN(0)) { OPQ_PTRS; ph_prologue(args, lds, wave0); ph_x_to_residual(args.in[0], R, ws + WS_A8, (float*)(ws + SSQX_OFF), wave0); if (BOTH(0)) GRID_BAR(); }

    for (int l_ = 0; l_ < 2; ++l_) {
        const int pb = 1 + 17 * l_;
        for (int hf_ = 0; hf_ < 2; ++hf_) {
            const int p2 = pb + 1 + 5 * hf_;
            if (IN(p2)) {
                OPQ_PTRS; OPQ_I(l, l_); OPQ_I(hf, hf_); const size_t r0 = (size_t)hf * HROWS;
                const float* ssq1 = (const float*)(ws + (l == 0 ? SSQX_OFF : SSQ1_OFF)) + r0 * 16;
                {
                    pg8::Gemm g{(const bf16*)(ws + WS_A8 + r0 * D), (const bf16*)(ws + WS_WG8 + (size_t)l * (WIN - GCOL0) * D), D / 2, D / 2, D / 2};
                    pg8::Order S; S.init(HROWS / 256, (WIN - GCOL0) / 256, G, (int)blockIdx.x, 0, D / 2, D / 2, nullptr, 0);
                    pg8::EpiGate8 E{(unsigned char*)U, 2 * UST, 2 * GCOL0, ssq1};
                    pg8::gemm_phase<pg8::EpiGate8, pg8::Order, true, true>(lds, fresh_tid(), g, S, E);
                }
                {
                    pg8::Gemm g{R + r0 * D, (const bf16*)(ws + WS_WIN) + (size_t)l * GCOL0 * D, D, D, D};
                    pg8::Order S; S.init(HROWS / 256, GCOL0 / 256, G, (int)blockIdx.x, 0, D, D, nullptr, 0);
                    pg8::EpiWin E{U, UST, ssq1, 1 << 20, kmean, C_KA / 256};
                    pg8::gemm_phase<pg8::EpiWin, pg8::Order, true>(lds, fresh_tid(), g, S, E);
                }
                if (BOTH(p2)) GRID_BAR();
            }
            if (IN(p2 + 2)) {
                OPQ_PTRS; OPQ_I(l, l_);
                ph_conv_pool(args, l, U, Y, lds, wave0);
                ph_attn(args, l, U, kmean, Y, lds, wave0);
                if (BOTH(p2 + 2)) GRID_BAR();
            }
            if (IN(p2 + 3)) {
                OPQ_PTRS; OPQ_I(l, l_);
                pg8::Gemm g{Y, (const bf16*)(ws + WS_BP) + (size_t)l * 4 * D * 256, 1024, 256, 256};
                pg8::Order S; S.init(HROWS / 256, 4, G, (int)blockIdx.x, 1, 1024, 256, nullptr, (size_t)D * 256 * 2);
                pg8::EpiMerge E{U, UST, GCOL0, MG, 1024, (const LAS float*)(lds + SLUT_OFF)};
                pg8::gemm_phase<pg8::EpiMerge, pg8::Order, true>(lds, fresh_tid(), g, S, E);
                if (BOTH(p2 + 3)) GRID_BAR();
            }
            if (IN(p2 + 4)) {
                OPQ_PTRS; OPQ_I(l, l_); OPQ_I(hf, hf_); const size_t r0 = (size_t)hf * HROWS;
                pg8::Gemm g{MG, (const bf16*)(ws + WS_WOUT) + (size_t)l * D * D, D, D, D};
                pg8::Order S; S.init(HROWS / 256, 4, G, (int)blockIdx.x, 0, D, D, nullptr, 0);
                pg8::EpiRes E{(const float*)nullptr, (const bf16*)(R + r0 * D), R + r0 * D, D, (l == 0) ? (float*)(ws + SSQ0_OFF) + r0 * 16 : (float*)nullptr};
                pg8::gemm_phase<pg8::EpiRes, pg8::Order, true>(lds, fresh_tid(), g, S, E);
                if (hf == 1 && BOTH(p2 + 4)) GRID_BAR();
            }
        }
        if (IN(pb + 11)) {
            OPQ_PTRS; OPQ_I(l, l_);
            if (l == 1) { ph_route(args, l, R, route, tokp, ctl, lds, wave0); if (BOTH(pb + 11)) GRID_BAR(); }
        }
        if (IN(pb + 12)) {
            OPQ_PTRS; OPQ_I(l, l_);
            if (l == 1) { ph_gather(args, l, R, route, tokp, gatep, tile_e, n_rt, ws + WS_HPERM, ctl, lds, wave0); if (BOTH(pb + 12)) GRID_BAR(); }
        }
        for (int ps_ = 0; ps_ < 2; ++ps_) {
            const int p3 = pb + 13 + 2 * ps_;
            if (IN(p3)) {
                OPQ_PTRS; OPQ_I(l, l_); OPQ_I(ps, ps_);
                if (l == 1) {
                    if (ps == 0) {
                        const int n0 = __builtin_amdgcn_readfirstlane(n_rt[0]), n1 = __builtin_amdgcn_readfirstlane(n_rt[1]);
                        pg8::Gemm g{(const bf16*)(ws + WS_HPERM), (const bf16*)(ws + WS_W13E), D / 2, D / 2, D / 2};
                        pg8::Order S; S.init(n0 + n1, 2 * FFE / 256, G, (int)blockIdx.x, 0, D / 2, D / 2, tile_e, (size_t)2 * FFE * D, n0, CAPT);
                        pg8::EpiSwiGLU8 E{ws + WS_TE, FFE, 256.0f, 8.0f};
                        pg8::gemm_phase<pg8::EpiSwiGLU8, pg8::Order, true, true>(lds, fresh_tid(), g, S, E);
                        if (BOTH(p3)) GRID_BAR();
                    }
                } else if (ps == 0) {
                    pg8::Gemm g{R, (const bf16*)(ws + WS_W13D), D, D, D};
                    pg8::Order S; S.init(M / 256, 2 * FF0 / 256, G, (int)blockIdx.x, 0, D, D, nullptr, 0);
                    pg8::EpiSwiGLU E{U, FF0, (const float*)(ws + SSQ0_OFF), 1};
                    pg8::gemm_phase<pg8::EpiSwiGLU, pg8::Order, true>(lds, fresh_tid(), g, S, E);
                    if (BOTH(p3)) GRID_BAR();
                }
            }
            if (IN(p3 + 1)) {
                OPQ_PTRS; OPQ_I(l, l_); OPQ_I(ps, ps_);
                if (l == 1) {
                    if (ps == 0) {
                        const int n0 = __builtin_amdgcn_readfirstlane(n_rt[0]), n1 = __builtin_amdgcn_readfirstlane(n_rt[1]);
                        pg8::Gemm g{(const bf16*)(ws + WS_TE), (const bf16*)(ws + WS_W2E), FFE / 2, FFE / 2, FFE / 2};
                        pg8::Order S; S.init(n0 + n1, 4, G, (int)blockIdx.x, 0, FFE / 2, FFE / 2, tile_e, (size_t)D * FFE, n0, CAPT);
                        pg8::EpiScatter E{R, D, tokp, gatep, 1.0f / 128.0f, nullptr, nullptr, (bf16*)args.out, 2048};
                        pg8::gemm_phase<pg8::EpiScatter, pg8::Order, true, true>(lds, fresh_tid(), g, S, E);
                        if (BOTH(p3 + 1)) GRID_BAR();
                    }
                } else if (ps == 0) {
                    pg8::Gemm g{U, (const bf16*)(ws + WS_W2D), FF0 / 2, FF0 / 2, FF0 / 2};
                    pg8::Order S; S.init(M / 256, 4, G, (int)blockIdx.x, 0, FF0 / 2, FF0 / 2, nullptr, 0);
                    pg8::EpiScatter E{R, D, nullptr, nullptr, 1.0f / 128.0f, (float*)(ws + SSQ1_OFF), ws + WS_A8, nullptr, 0};
                    pg8::gemm_phase<pg8::EpiScatter, pg8::Order, true, true>(lds, fresh_tid(), g, S, E);
                    if (BOTH(p3 + 1)) GRID_BAR();
                }
            }
        }
    }
    if (IN(35)) { OPQ_PTRS; ph_final_norm(R, args.in[19], args.out, wave0); }
#undef IN
#undef BOTH
}

extern "C" void kernel_launch(void* const* d_in, const int* in_sizes, int n_in, void* d_out, int out_size, void* d_ws, size_t ws_size, hipStream_t stream) {
    static int grid = 0;
    if (grid == 0) {
        if (n_in != 20 || in_sizes[0] != M * D || out_size != M * D || ws_size < WS_END) { fprintf(stderr, "kernel_launch: unexpected shapes / workspace (n_in %d, ws %zu); nothing launched\n", n_in, ws_size); grid = -1; return; }
        int dev = 0, cus = 0, per_cu = 0;
        if (hipGetDevice(&dev) != hipSuccess || hipDeviceGetAttribute(&cus, hipDeviceAttributeMultiprocessorCount, dev) != hipSuccess) { grid = -1; return; }
        if (hipFuncSetAttribute((const void*)mega_fwd, hipFuncAttributeMaxDynamicSharedMemorySize, LDS_BYTES) != hipSuccess) { fprintf(stderr, "kernel_launch: hipFuncSetAttribute failed\n"); grid = -1; return; }
        if (hipOccupancyMaxActiveBlocksPerMultiprocessor(&per_cu, (const void*)mega_fwd, NWAVES * 64, LDS_BYTES) != hipSuccess || per_cu < 1) { fprintf(stderr, "kernel_launch: occupancy query reports %d\n", per_cu); }
        (void)hipGetLastError();
        grid = cus;
    }
    if (grid < 0) return;
    if (hipMemsetAsync((char*)d_ws + WS_CTL, 0, CTL_ZERO_BYTES, stream) != hipSuccess) return;
    Args a{};
    for (int i = 0; i < 20; ++i) a.in[i] = (const float*)d_in[i];
    a.out = (float*)d_out; a.ws = (unsigned char*)d_ws;
#if MK_ONE_LAUNCH
#ifdef PROBE_DUP
    { const int dup[] = {PROBE_DUP}; const int nd = (int)(sizeof(dup) / sizeof(int)); int lo = 0;
      for (int i = 0; i <= nd; ++i) { a.ph_lo = lo; a.ph_hi = (i < nd) ? dup[i] + 1 : 36; a.li = i; hipLaunchKernelGGL(mega_fwd, dim3(grid), dim3(NWAVES * 64), LDS_BYTES, stream, a); if (i < nd) lo = dup[i]; } }
#else
    a.ph_lo = 0; a.ph_hi = 36;
    hipLaunchKernelGGL(mega_fwd, dim3(grid), dim3(NWAVES * 64), LDS_BYTES, stream, a);
#endif
#else
    for (int p = 0; p < 36; ++p) {
        if (p == 1 + 12 || p == 1 + 15 || p == 1 + 16) continue;
        a.ph_lo = p; a.ph_hi = p + 1;
        hipLaunchKernelGGL(mega_fwd, dim3(grid), dim3(NWAVES * 64), LDS_BYTES, stream, a);
    }
#endif
}
```
